# Optimizing an MI355X kernel written in HIP

```python
import jax, jax.numpy as jnp
from jax import lax
import numpy as np

D_MODEL = 1024
BATCH = 1
SEQ = 16384
DEPTH = 1
DEC_BATCH = 32
DEC_SEQ = 16
PAST_LEN = 4096

CHUNK = 64
POOL_WIDTH = D_MODEL // 2
POOL_WINDOWS = (2, 4, 8, 16)
POOL_GROUPS = len(POOL_WINDOWS)
POOL_GD = POOL_WIDTH // POOL_GROUPS
POOL_HIST = max(POOL_WINDOWS) - 1
GLA_HEADS = 4
GLA_DK = D_MODEL // 2
GLA_DV = D_MODEL
GLA_HK = GLA_DK // GLA_HEADS
GLA_HV = GLA_DV // GLA_HEADS
GLA_LOWRANK = 16
GLA_GATE_NORM = 16.0
D_FF = 4 * D_MODEL
EPS = 1e-6
IN_SIZES = (POOL_WIDTH, GLA_DK, GLA_DK, GLA_DV, GLA_DV, GLA_LOWRANK, D_MODEL, D_MODEL)
IN_WIDTH = sum(IN_SIZES)
IN_OFFSETS = tuple(int(o) for o in np.cumsum(IN_SIZES)[:-1])

kernel_name = "hybrid_pool_gla_adaln_stream_step"


def rmsnorm(x, g):
    xf = x.astype(jnp.float32)
    r = lax.rsqrt(jnp.mean(xf * xf, axis=-1, keepdims=True) + EPS)
    return (xf * r * g.astype(jnp.float32)).astype(x.dtype)


def modulate(h, shift, scale):
    return h * (1 + scale[:, None, :]) + shift[:, None, :]


def pool_mixer(u, hist, pos0, w_pool, pool_scale):
    B, L, _ = u.shape
    ext = jnp.concatenate([hist.astype(u.dtype), u], axis=1)
    cs = jnp.cumsum(ext.astype(jnp.float32), axis=1)
    cs = jnp.concatenate([jnp.zeros((B, 1, POOL_WIDTH), jnp.float32), cs], axis=1)
    end = cs[:, POOL_HIST + 1:]
    pos = pos0 + jnp.arange(L)
    uf = u.astype(jnp.float32)
    outs = []
    for gi, w in enumerate(POOL_WINDOWS):
        sl = slice(gi * POOL_GD, (gi + 1) * POOL_GD)
        start = cs[:, POOL_HIST + 1 - w: POOL_HIST + 1 - w + L, sl]
        cnt = jnp.minimum(pos + 1, w).astype(jnp.float32)[None, :, None]
        outs.append((end[..., sl] - start) / cnt - uf[..., sl])
    d = jnp.stack(outs, axis=2)
    mixed = jnp.einsum('blgc,gcd->blgd', d, w_pool.astype(jnp.float32)).reshape(B, L, POOL_WIDTH)
    mixed = mixed * pool_scale.astype(jnp.float32)
    return mixed.astype(u.dtype), ext[:, -POOL_HIST:]


def gla_block(S, q, k, v, a):
    C = q.shape[2]
    b = jnp.cumsum(a, axis=2)
    mask = jnp.tril(jnp.ones((C, C), dtype=bool))
    diff = b[:, :, :, None, :] - b[:, :, None, :, :]
    decay = jnp.exp(jnp.where(mask[None, None, :, :, None], diff, -jnp.inf))
    scores = jnp.einsum('bhic,bhijc,bhjc->bhij', q, decay, k)
    o = jnp.einsum('bhij,bhjv->bhiv', scores, v) + jnp.einsum('bhic,bhcv->bhiv', q * jnp.exp(b), S)
    b_last = b[:, :, -1:, :]
    S_new = jnp.exp(b_last[:, :, 0, :])[..., None] * S + jnp.einsum('bhjc,bhjv->bhcv', k * jnp.exp(b_last - b), v)
    return S_new, o


def gla_mixer(q, k, v, g, alr, S0, w_alpha, b_alpha, gla_norm_g):
    B, L, _ = q.shape
    f32 = jnp.float32
    a = jax.nn.log_sigmoid((alr @ w_alpha + b_alpha).astype(f32)) / GLA_GATE_NORM

    def heads(t, d):
        return t.astype(f32).reshape(B, L, GLA_HEADS, d).transpose(0, 2, 1, 3)

    qh = heads(q, GLA_HK) * (GLA_HK ** -0.5)
    kh = heads(k, GLA_HK)
    vh = heads(v, GLA_HV)
    ah = heads(a, GLA_HK)
    S0f = S0.astype(f32)
    C = min(L, CHUNK)
    N = L // C
    if N == 1:
        S_new, o = gla_block(S0f, qh, kh, vh, ah)
    else:
        def to_blocks(t):
            return t.reshape(B, GLA_HEADS, N, C, t.shape[-1]).transpose(2, 0, 1, 3, 4)
        S_new, o = lax.scan(lambda S, xs: gla_block(S, *xs), S0f,
                            (to_blocks(qh), to_blocks(kh), to_blocks(vh), to_blocks(ah)))
        o = o.transpose(1, 2, 0, 3, 4).reshape(B, GLA_HEADS, L, GLA_HV)
    o = rmsnorm(o.transpose(0, 2, 1, 3), gla_norm_g)
    o = o.reshape(B, L, GLA_DV) * jax.nn.silu(g.astype(f32))
    return o.astype(q.dtype), S_new.astype(S0.dtype)


def layer(x, c, pool_hist, S0, pos0, w_ada, b_ada, norm1_g, w_in, w_alpha, b_alpha, w_pool,
          pool_scale, gla_norm_g, w_pa, w_pb, w_out, norm2_g, w_ff1, w_ff2):
    mod = jax.nn.silu(c) @ w_ada + b_ada
    sh1, sc1, gt1, sh2, sc2, gt2 = jnp.split(mod, 6, axis=-1)
    h = modulate(rmsnorm(x, norm1_g), sh1, sc1)
    proj = h @ w_in
    u_pool, q, k, v, g, alr, ga, gb = jnp.split(proj, IN_OFFSETS, axis=-1)
    a_out, new_hist = pool_mixer(u_pool, pool_hist, pos0, w_pool, pool_scale)
    b_out, S_new = gla_mixer(q, k, v, g, alr, S0, w_alpha, b_alpha, gla_norm_g)
    merged = jax.nn.sigmoid(ga) * (a_out @ w_pa) + jax.nn.sigmoid(gb) * (b_out @ w_pb)
    x = x + gt1[:, None, :] * (merged @ w_out)
    h2 = modulate(rmsnorm(x, norm2_g), sh2, sc2)
    ff = jnp.square(jax.nn.relu(h2 @ w_ff1)) @ w_ff2
    x = x + gt2[:, None, :] * ff
    return x, new_hist, S_new


def setup_inputs(seed: int = 0) -> dict:
    key = jax.random.key(seed)
    ks = jax.random.split(key, 24)
    f32 = jnp.float32
    nrm = lambda k, shape, s: (jax.random.normal(k, shape, f32) * s)
    L_ = DEPTH
    return {
        "x_prompt": nrm(ks[0], (BATCH, SEQ, D_MODEL), 1.0),
        "x_sample": nrm(ks[1], (DEC_BATCH, DEC_SEQ, D_MODEL), 1.0),
        "c_prompt": nrm(ks[2], (BATCH, D_MODEL), 1.0),
        "c_sample": nrm(ks[3], (DEC_BATCH, D_MODEL), 1.0),
        "state_gla": nrm(ks[4], (L_, DEC_BATCH, GLA_HEADS, GLA_HK, GLA_HV), 1.0),
        "cache_pool": nrm(ks[5], (L_, DEC_BATCH, POOL_HIST, POOL_WIDTH), 1.0),
        "w_ada": nrm(ks[6], (L_, D_MODEL, 6 * D_MODEL), 0.5 * D_MODEL ** -0.5),
        "b_ada": nrm(ks[7], (L_, 6 * D_MODEL), 0.02),
        "norm1_g": 1.0 + nrm(ks[8], (L_, D_MODEL), 0.05),
        "w_in": nrm(ks[9], (L_, D_MODEL, IN_WIDTH), D_MODEL ** -0.5),
        "w_alpha": nrm(ks[10], (L_, GLA_LOWRANK, GLA_DK), GLA_LOWRANK ** -0.5),
        "b_alpha": nrm(ks[11], (L_, GLA_DK), 0.1),
        "w_pool": nrm(ks[12], (L_, POOL_GROUPS, POOL_GD, POOL_GD), POOL_GD ** -0.5),
        "pool_scale": 1.0 + nrm(ks[13], (L_, POOL_WIDTH), 0.1),
        "gla_norm_g": 1.0 + nrm(ks[14], (L_, GLA_HV), 0.05),
        "w_pa": nrm(ks[15], (L_, POOL_WIDTH, D_MODEL), POOL_WIDTH ** -0.5),
        "w_pb": nrm(ks[16], (L_, GLA_DV, D_MODEL), GLA_DV ** -0.5),
        "w_out": nrm(ks[17], (L_, D_MODEL, D_MODEL), D_MODEL ** -0.5),
        "norm2_g": 1.0 + nrm(ks[18], (L_, D_MODEL), 0.05),
        "w_ff1": nrm(ks[19], (L_, D_MODEL, D_FF), D_MODEL ** -0.5),
        "w_ff2": nrm(ks[20], (L_, D_FF, D_MODEL), D_FF ** -0.5),
        "final_g": 1.0 + nrm(ks[21], (D_MODEL,), 0.05),
    }


def reference(x_prompt, x_sample, c_prompt, c_sample, state_gla, cache_pool, w_ada, b_ada,
              norm1_g, w_in, w_alpha, b_alpha, w_pool, pool_scale, gla_norm_g, w_pa, w_pb,
              w_out, norm2_g, w_ff1, w_ff2, final_g):
    yp, ys = x_prompt, x_sample
    sp_list, hp_list, ss_list, hs_list = [], [], [], []
    for l in range(DEPTH):
        params = (w_ada[l], b_ada[l], norm1_g[l], w_in[l], w_alpha[l], b_alpha[l], w_pool[l],
                  pool_scale[l], gla_norm_g[l], w_pa[l], w_pb[l], w_out[l], norm2_g[l],
                  w_ff1[l], w_ff2[l])
        hist0 = jnp.zeros((BATCH, POOL_HIST, POOL_WIDTH), x_prompt.dtype)
        S0 = jnp.zeros((BATCH, GLA_HEADS, GLA_HK, GLA_HV), state_gla.dtype)
        yp, hp, sp = layer(yp, c_prompt, hist0, S0, 0, *params)
        ys, hs, ss = layer(ys, c_sample, cache_pool[l], state_gla[l], PAST_LEN, *params)
        sp_list.append(sp)
        hp_list.append(hp)
        ss_list.append(ss)
        hs_list.append(hs)
    y_prompt = rmsnorm(yp, final_g)
    y_sample = rmsnorm(ys, final_g)
    state_gla_prompt = jnp.stack(sp_list, axis=0)
    cache_pool_prompt = jnp.stack(hp_list, axis=0)
    state_gla_sample = jnp.stack(ss_list, axis=0)
    cache_pool_sample = jnp.stack(hs_list, axis=0)
    return (y_prompt, y_sample, state_gla_prompt, cache_pool_prompt, state_gla_sample, cache_pool_sample)
```

```cpp
#include <hip/hip_runtime.h>
#include <hip/hip_cooperative_groups.h>
#include <cstdio>
#include <cstdint>
namespace cg = cooperative_groups;
__device__ __forceinline__ int lane_id_fresh() { int l; asm volatile("v_mbcnt_lo_u32_b32 %0, -1, 0\n\tv_mbcnt_hi_u32_b32 %0, -1, %0" : "=v"(l)); return l; }
__device__ __forceinline__ float shfl_xor_l(float v, int o, int lane) { return __int_as_float(__builtin_amdgcn_ds_bpermute((lane ^ o) << 2, __float_as_int(v))); }
__device__ __forceinline__ float bf_lo(unsigned w) { return __uint_as_float(w << 16); }
__device__ __forceinline__ float bf_hi(unsigned w) { return __uint_as_float(w & 0xffff0000u); }
__device__ __forceinline__ float sigm(float x) { return 1.0f / (1.0f + __expf(-x)); }
namespace pg8 {
#define PG8_LAS __attribute__((address_space(3)))
typedef unsigned short bf16_t;
typedef short bf16x8 __attribute__((ext_vector_type(8)));
typedef float f32x4 __attribute__((ext_vector_type(4)));
typedef unsigned u32x4 __attribute__((ext_vector_type(4)));
constexpr int BM = 256, BK = 64, HALF = 128, HTB = HALF * BK * 2  , STAGE_BYTES = 8 * HTB, NXCD = 8, WGM = 8;

__host__ __device__ __forceinline__ int lds_byte(int r, int c) { const int st = (r >> 4) * 2 + (c >> 5), rr = r & 15, cc = c & 31, ob = rr * 64 + cc * 2; return st * 1024 + (ob ^ (((ob >> 9) & 1) << 5)); }
__host__ __device__ __forceinline__ void stage_rc(int b, int& R, int& C) { const int st = b / 1024, sb = b % 1024, swz = sb ^ (((sb >> 9) & 1) << 5); R = (st >> 1) * 16 + swz / 64; C = (st & 1) * 32 + (swz % 64) / 2; }
__host__ __device__ __forceinline__ int perm32(int rho) { const int n = rho >> 4, i = rho & 15; return 8 * (i >> 2) + 4 * n + (i & 3); }

struct Unit { int pm, pn; };
struct Gemm { const bf16_t* A; const bf16_t* Bt; int M, N, K; };

struct StaticOrder {
    int nM, nN, nwg, G, c;
    __host__ __device__ void init(int M, int N, int G_, int c_) { nM = M / BM; nN = N / BM; nwg = nM * nN; G = G_; c = c_; }
    __host__ __device__ bool next(int i, Unit& u) const {
        const long L = (long)i * G + c; if (L >= nwg) return false;
        int wgid = (int)L; { const int q = nwg / NXCD, r = nwg % NXCD, xcd = wgid % NXCD, off = wgid / NXCD; wgid = (xcd < r ? xcd * (q + 1) : r * (q + 1) + (xcd - r) * q) + off; }
        const int nig = WGM * nN, gid = wgid / nig, fm = gid * WGM, gsz = (nM - fm) < WGM ? (nM - fm) : WGM;
        u.pm = fm + ((wgid % nig) % gsz); u.pn = (wgid % nig) / gsz; return true;
    }
    __device__ __forceinline__ void a_ready(const Unit&) const {}
    __device__ __forceinline__ void done(const Unit&) const {}
};

__device__ __forceinline__ unsigned cvt_pk_bf16(float lo, float hi) { unsigned r; asm volatile("v_cvt_pk_bf16_f32 %0, %1, %2" : "=v"(r) : "v"(lo), "v"(hi)); return r; }
template <class Epi, class Sched, bool ALIGN_EPI = false, bool SP2 = false>
__device__ __forceinline__ void gemm_phase(PG8_LAS unsigned char* lds, const Gemm g, const Sched& S, const Epi& E, const int wave_id) {
    int tid_ = lane_id_fresh() + 64 * wave_id;
    const int tid = tid_, wid = __builtin_amdgcn_readfirstlane(tid >> 6), lane = tid & 63, wr = wid >> 2, wc = wid & 3, fr = lane & 15, fq = lane >> 4;
    const int K = g.K, nt = K / BK;
    unsigned voffA[2], voffB[2];
#pragma unroll
    for (int i = 0; i < 2; ++i) { int R, C; stage_rc(tid * 16 + i * 8192, R, C); const int Rb = Epi::PERM ? ((R & ~31) + perm32(R & 31)) : R;
        voffA[i] = (unsigned)(R * K + C) * 2u; voffB[i] = (unsigned)(Rb * K + C) * 2u; }
    const size_t kstep = (size_t)(BK * 2);
    const size_t hstep = (size_t)HALF * K * 2;
    const size_t tstep = 2 * hstep;
    const unsigned ldsw = (unsigned)wid * 1024u;
    const int aoff = lds_byte(wr * 64 + fr, fq * 8), boff = lds_byte(wc * 32 + fr, fq * 8);
#define PG8_SA(b, h) (((b) * 2 + (h)) * HTB)
#define PG8_SB(b, h) ((4 + (b) * 2 + (h)) * HTB)
#define PG8_STAGE(bufoff, gbase, voff) do { _Pragma("unroll") for (int _i = 0; _i < 2; ++_i) \
        __builtin_amdgcn_global_load_lds((const unsigned*)((const char*)(gbase) + (voff)[_i]), (PG8_LAS unsigned*)(lds + (bufoff) + ldsw + _i * 8192), 16, 0, 0); } while (0)
#define PG8_LDA(dst, b, h) do { _Pragma("unroll") for (int m = 0; m < 4; ++m) _Pragma("unroll") for (int k = 0; k < 2; ++k) dst[m][k] = *(const PG8_LAS bf16x8*)(lds + PG8_SA(b, h) + aoff + m * 2048 + k * 1024); } while (0)
#define PG8_LDB(dst, b, h) do { _Pragma("unroll") for (int n = 0; n < 2; ++n) _Pragma("unroll") for (int k = 0; k < 2; ++k) dst[n][k] = *(const PG8_LAS bf16x8*)(lds + PG8_SB(b, h) + boff + n * 2048 + k * 1024); } while (0)
#define PG8_MMA(ai, bj, At, Bt) do { __builtin_amdgcn_s_setprio(1); _Pragma("unroll") for (int m = 0; m < 4; ++m) _Pragma("unroll") for (int n = 0; n < 2; ++n) _Pragma("unroll") for (int k = 0; k < 2; ++k) \
        acc[ai][bj][m][n] = __builtin_amdgcn_mfma_f32_16x16x32_bf16(Bt[n][k], At[m][k], acc[ai][bj][m][n], 0, 0, 0); __builtin_amdgcn_s_setprio(0); } while (0)
#define PG8_WAIT_V(n) asm volatile("s_waitcnt vmcnt(" #n ")" ::: "memory")
#define PG8_WAIT_L(n) asm volatile("s_waitcnt lgkmcnt(" #n ")" ::: "memory")
#define PG8_BAR __builtin_amdgcn_s_barrier()
#define PG8_SCHED __builtin_amdgcn_sched_barrier(0)
    Unit cur, nxt; int ui = 0;
    if (!S.next(0, cur)) return;
    f32x4 acc[2][2][4][2];
#pragma unroll
    for (int a = 0; a < 2; ++a)
#pragma unroll
        for (int b = 0; b < 2; ++b)
#pragma unroll
            for (int m = 0; m < 4; ++m)
#pragma unroll
                for (int n = 0; n < 2; ++n) acc[a][b][m][n] = (f32x4){0.f, 0.f, 0.f, 0.f};
    bf16x8 At[4][2], B0[2][2], B1[2][2];
    const char* cA = (const char*)g.A + (size_t)cur.pm * tstep; const char* cB = (const char*)g.Bt + (size_t)cur.pn * tstep;
    S.a_ready(cur);
    if constexpr (SP2) {
        PG8_STAGE(PG8_SB(0, 0), cB, voffB); PG8_STAGE(PG8_SB(0, 1), cB + hstep, voffB); PG8_STAGE(PG8_SA(0, 0), cA, voffA); PG8_STAGE(PG8_SA(0, 1), cA + hstep, voffA);
        if (wr == 1) PG8_BAR;
        PG8_WAIT_V(2); PG8_BAR;
        PG8_STAGE(PG8_SB(1, 0), cB + kstep, voffB); PG8_STAGE(PG8_SA(1, 0), cA + kstep, voffA); PG8_STAGE(PG8_SB(1, 1), cB + hstep + kstep, voffB);
        PG8_WAIT_V(6); PG8_BAR;
    } else {
        PG8_STAGE(PG8_SB(0, 0), cB, voffB); PG8_STAGE(PG8_SA(0, 0), cA, voffA); PG8_STAGE(PG8_SB(0, 1), cB + hstep, voffB); PG8_STAGE(PG8_SA(0, 1), cA + hstep, voffA);
        if (wr == 1) PG8_BAR;
        PG8_WAIT_V(4); PG8_BAR;
        PG8_STAGE(PG8_SB(1, 0), cB + kstep, voffB); PG8_STAGE(PG8_SA(1, 0), cA + kstep, voffA); PG8_STAGE(PG8_SB(1, 1), cB + hstep + kstep, voffB);
        PG8_WAIT_V(6); PG8_BAR;
    }
    for (;;) {
        const bool has_next = S.next(ui + 1, nxt);
        const char* nA = has_next ? (const char*)g.A + (size_t)nxt.pm * tstep : cA; const char* nB = has_next ? (const char*)g.Bt + (size_t)nxt.pn * tstep : cB;
        for (int t = 0; t < nt; t += 2) {
            if constexpr (Epi::MID_T > 0) { if (t == Epi::MID_T) E.mid(acc, cur, wr, wc, fr, fq); }
            const bool last = (t == nt - 2);
            const char* a1 = cA + (size_t)(t + 1) * kstep;
            const char* a2 = last ? nA : cA + (size_t)(t + 2) * kstep; const char* b2 = last ? nB : cB + (size_t)(t + 2) * kstep;
            const char* a3 = a2 + kstep; const char* b3 = b2 + kstep;
            if (last && has_next) S.a_ready(nxt);
            if constexpr (SP2) {
            PG8_LDB(B0, 0, 0); PG8_LDB(B1, 0, 1); PG8_SCHED; PG8_LDA(At, 0, 0); PG8_STAGE(PG8_SA(1, 1), a1 + hstep, voffA);
            PG8_WAIT_V(8); PG8_WAIT_L(0); PG8_BAR; PG8_MMA(0, 0, At, B0); PG8_MMA(0, 1, At, B1); PG8_BAR; PG8_SCHED;
            PG8_LDA(At, 0, 1); PG8_STAGE(PG8_SB(0, 0), b2, voffB); PG8_STAGE(PG8_SB(0, 1), b2 + hstep, voffB); PG8_STAGE(PG8_SA(0, 0), a2, voffA);
            PG8_WAIT_V(8); PG8_WAIT_L(0); PG8_BAR; PG8_MMA(1, 0, At, B0); PG8_MMA(1, 1, At, B1); PG8_BAR; PG8_SCHED;
            PG8_LDB(B0, 1, 0); PG8_LDB(B1, 1, 1); PG8_SCHED; PG8_LDA(At, 1, 0); PG8_STAGE(PG8_SA(0, 1), a2 + hstep, voffA);
            PG8_WAIT_V(8); PG8_WAIT_L(0); PG8_BAR; PG8_MMA(0, 0, At, B0); PG8_MMA(0, 1, At, B1); PG8_BAR; PG8_SCHED;
            PG8_LDA(At, 1, 1); PG8_STAGE(PG8_SB(1, 0), b3, voffB); PG8_STAGE(PG8_SB(1, 1), b3 + hstep, voffB); PG8_STAGE(PG8_SA(1, 0), a3, voffA);
            PG8_WAIT_V(8); PG8_WAIT_L(0); PG8_BAR; PG8_MMA(1, 0, At, B0); PG8_MMA(1, 1, At, B1); PG8_BAR; PG8_SCHED;
            } else {
            PG8_LDB(B0, 0, 0); PG8_SCHED; PG8_LDA(At, 0, 0); PG8_STAGE(PG8_SA(1, 1), a1 + hstep, voffA);
            PG8_WAIT_L(8); PG8_BAR; PG8_WAIT_L(0); PG8_MMA(0, 0, At, B0); PG8_BAR; PG8_SCHED;
            PG8_LDB(B1, 0, 1); PG8_STAGE(PG8_SB(0, 0), b2, voffB);
            PG8_BAR; PG8_WAIT_L(0); PG8_MMA(0, 1, At, B1); PG8_BAR;
            PG8_LDA(At, 0, 1); PG8_STAGE(PG8_SA(0, 0), a2, voffA);
            PG8_BAR; PG8_WAIT_L(0); PG8_MMA(1, 0, At, B0); PG8_BAR; PG8_SCHED;
            PG8_STAGE(PG8_SB(0, 1), b2 + hstep, voffB);
            PG8_WAIT_V(6); PG8_BAR; PG8_MMA(1, 1, At, B1); PG8_BAR;
            PG8_LDB(B0, 1, 0); PG8_SCHED; PG8_LDA(At, 1, 0); PG8_STAGE(PG8_SA(0, 1), a2 + hstep, voffA);
            PG8_WAIT_L(8); PG8_BAR; PG8_WAIT_L(0); PG8_MMA(0, 0, At, B0); PG8_BAR; PG8_SCHED;
            PG8_LDB(B1, 1, 1); PG8_STAGE(PG8_SB(1, 0), b3, voffB);
            PG8_BAR; PG8_WAIT_L(0); PG8_MMA(0, 1, At, B1); PG8_BAR;
            PG8_LDA(At, 1, 1); PG8_STAGE(PG8_SA(1, 0), a3, voffA);
            PG8_BAR; PG8_WAIT_L(0); PG8_MMA(1, 0, At, B0); PG8_BAR; PG8_SCHED;
            PG8_STAGE(PG8_SB(1, 1), b3 + hstep, voffB);
            PG8_WAIT_V(6); PG8_BAR; PG8_MMA(1, 1, At, B1); PG8_BAR;
            }
        }
        if constexpr (ALIGN_EPI) { if (wr == 0) PG8_BAR; }
        if constexpr (!Epi::AFTER_DRAIN) { E(acc, cur, wr, wc, fr, fq); S.done(cur); }
        if (!has_next) break;
#pragma unroll
        for (int a = 0; a < 2; ++a)
#pragma unroll
            for (int b = 0; b < 2; ++b)
#pragma unroll
                for (int m = 0; m < 4; ++m)
#pragma unroll
                    for (int n = 0; n < 2; ++n) acc[a][b][m][n] = (f32x4){0.f, 0.f, 0.f, 0.f};
        cur = nxt; cA = nA; cB = nB; ++ui;
        if constexpr (ALIGN_EPI) { if (wr == 1) PG8_BAR; }
    }
    PG8_WAIT_V(0);
    if constexpr (!ALIGN_EPI) { if (wr == 0) PG8_BAR; }
    PG8_BAR;
    if constexpr (Epi::AFTER_DRAIN) { E.fused(acc, cur, wr, wc, fr, fq, lds, wid, lane); S.done(cur); }
#undef PG8_SA
#undef PG8_SB
#undef PG8_STAGE
#undef PG8_LDA
#undef PG8_LDB
#undef PG8_MMA
#undef PG8_WAIT_V
#undef PG8_WAIT_L
#undef PG8_BAR
#undef PG8_SCHED
}


constexpr int MP_ROWS = 16384;

struct EpiProj {
    static constexpr bool PERM = true, AFTER_DRAIN = false; static constexpr int MID_T = 0;
    bf16_t* PA; bf16_t* PB; float* ALR;
    __device__ __forceinline__ void mid(f32x4 (&)[2][2][4][2], const Unit&, int, int, int, int) const {}
    __device__ __forceinline__ void operator()(const f32x4 (&acc)[2][2][4][2], const Unit& u, int wr, int wc, int fr, int fq) const {
        const int row0 = u.pm * BM + wr * 64 + fr;
        if (u.pn < 22) {
            bf16_t* base; int ldc, colt;
            if (u.pn < 14) { base = PA; ldc = 3584; colt = u.pn * BM; } else { base = PB; ldc = 2048; colt = (u.pn - 14) * BM; }
            const int col0 = colt + wc * 32 + 8 * fq;
#pragma unroll
            for (int ai = 0; ai < 2; ++ai)
#pragma unroll
                for (int m = 0; m < 4; ++m) { bf16_t* rowp = base + (size_t)(row0 + ai * HALF + m * 16) * ldc + col0;
#pragma unroll
                    for (int bj = 0; bj < 2; ++bj) { const f32x4 v0 = acc[ai][bj][m][0], v1 = acc[ai][bj][m][1];
                        u32x4 w; w.x = cvt_pk_bf16(v0[0], v0[1]); w.y = cvt_pk_bf16(v0[2], v0[3]); w.z = cvt_pk_bf16(v1[0], v1[1]); w.w = cvt_pk_bf16(v1[2], v1[3]);
                        *(u32x4*)(rowp + bj * HALF) = w; } }
        } else if (wc == 0 && fq < 2) {
#pragma unroll
            for (int ai = 0; ai < 2; ++ai)
#pragma unroll
                for (int m = 0; m < 4; ++m) { float* p = ALR + (size_t)(row0 + ai * HALF + m * 16) * 16 + 8 * fq;
                    *(f32x4*)p = acc[ai][0][m][0]; *(f32x4*)(p + 4) = acc[ai][0][m][1]; }
        }
    }
};
struct EpiMerge {
    static constexpr bool PERM = true, AFTER_DRAIN = false; static constexpr int MID_T = 8;
    const bf16_t* PB; bf16_t* O;
    __device__ __forceinline__ void mid(f32x4 (&acc)[2][2][4][2], const Unit& u, int wr, int wc, int fr_, int fq) const {
        int fr = fr_; asm volatile("" : "+v"(fr));
        const int row0 = u.pm * BM + wr * 64 + fr, col0 = u.pn * BM + wc * 32 + 8 * fq;
#pragma unroll
        for (int ai = 0; ai < 2; ++ai)
#pragma unroll
            for (int m = 0; m < 4; ++m) { const bf16_t* gp = PB + (size_t)(row0 + ai * HALF + m * 16) * 2048 + col0;
#pragma unroll
                for (int bj = 0; bj < 2; ++bj) { const u32x4 a8 = *(const u32x4*)(gp + bj * HALF), b8 = *(const u32x4*)(gp + 1024 + bj * HALF);
#pragma unroll
                    for (int e = 0; e < 4; ++e) { const unsigned aw = a8[e], bw = b8[e];
                        const float f0 = (1.0f + __expf(-bf_lo(bw))) / (1.0f + __expf(-bf_lo(aw))), f1 = (1.0f + __expf(-bf_hi(bw))) / (1.0f + __expf(-bf_hi(aw)));
                        acc[ai][bj][m][e >> 1][(e & 1) * 2] *= f0; acc[ai][bj][m][e >> 1][(e & 1) * 2 + 1] *= f1; } }
                asm volatile("" ::: "memory"); }
    }
    __device__ __forceinline__ void operator()(const f32x4 (&acc)[2][2][4][2], const Unit& u, int wr, int wc, int fr, int fq) const {
        const int row0 = u.pm * BM + wr * 64 + fr, col0 = u.pn * BM + wc * 32 + 8 * fq;
#pragma unroll
        for (int ai = 0; ai < 2; ++ai)
#pragma unroll
            for (int m = 0; m < 4; ++m) { const size_t r = (size_t)(row0 + ai * HALF + m * 16);
#pragma unroll
                for (int bj = 0; bj < 2; ++bj) { const u32x4 b8 = *(const u32x4*)(PB + r * 2048 + 1024 + col0 + bj * HALF);
                    const f32x4 v0 = acc[ai][bj][m][0], v1 = acc[ai][bj][m][1]; u32x4 w;
                    w.x = cvt_pk_bf16(v0[0] * sigm(bf_lo(b8.x)), v0[1] * sigm(bf_hi(b8.x))); w.y = cvt_pk_bf16(v0[2] * sigm(bf_lo(b8.y)), v0[3] * sigm(bf_hi(b8.y)));
                    w.z = cvt_pk_bf16(v1[0] * sigm(bf_lo(b8.z)), v1[1] * sigm(bf_hi(b8.z))); w.w = cvt_pk_bf16(v1[2] * sigm(bf_lo(b8.w)), v1[3] * sigm(bf_hi(b8.w)));
                    *(u32x4*)(O + r * 1024 + col0 + bj * HALF) = w; } }
    }
};
template <bool INPLACE> struct EpiRes {
    static constexpr bool PERM = false, AFTER_DRAIN = false; static constexpr int MID_T = 0;
    const float* xp; const float* xs; float* out; const float* gate;
    __device__ __forceinline__ void mid(f32x4 (&)[2][2][4][2], const Unit&, int, int, int, int) const {}
    __device__ __forceinline__ void operator()(const f32x4 (&acc)[2][2][4][2], const Unit& u, int wr, int wc, int fr, int fq) const {
        const int row0 = u.pm * BM + wr * 64 + fr, col0 = u.pn * BM + wc * 32 + 4 * fq;
#pragma unroll
        for (int ai = 0; ai < 2; ++ai)
#pragma unroll
            for (int m = 0; m < 4; ++m) { const int row = row0 + ai * HALF + m * 16; const int seq = row < MP_ROWS ? 0 : 1 + ((row - MP_ROWS) >> 4);
                const float* g = gate + (size_t)seq * 6144 + col0; float* op = out + (size_t)row * 1024 + col0;
                const float* bp = INPLACE ? (const float*)op : ((row < MP_ROWS ? xp + (size_t)row * 1024 : xs + (size_t)(row - MP_ROWS) * 1024) + col0);
#pragma unroll
                for (int bj = 0; bj < 2; ++bj)
#pragma unroll
                    for (int n = 0; n < 2; ++n) { const int c = bj * HALF + n * 16; const f32x4 bs = *(const f32x4*)(bp + c), gt = *(const f32x4*)(g + c);
                        *(f32x4*)(op + c) = bs + gt * acc[ai][bj][m][n]; }
                if (m & 1) asm volatile("" ::: "memory"); }
    }
};
struct EpiRelu2 {
    static constexpr bool PERM = true, AFTER_DRAIN = false; static constexpr int MID_T = 0;
    bf16_t* O;
    __device__ __forceinline__ void mid(f32x4 (&)[2][2][4][2], const Unit&, int, int, int, int) const {}
    __device__ __forceinline__ void operator()(const f32x4 (&acc)[2][2][4][2], const Unit& u, int wr, int wc, int fr, int fq) const {
        const int row0 = u.pm * BM + wr * 64 + fr, col0 = u.pn * BM + wc * 32 + 8 * fq;
#pragma unroll
        for (int ai = 0; ai < 2; ++ai)
#pragma unroll
            for (int m = 0; m < 4; ++m) { bf16_t* rowp = O + (size_t)(row0 + ai * HALF + m * 16) * 4096 + col0;
#pragma unroll
                for (int bj = 0; bj < 2; ++bj) { f32x4 v0 = acc[ai][bj][m][0], v1 = acc[ai][bj][m][1];
#pragma unroll
                    for (int e = 0; e < 4; ++e) { const float a = fmaxf(v0[e], 0.f), b = fmaxf(v1[e], 0.f); v0[e] = a * a; v1[e] = b * b; }
                    u32x4 w; w.x = cvt_pk_bf16(v0[0], v0[1]); w.y = cvt_pk_bf16(v0[2], v0[3]); w.z = cvt_pk_bf16(v1[0], v1[1]); w.w = cvt_pk_bf16(v1[2], v1[3]);
                    *(u32x4*)(rowp + bj * HALF) = w; } }
    }
};
}

#define LAS __attribute__((address_space(3)))
typedef unsigned short bf16;
typedef float f32x4 __attribute__((ext_vector_type(4)));
typedef float f32x2 __attribute__((ext_vector_type(2)));
typedef unsigned u32x4 __attribute__((ext_vector_type(4)));
typedef unsigned u32x2 __attribute__((ext_vector_type(2)));
typedef short bf16x8 __attribute__((ext_vector_type(8)));
typedef short s16x4 __attribute__((ext_vector_type(4)));

constexpr int DM = 1024, MP = 16384, NSEQ = 32, LSAMP = 16, MS = NSEQ * LSAMP, MT = MP + MS;
constexpr int NIN = 5888, KCAT = 1536, DFF = 4096, NMOD = 6144, NROWS_MOD = 33;
constexpr int PA_LD = 3584, PB_LD = 2048;
constexpr int NSC = 64;
constexpr float EPS = 1e-6f;
constexpr size_t MiB = 1u << 20;
constexpr size_t WS_MOD = 1 * MiB;
constexpr size_t WS_ALR = 2 * MiB;
constexpr size_t WS_GT = 4 * MiB;
constexpr size_t WS_WIN = 8 * MiB;
constexpr size_t WS_WCAT = 20 * MiB;
constexpr size_t WS_WOUT = 23 * MiB;
constexpr size_t WS_WFF1 = 25 * MiB;
constexpr size_t WS_WFF2 = 33 * MiB;
constexpr size_t WS_PB = 42 * MiB;
constexpr size_t WS_PA = 108 * MiB;
constexpr size_t WS_US = 224 * MiB;
constexpr size_t WS_END = 256 * MiB;
constexpr size_t O_Y = 0, O_SGP = (size_t)MT * DM, O_CPP = O_SGP + 131072, O_SGS = O_CPP + 7680, O_CPS = O_SGS + (size_t)NSEQ * 131072;
constexpr int LDS_BYTES = 147456;

__device__ __forceinline__ float bf2f(unsigned short h) { return __uint_as_float((unsigned)h << 16); }
__device__ __forceinline__ unsigned f2bf(float f) { unsigned u = __float_as_uint(f); return (u + 0x7fffu + ((u >> 16) & 1u)) >> 16; }
__device__ __forceinline__ unsigned pk2(float lo, float hi) { return f2bf(lo) | (f2bf(hi) << 16); }
__device__ __forceinline__ float wave_sum(float v, int lane) {
#pragma unroll
    for (int o = 1; o < 64; o <<= 1) v += shfl_xor_l(v, o, lane);
    return v;
}
__device__ __forceinline__ float silu_f(float x) { return x / (1.0f + __expf(-x)); }

__device__ __forceinline__ void transpose_item(const float* W, int ldn, int k0, int c0, int valid, bf16* WT, int dld, int drow0, int dk0, LAS float* scr, int lane) {
#pragma unroll 8
    for (int i = 0; i < 32; ++i) { const int kk = 2 * i + (lane >> 5), n = lane & 31; scr[kk * 33 + n] = n < valid ? W[(size_t)(k0 + kk) * ldn + c0 + n] : 0.f; }
    asm volatile("s_waitcnt lgkmcnt(0)" ::: "memory");
    const int c = lane & 7;
#pragma unroll
    for (int j = 0; j < 4; ++j) { const int n = (lane >> 3) + 8 * j; const LAS float* s = scr + (8 * c) * 33 + n;
        u32x4 o; o.x = pk2(s[0 * 33], s[1 * 33]); o.y = pk2(s[2 * 33], s[3 * 33]); o.z = pk2(s[4 * 33], s[5 * 33]); o.w = pk2(s[6 * 33], s[7 * 33]);
        *(u32x4*)(WT + (size_t)(drow0 + n) * dld + dk0 + k0 + 8 * c) = o; }
    asm volatile("s_waitcnt lgkmcnt(0)" ::: "memory");
}

struct Args { const float* in[22]; float* out; unsigned char* ws; };

constexpr int G_QD = 0, G_KD = 17408, G_KPT = 34816, G_VT = 53248, G_ALR = 90112, G_PART = 94208, G_GL = 96256, G_SSQ = 96768;
#define MFMA16(a, b, c) __builtin_amdgcn_mfma_f32_16x16x32_bf16((a), (b), (c), 0, 0, 0)
__device__ __forceinline__ bf16x8 pack8(const f32x4& a, const f32x4& b) {
    u32x4 p; p.x = pk2(a[0], a[1]); p.y = pk2(a[2], a[3]); p.z = pk2(b[0], b[1]); p.w = pk2(b[2], b[3]); return __builtin_bit_cast(bf16x8, p);
}
template <bool DO_O>
__device__ __forceinline__ void gla_unit(LAS unsigned char* lds, const int tid_in, const int row0, const int nchunks, const int nvalid, const int h,
                                         const bf16* PA, const float* ALR, const float* w_alpha, const float* b_alpha, const float* gnorm,
                                         const float* Sinit, float* Sout, float* Gout, bf16* ACAT) {
    int tid = tid_in; asm volatile("" : "+v"(tid));
    const int lane = tid & 63, wid = tid >> 6, fr = lane & 15, fq = lane >> 4, dvb = wid * 32;
    f32x4 S[8][2];
#pragma unroll
    for (int kt = 0; kt < 8; ++kt)
#pragma unroll
        for (int dvt = 0; dvt < 2; ++dvt) {
            if (Sinit) {
#pragma unroll
                for (int r = 0; r < 4; ++r) S[kt][dvt][r] = Sinit[(size_t)(16 * kt + 4 * fq + r) * 256 + dvb + 16 * dvt + fr];
            } else S[kt][dvt] = (f32x4){0.f, 0.f, 0.f, 0.f};
        }
    const int dk = tid & 127, tq = tid >> 7;
    float gsum = 0.f;
    LAS bf16* QD = (LAS bf16*)(lds + G_QD); LAS bf16* KD = (LAS bf16*)(lds + G_KD);
    LAS float* ALRL = (LAS float*)(lds + G_ALR); LAS float* PART = (LAS float*)(lds + G_PART); LAS float* GL = (LAS float*)(lds + G_GL); LAS float* SSQ = (LAS float*)(lds + G_SSQ);
    for (int ch = 0; ch < nchunks; ++ch) {
        const int r0 = row0 + ch * 64;
        __syncthreads();
        if (tid < 256) { const int t = tid >> 2, part = tid & 3; f32x4 v = (f32x4){0.f, 0.f, 0.f, 0.f}; if (t < nvalid) v = *(const f32x4*)(ALR + (size_t)(r0 + t) * 16 + part * 4);
            *(LAS f32x4*)(ALRL + t * 16 + part * 4) = v; }
        unsigned short qv[16], kv[16];
#pragma unroll
        for (int i = 0; i < 16; ++i) { const int t = 16 * tq + i; qv[i] = 0; kv[i] = 0;
            if (t < nvalid) { const bf16* p = PA + (size_t)(r0 + t) * PA_LD + h * 128 + dk; qv[i] = p[512]; kv[i] = p[1024]; } }
        {
            const int dv2 = tid & 127, tg = tid >> 7; unsigned vv[16];
#pragma unroll
            for (int i = 0; i < 16; ++i) { const int t = 16 * tg + i; vv[i] = 0u; if (t < nvalid) vv[i] = *(const unsigned*)(PA + (size_t)(r0 + t) * PA_LD + 1536 + h * 256 + 2 * dv2); }
            u32x4 lo0, lo1, hi0, hi1;
#pragma unroll
            for (int j = 0; j < 4; ++j) { lo0[j] = (vv[2 * j] & 0xffffu) | (vv[2 * j + 1] << 16); hi0[j] = (vv[2 * j] >> 16) | (vv[2 * j + 1] & 0xffff0000u);
                lo1[j] = (vv[8 + 2 * j] & 0xffffu) | (vv[8 + 2 * j + 1] << 16); hi1[j] = (vv[8 + 2 * j] >> 16) | (vv[8 + 2 * j + 1] & 0xffff0000u); }
            LAS unsigned char* vt = lds + G_VT + (2 * dv2) * 144 + tg * 32;
            *(LAS u32x4*)(vt) = lo0; *(LAS u32x4*)(vt + 16) = lo1; *(LAS u32x4*)(vt + 144) = hi0; *(LAS u32x4*)(vt + 160) = hi1;
        }
        __syncthreads();
        const float* wa_ = w_alpha; asm volatile("" : "+s"(wa_));
        float wal[16];
#pragma unroll
        for (int r = 0; r < 16; ++r) wal[r] = wa_[r * 512 + h * 128 + dk];
        const float bal = b_alpha[h * 128 + dk];
        float bl[16]; float run = 0.f;
#pragma unroll
        for (int i = 0; i < 16; ++i) { const int t = 16 * tq + i; const LAS f32x4* ar = (const LAS f32x4*)(ALRL + t * 16); float x = bal;
#pragma unroll
            for (int j = 0; j < 4; ++j) { const f32x4 a4 = ar[j]; x += a4[0] * wal[4 * j] + a4[1] * wal[4 * j + 1] + a4[2] * wal[4 * j + 2] + a4[3] * wal[4 * j + 3]; }
            const float ls = fminf(x, 0.f) - log1pf(__expf(-fabsf(x)));
            run += (t < nvalid) ? ls * (1.0f / 16.0f) : 0.f; bl[i] = run; }
        PART[tq * 128 + dk] = run;
        __syncthreads();
        float off = 0.f, tot = 0.f;
#pragma unroll
        for (int t4 = 0; t4 < 4; ++t4) { const float p = PART[t4 * 128 + dk]; tot += p; off += (t4 < tq) ? p : 0.f; }
        unsigned kpk[8];
#pragma unroll
        for (int i = 0; i < 16; ++i) { const int t = 16 * tq + i; const float b = bl[i] + off; const float q = bf2f(qv[i]) * 0.08838834764831845f, k = bf2f(kv[i]);
            QD[t * 136 + dk] = (bf16)f2bf(q * __expf(b)); KD[t * 136 + dk] = (bf16)f2bf(k * __expf(-b));
            const unsigned kp = f2bf(k * __expf(tot - b)); if (i & 1) kpk[i >> 1] |= kp << 16; else kpk[i >> 1] = kp; }
        { LAS unsigned char* kp = lds + G_KPT + dk * 144 + tq * 32; *(LAS u32x4*)kp = (u32x4){kpk[0], kpk[1], kpk[2], kpk[3]}; *(LAS u32x4*)(kp + 16) = (u32x4){kpk[4], kpk[5], kpk[6], kpk[7]}; }
        if (tq == 0) GL[dk] = __expf(tot);
        gsum += tot;
        __syncthreads();
        if constexpr (DO_O) {
            f32x4 oT[4][2];
#pragma unroll
            for (int it = 0; it < 4; ++it) {
                oT[it][0] = (f32x4){0.f, 0.f, 0.f, 0.f}; oT[it][1] = (f32x4){0.f, 0.f, 0.f, 0.f};
#pragma unroll
                for (int jp = 0; jp < 2; ++jp) {
                    if (2 * jp > it) continue;
                    const int jt0 = 2 * jp, jt1 = 2 * jp + 1;
                    f32x4 P0 = (f32x4){0.f, 0.f, 0.f, 0.f}, P1 = (f32x4){0.f, 0.f, 0.f, 0.f};
#pragma unroll
                    for (int ks = 0; ks < 4; ++ks) {
                        const bf16x8 yq = *(const LAS bf16x8*)(lds + G_QD + (16 * it + fr) * 272 + (32 * ks + 8 * fq) * 2);
                        const bf16x8 x0 = *(const LAS bf16x8*)(lds + G_KD + (16 * jt0 + fr) * 272 + (32 * ks + 8 * fq) * 2);
                        P0 = MFMA16(x0, yq, P0);
                        if (jt1 <= it) { const bf16x8 x1 = *(const LAS bf16x8*)(lds + G_KD + (16 * jt1 + fr) * 272 + (32 * ks + 8 * fq) * 2); P1 = MFMA16(x1, yq, P1); }
                    }
                    if (jt0 == it) {
#pragma unroll
                        for (int r = 0; r < 4; ++r) if (fr < 4 * fq + r) P0[r] = 0.f;
                    }
                    if (jt1 == it) {
#pragma unroll
                        for (int r = 0; r < 4; ++r) if (fr < 4 * fq + r) P1[r] = 0.f;
                    }
                    const bf16x8 pb = pack8(P0, P1);
#pragma unroll
                    for (int dvt = 0; dvt < 2; ++dvt) {
                        const LAS unsigned char* vr = lds + G_VT + (dvb + 16 * dvt + fr) * 144;
                        const s16x4 a0 = *(const LAS s16x4*)(vr + (16 * jt0 + 4 * fq) * 2), a1 = *(const LAS s16x4*)(vr + (16 * jt1 + 4 * fq) * 2);
                        const bf16x8 xa = __builtin_shufflevector(a0, a1, 0, 1, 2, 3, 4, 5, 6, 7);
                        oT[it][dvt] = MFMA16(xa, pb, oT[it][dvt]);
                    }
                }
            }
#pragma unroll
            for (int kp = 0; kp < 4; ++kp) {
                const bf16x8 Sb0 = pack8(S[2 * kp][0], S[2 * kp + 1][0]), Sb1 = pack8(S[2 * kp][1], S[2 * kp + 1][1]);
#pragma unroll
                for (int it = 0; it < 4; ++it) {
                    const LAS unsigned char* qr = lds + G_QD + (16 * it + fr) * 272;
                    const s16x4 q0 = *(const LAS s16x4*)(qr + (32 * kp + 4 * fq) * 2), q1 = *(const LAS s16x4*)(qr + (32 * kp + 16 + 4 * fq) * 2);
                    const bf16x8 yq = __builtin_shufflevector(q0, q1, 0, 1, 2, 3, 4, 5, 6, 7);
                    oT[it][0] = MFMA16(Sb0, yq, oT[it][0]); oT[it][1] = MFMA16(Sb1, yq, oT[it][1]);
                }
            }
#pragma unroll
            for (int it = 0; it < 4; ++it) {
                float ss = 0.f;
#pragma unroll
                for (int dvt = 0; dvt < 2; ++dvt)
#pragma unroll
                    for (int r = 0; r < 4; ++r) ss += oT[it][dvt][r] * oT[it][dvt][r];
                ss += shfl_xor_l(ss, 16, lane); ss += shfl_xor_l(ss, 32, lane);
                if (fq == 0) SSQ[wid * 64 + 16 * it + fr] = ss;
            }
            __syncthreads();
            int r0o = r0; asm volatile("" : "+s"(r0o));
#pragma unroll
            for (int it = 0; it < 4; ++it) {
                const int tok = 16 * it + fr; float tss = 0.f;
#pragma unroll
                for (int w = 0; w < 8; ++w) tss += SSQ[w * 64 + tok];
                const float rstd = rsqrtf(tss * (1.0f / 256.0f) + EPS);
                if (tok < nvalid) {
#pragma unroll
                    for (int dvt = 0; dvt < 2; ++dvt) { const int dv0 = dvb + 16 * dvt + 4 * fq; const size_t row = (size_t)(r0o + tok);
                        const u32x2 g4 = *(const u32x2*)(PA + row * PA_LD + 2560 + h * 256 + dv0); const f32x4 gn = *(const f32x4*)(gnorm + dv0);
                        const f32x4 o = oT[it][dvt]; u32x2 w;
                        w.x = pk2(o[0] * rstd * gn[0] * silu_f(bf_lo(g4.x)), o[1] * rstd * gn[1] * silu_f(bf_hi(g4.x)));
                        w.y = pk2(o[2] * rstd * gn[2] * silu_f(bf_lo(g4.y)), o[3] * rstd * gn[3] * silu_f(bf_hi(g4.y)));
                        *(u32x2*)(ACAT + row * KCAT + 512 + h * 256 + dv0) = w; }
                }
            }
        }
#pragma unroll
        for (int kt = 0; kt < 8; ++kt) { const f32x4 gl = *(const LAS f32x4*)(GL + 16 * kt + 4 * fq); S[kt][0] *= gl; S[kt][1] *= gl; }
#pragma unroll
        for (int ks = 0; ks < 2; ++ks) {
            const bf16x8 yv0 = *(const LAS bf16x8*)(lds + G_VT + (dvb + fr) * 144 + (32 * ks + 8 * fq) * 2);
            const bf16x8 yv1 = *(const LAS bf16x8*)(lds + G_VT + (dvb + 16 + fr) * 144 + (32 * ks + 8 * fq) * 2);
#pragma unroll
            for (int kt = 0; kt < 8; ++kt) { const bf16x8 xk = *(const LAS bf16x8*)(lds + G_KPT + (16 * kt + fr) * 144 + (32 * ks + 8 * fq) * 2);
                S[kt][0] = MFMA16(xk, yv0, S[kt][0]); S[kt][1] = MFMA16(xk, yv1, S[kt][1]); }
        }
    }
    if (Sout) {
        int l2 = lane; asm volatile("" : "+v"(l2)); const int fr2 = l2 & 15, fq2 = l2 >> 4;
#pragma unroll
        for (int kt = 0; kt < 8; ++kt)
#pragma unroll
            for (int dvt = 0; dvt < 2; ++dvt)
#pragma unroll
                for (int r = 0; r < 4; ++r) Sout[(size_t)(16 * kt + 4 * fq2 + r) * 256 + dvb + 16 * dvt + fr2] = S[kt][dvt][r];
    }
    if (Gout && tq == 0) Gout[dk] = __expf(gsum);
}

__device__ __forceinline__ void norm_row_bf16(const float* xrow, const float* g, const float* shift, const float* scale, bf16* orow, int lane) {
    const f32x4* xr = (const f32x4*)xrow + lane; f32x4 v[4]; float s = 0.f;
#pragma unroll
    for (int j = 0; j < 4; ++j) { v[j] = xr[64 * j]; s += (v[j][0] * v[j][0] + v[j][1] * v[j][1]) + (v[j][2] * v[j][2] + v[j][3] * v[j][3]); }
    const float rstd = rsqrtf(wave_sum(s, lane) * (1.0f / DM) + EPS);
#pragma unroll
    for (int j = 0; j < 4; ++j) { const int c = 4 * lane + 256 * j; const f32x4 gg = *(const f32x4*)(g + c), sh = *(const f32x4*)(shift + c), sc = *(const f32x4*)(scale + c);
        const f32x4 o = v[j] * rstd * gg * (1.0f + sc) + sh;
        u32x2 w; w.x = pk2(o[0], o[1]); w.y = pk2(o[2], o[3]); *(u32x2*)(orow + c) = w; }
}

__global__ void __launch_bounds__(512, 2) fwd_kernel(Args a) {
    extern __shared__ __attribute__((aligned(16))) unsigned char lds_raw[];
    cg::grid_group grid = cg::this_grid();
    LAS unsigned char* lds = (LAS unsigned char*)lds_raw;
    const int wave = __builtin_amdgcn_readfirstlane((int)threadIdx.x >> 6);
    const int G = gridDim.x, blk = blockIdx.x, gw = blk * 8 + wave, NGW = G * 8;
#define FRESH_TID() const __attribute__((address_space(4))) Args* ap = (const __attribute__((address_space(4))) Args*)__builtin_amdgcn_kernarg_segment_ptr(); asm volatile("" : "+s"(ap)); int tid = lane_id_fresh() + 64 * wave; const int lane = tid & 63; (void)lane; (void)tid
#define ws (ap->ws)
#define out (ap->out)
#define x_prompt (ap->in[0])
#define x_sample (ap->in[1])
#define c_prompt (ap->in[2])
#define c_sample (ap->in[3])
#define state_gla (ap->in[4])
#define cache_pool (ap->in[5])
#define w_ada (ap->in[6])
#define b_ada (ap->in[7])
#define norm1_g (ap->in[8])
#define w_in (ap->in[9])
#define w_alpha (ap->in[10])
#define b_alpha (ap->in[11])
#define w_pool (ap->in[12])
#define pool_scale (ap->in[13])
#define gla_norm_g (ap->in[14])
#define w_pa (ap->in[15])
#define w_pb (ap->in[16])
#define w_out (ap->in[17])
#define norm2_g (ap->in[18])
#define w_ff1 (ap->in[19])
#define w_ff2 (ap->in[20])
#define final_g (ap->in[21])
#define MOD ((float*)(ws + WS_MOD))
#define ALR ((float*)(ws + WS_ALR))
#define GT ((float*)(ws + WS_GT))
#define Win_t ((bf16*)(ws + WS_WIN))
#define Wcat_t ((bf16*)(ws + WS_WCAT))
#define Wout_t ((bf16*)(ws + WS_WOUT))
#define Wff1_t ((bf16*)(ws + WS_WFF1))
#define Wff2_t ((bf16*)(ws + WS_WFF2))
#define PB ((bf16*)(ws + WS_PB))
#define PA ((bf16*)(ws + WS_PA))
#define US ((float*)(ws + WS_US))
#define MODP ((float*)(ws + WS_US))
#define H ((bf16*)out)
#define ACAT ((bf16*)out)
#define H2 ((bf16*)(ws + WS_PB))
#define MERGED ((bf16*)(ws + WS_PA))
#define HID ((bf16*)(ws + WS_PA))
#define Y (out + O_Y)

    {
        FRESH_TID();
        LAS float* scr = (LAS float*)(lds + wave * 16384);
        constexpr int I_IN = 16 * 184, I_PB = 16 * 32, I_OUT = 16 * 32, I_F1 = 16 * 128, I_F2 = 64 * 32, I_WA = 1024, I_MOD = 96 * 16;
        constexpr int NITEMS = I_MOD + I_IN + I_PB + I_OUT + I_F1 + I_F2 + I_WA;
        for (int it = gw; it < NITEMS; it += NGW) {
            int r = it;
            if (r < I_MOD) {
                const int cgp = r % 96, ks = r / 96, k0 = 64 * ks, n = 64 * cgp + lane;
#pragma unroll 1
                for (int rr = 0; rr < NROWS_MOD; ++rr) { const float cv = rr == 0 ? c_prompt[k0 + lane] : c_sample[(size_t)(rr - 1) * DM + k0 + lane]; scr[rr * 64 + lane] = silu_f(cv); }
                asm volatile("s_waitcnt lgkmcnt(0)" ::: "memory");
                float acc[NROWS_MOD];
#pragma unroll
                for (int rr = 0; rr < NROWS_MOD; ++rr) acc[rr] = 0.f;
#pragma unroll 4
                for (int kk = 0; kk < 64; ++kk) { const float w = w_ada[(size_t)(k0 + kk) * NMOD + n];
#pragma unroll
                    for (int rr = 0; rr < NROWS_MOD; ++rr) acc[rr] += scr[rr * 64 + kk] * w; }
#pragma unroll
                for (int rr = 0; rr < NROWS_MOD; ++rr) MODP[((size_t)ks * NROWS_MOD + rr) * NMOD + n] = acc[rr];
                asm volatile("s_waitcnt lgkmcnt(0)" ::: "memory");
                continue;
            }
            r -= I_MOD;
            if (r < I_IN) { const int kb = r / 184, nb = r % 184; int c0, valid;
                if (nb < 112) { c0 = 32 * nb; valid = 32; } else if (nb < 176) { c0 = 32 * nb + 16; valid = 32; } else if (nb == 176) { c0 = 3584; valid = 16; } else { c0 = 0; valid = 0; }
                transpose_item(w_in, 5648, 64 * kb, c0, valid, Win_t, DM, 32 * nb, 0, scr, lane); continue; }
            r -= I_IN;
            if (r < I_PB) { transpose_item(w_pb, DM, 64 * (r / 32), 32 * (r % 32), 32, Wcat_t, KCAT, 32 * (r % 32), 512, scr, lane); continue; }
            r -= I_PB;
            if (r < I_OUT) { transpose_item(w_out, DM, 64 * (r / 32), 32 * (r % 32), 32, Wout_t, DM, 32 * (r % 32), 0, scr, lane); continue; }
            r -= I_OUT;
            if (r < I_F1) { transpose_item(w_ff1, DFF, 64 * (r / 128), 32 * (r % 128), 32, Wff1_t, DM, 32 * (r % 128), 0, scr, lane); continue; }
            r -= I_F1;
            if (r < I_F2) { transpose_item(w_ff2, DM, 64 * (r / 32), 32 * (r % 32), 32, Wff2_t, DFF, 32 * (r % 32), 0, scr, lane); continue; }
            r -= I_F2;
            {
                const int g = r >> 8, cb = (r >> 4) & 15, nb = r & 15, n = 64 * nb + lane, c0 = 8 * cb;
                float acc[8];
#pragma unroll
                for (int cc = 0; cc < 8; ++cc) acc[cc] = 0.f;
#pragma unroll 4
                for (int d = 0; d < 128; ++d) { const float wp = w_pa[(size_t)(g * 128 + d) * DM + n] * pool_scale[g * 128 + d];
#pragma unroll
                    for (int cc = 0; cc < 8; ++cc) acc[cc] += w_pool[(size_t)(g * 128 + c0 + cc) * 128 + d] * wp; }
                u32x4 o; o.x = pk2(acc[0], acc[1]); o.y = pk2(acc[2], acc[3]); o.z = pk2(acc[4], acc[5]); o.w = pk2(acc[6], acc[7]);
                *(u32x4*)(Wcat_t + (size_t)n * KCAT + g * 128 + c0) = o;
            }
        }
    }
    grid.sync();
    { FRESH_TID();
    for (int i = blk * 512 + tid; i < NROWS_MOD * NMOD; i += G * 512) { float s = b_ada[i % NMOD];
#pragma unroll
        for (int ks = 0; ks < 16; ++ks) s += MODP[(size_t)ks * NROWS_MOD * NMOD + i];
        MOD[i] = s; } }
    grid.sync();
    { FRESH_TID();
    for (int m = gw; m < MT; m += NGW) { const int seq = m < MP ? 0 : 1 + ((m - MP) >> 4); const float* xr = m < MP ? x_prompt + (size_t)m * DM : x_sample + (size_t)(m - MP) * DM;
        norm_row_bf16(xr, norm1_g, MOD + (size_t)seq * NMOD, MOD + (size_t)seq * NMOD + 1024, H + (size_t)m * DM, lane); } }
    grid.sync();
    {
        FRESH_TID();
        pg8::Gemm g{H, Win_t, MT, NIN, DM}; pg8::StaticOrder S; S.init(MT, NIN, G, blk);
        pg8::EpiProj E{PA, PB, ALR};
        pg8::gemm_phase<pg8::EpiProj, pg8::StaticOrder, true, true>(lds, g, S, E, wave);
    }
    grid.sync();
    {
        FRESH_TID();
        for (int u = blk; u < NSC * 4; u += G) { const int sc2 = u >> 2, h2 = u & 3;
            gla_unit<false>(lds, tid, sc2 * 256, 4, 64, h2, PA, ALR, w_alpha, b_alpha, gla_norm_g, nullptr, US + (size_t)u * 32768, GT + (size_t)u * 128, ACAT); }
        for (int u = (G - 1 - blk); u < NSEQ * 4; u += G) { const int s = u >> 2, h = u & 3;
            gla_unit<true>(lds, tid, MP + s * 16, 1, 16, h, PA, ALR, w_alpha, b_alpha, gla_norm_g, state_gla + (size_t)u * 32768, out + O_SGS + (size_t)u * 32768, nullptr, ACAT); }
        for (int pt = blk; pt < MT / 16; pt += G) {
            const int rowb = pt * 16, c = tid, gi = c >> 7, w = 2 << gi; const bool samp = rowb >= MP; const int seq = samp ? (rowb - MP) >> 4 : 0;
            float sum = 0.f;
            for (int j = 1 - w; j < 0; ++j) { float e;
                if (samp) e = cache_pool[((size_t)seq * 15 + (15 + j)) * 512 + c]; else e = (rowb + j >= 0) ? bf2f(PA[(size_t)(rowb + j) * PA_LD + c]) : 0.f;
                sum += e; }
#pragma unroll 4
            for (int tl = 0; tl < 16; ++tl) { const int row = rowb + tl; const float ut = bf2f(PA[(size_t)row * PA_LD + c]);
                sum += ut;
                const float cnt = samp ? (float)w : (float)((row + 1) < w ? (row + 1) : w);
                ACAT[(size_t)row * KCAT + c] = (bf16)f2bf(sum / cnt - ut);
                const int j = tl - w + 1; float e;
                if (j >= 0) e = bf2f(PA[(size_t)(rowb + j) * PA_LD + c]); else if (samp) e = cache_pool[((size_t)seq * 15 + (15 + j)) * 512 + c]; else e = (rowb + j >= 0) ? bf2f(PA[(size_t)(rowb + j) * PA_LD + c]) : 0.f;
                sum -= e;
                if (samp) { if (tl >= 1) out[O_CPS + ((size_t)seq * 15 + (tl - 1)) * 512 + c] = ut; }
                else if (row >= MP - 15) out[O_CPP + (size_t)(row - (MP - 15)) * 512 + c] = ut; }
        }
    }
    grid.sync();
    { FRESH_TID();
    for (int e = blk * 512 + tid; e < 131072; e += G * 512) { float S = 0.f; const int hd = e >> 8;
#pragma unroll 16
        for (int sc = 0; sc < NSC; ++sc) { const float u = US[(size_t)sc * 131072 + e]; US[(size_t)sc * 131072 + e] = S; S = GT[sc * 512 + hd] * S + u; }
        out[O_SGP + e] = S; } }
    grid.sync();
    { FRESH_TID();
    for (int u = blk; u < NSC * 4; u += G) { const int sc = u >> 2, h = u & 3;
        gla_unit<true>(lds, tid, sc * 256, 4, 64, h, PA, ALR, w_alpha, b_alpha, gla_norm_g, US + (size_t)u * 32768, nullptr, nullptr, ACAT); } }
    grid.sync();
    {
        FRESH_TID();
        pg8::Gemm g{ACAT, Wcat_t, MT, DM, KCAT}; pg8::StaticOrder S; S.init(MT, DM, G, blk);
        pg8::EpiMerge E{PB, MERGED};
        pg8::gemm_phase<pg8::EpiMerge, pg8::StaticOrder, true, true>(lds, g, S, E, wave);
    }
    grid.sync();
    {
        FRESH_TID();
        pg8::Gemm g{MERGED, Wout_t, MT, DM, DM}; pg8::StaticOrder S; S.init(MT, DM, G, blk);
        pg8::EpiRes<false> E{x_prompt, x_sample, Y, MOD + 2048};
        pg8::gemm_phase<pg8::EpiRes<false>, pg8::StaticOrder, true, true>(lds, g, S, E, wave);
    }
    grid.sync();
    { FRESH_TID();
    for (int m = gw; m < MT; m += NGW) { const int seq = m < MP ? 0 : 1 + ((m - MP) >> 4);
        norm_row_bf16(Y + (size_t)m * DM, norm2_g, MOD + (size_t)seq * NMOD + 3072, MOD + (size_t)seq * NMOD + 4096, H2 + (size_t)m * DM, lane); } }
    grid.sync();
    {
        FRESH_TID();
        pg8::Gemm g{H2, Wff1_t, MT, DFF, DM}; pg8::StaticOrder S; S.init(MT, DFF, G, blk);
        pg8::EpiRelu2 E{HID};
        pg8::gemm_phase<pg8::EpiRelu2, pg8::StaticOrder, true, true>(lds, g, S, E, wave);
    }
    grid.sync();
    {
        FRESH_TID();
        pg8::Gemm g{HID, Wff2_t, MT, DM, DFF}; pg8::StaticOrder S; S.init(MT, DM, G, blk);
        pg8::EpiRes<true> E{nullptr, nullptr, Y, MOD + 5120};
        pg8::gemm_phase<pg8::EpiRes<true>, pg8::StaticOrder, true, true>(lds, g, S, E, wave);
    }
    grid.sync();
    { FRESH_TID();
    for (int m = gw; m < MT; m += NGW) { f32x4* xr = (f32x4*)(Y + (size_t)m * DM) + lane; f32x4 v[4]; float s = 0.f;
#pragma unroll
        for (int j = 0; j < 4; ++j) { v[j] = xr[64 * j]; s += (v[j][0] * v[j][0] + v[j][1] * v[j][1]) + (v[j][2] * v[j][2] + v[j][3] * v[j][3]); }
        const float rstd = rsqrtf(wave_sum(s, lane) * (1.0f / DM) + EPS);
#pragma unroll
        for (int j = 0; j < 4; ++j) { const f32x4 gg = *(const f32x4*)(final_g + 4 * lane + 256 * j); xr[64 * j] = v[j] * rstd * gg; } } }
}

#undef ws
#undef out
#undef x_prompt
#undef x_sample
#undef c_prompt
#undef c_sample
#undef state_gla
#undef cache_pool
#undef w_ada
#undef b_ada
#undef norm1_g
#undef w_in
#undef w_alpha
#undef b_alpha
#undef w_pool
#undef pool_scale
#undef gla_norm_g
#undef w_pa
#undef w_pb
#undef w_out
#undef norm2_g
#undef w_ff1
#undef w_ff2
#undef final_g
#undef MOD
#undef ALR
#undef GT
#undef Win_t
#undef Wcat_t
#undef Wout_t
#undef Wff1_t
#undef Wff2_t
#undef PB
#undef PA
#undef US
#undef MODP
#undef H
#undef ACAT
#undef H2
#undef MERGED
#undef HID
#undef Y
extern "C" void kernel_launch(void* const* d_in, const int* in_sizes, int n_in, void* d_out, int out_size, void* d_ws, size_t ws_size, hipStream_t stream) {
    static int grid = 0;
    if (grid == 0) {
        if (n_in != 22 || ws_size < WS_END) { fprintf(stderr, "kernel_launch: unexpected n_in %d / ws %zu\n", n_in, ws_size); grid = -1; return; }
        int dev = 0, cus = 0, per_cu = 0;
        hipGetDevice(&dev); hipDeviceGetAttribute(&cus, hipDeviceAttributeMultiprocessorCount, dev);
        if (hipFuncSetAttribute((const void*)fwd_kernel, hipFuncAttributeMaxDynamicSharedMemorySize, LDS_BYTES) != hipSuccess) { fprintf(stderr, "kernel_launch: hipFuncSetAttribute failed\n"); grid = -1; return; }
        if (hipOccupancyMaxActiveBlocksPerMultiprocessor(&per_cu, (const void*)fwd_kernel, 512, LDS_BYTES) != hipSuccess || per_cu < 1) { fprintf(stderr, "kernel_launch: occupancy query says %d\n", per_cu); per_cu = 1; }
        (void)hipGetLastError();
        grid = cus * 1;
    }
    if (grid < 0) return;
    Args a{};
    for (int i = 0; i < 22; ++i) a.in[i] = (const float*)d_in[i];
    a.out = (float*)d_out; a.ws = (unsigned char*)d_ws;
    void* args[] = {&a};
    hipError_t e = hipLaunchCooperativeKernel((const void*)fwd_kernel, dim3(grid), dim3(512), args, LDS_BYTES, stream);
    if (e != hipSuccess) fprintf(stderr, "kernel_launch: cooperative launch failed: %s (grid %d)\n", hipGetErrorString(e), grid);
}
```

```cpp
#include <hip/hip_runtime.h>
#include <hip/hip_cooperative_groups.h>
#include <cstdio>
#include <cstdint>
namespace cg = cooperative_groups;
__device__ __forceinline__ int lane_id_fresh() { int l; asm volatile("v_mbcnt_lo_u32_b32 %0, -1, 0\n\tv_mbcnt_hi_u32_b32 %0, -1, %0" : "=v"(l)); return l; }
__device__ __forceinline__ float shfl_xor_l(float v, int o, int lane) { return __int_as_float(__builtin_amdgcn_ds_bpermute((lane ^ o) << 2, __float_as_int(v))); }
__device__ __forceinline__ float bf_lo(unsigned w) { return __uint_as_float(w << 16); }
__device__ __forceinline__ float bf_hi(unsigned w) { return __uint_as_float(w & 0xffff0000u); }
__device__ __forceinline__ float sigm(float x) { return 1.0f / (1.0f + __expf(-x)); }
namespace pg8 {
#define PG8_LAS __attribute__((address_space(3)))
typedef unsigned short bf16_t;
typedef short bf16x8 __attribute__((ext_vector_type(8)));
typedef float f32x4 __attribute__((ext_vector_type(4)));
typedef unsigned u32x4 __attribute__((ext_vector_type(4)));
constexpr int BM = 256, BK = 64, HALF = 128, HTB = HALF * BK * 2  , STAGE_BYTES = 8 * HTB, NXCD = 8, WGM = 8;

__host__ __device__ __forceinline__ int lds_byte(int r, int c) { const int st = (r >> 4) * 2 + (c >> 5), rr = r & 15, cc = c & 31, ob = rr * 64 + cc * 2; return st * 1024 + (ob ^ (((ob >> 9) & 1) << 5)); }
__host__ __device__ __forceinline__ void stage_rc(int b, int& R, int& C) { const int st = b / 1024, sb = b % 1024, swz = sb ^ (((sb >> 9) & 1) << 5); R = (st >> 1) * 16 + swz / 64; C = (st & 1) * 32 + (swz % 64) / 2; }
__host__ __device__ __forceinline__ int perm32(int rho) { const int n = rho >> 4, i = rho & 15; return 8 * (i >> 2) + 4 * n + (i & 3); }

struct Unit { int pm, pn; };
struct Gemm { const bf16_t* A; const bf16_t* Bt; int M, N, K; };

struct StaticOrder {
    int nM, nN, nwg, G, c;
    __host__ __device__ void init(int M, int N, int G_, int c_) { nM = M / BM; nN = N / BM; nwg = nM * nN; G = G_; c = c_; }
    __host__ __device__ bool next(int i, Unit& u) const {
        const long L = (long)i * G + c; if (L >= nwg) return false;
        int wgid = (int)L; { const int q = nwg / NXCD, r = nwg % NXCD, xcd = wgid % NXCD, off = wgid / NXCD; wgid = (xcd < r ? xcd * (q + 1) : r * (q + 1) + (xcd - r) * q) + off; }
        const int nig = WGM * nN, gid = wgid / nig, fm = gid * WGM, gsz = (nM - fm) < WGM ? (nM - fm) : WGM;
        u.pm = fm + ((wgid % nig) % gsz); u.pn = (wgid % nig) / gsz; return true;
    }
    __device__ __forceinline__ void a_ready(const Unit&) const {}
    __device__ __forceinline__ void done(const Unit&) const {}
};

__device__ __forceinline__ unsigned cvt_pk_bf16(float lo, float hi) { unsigned r; asm volatile("v_cvt_pk_bf16_f32 %0, %1, %2" : "=v"(r) : "v"(lo), "v"(hi)); return r; }
template <class Epi, class Sched, bool ALIGN_EPI = false, bool SP2 = false>
__device__ __forceinline__ void gemm_phase(PG8_LAS unsigned char* lds, const Gemm g, const Sched& S, const Epi& E, const int wave_id) {
    int tid_ = lane_id_fresh() + 64 * wave_id;
    const int tid = tid_, wid = __builtin_amdgcn_readfirstlane(tid >> 6), lane = tid & 63, wr = wid >> 2, wc = wid & 3, fr = lane & 15, fq = lane >> 4;
    const int K = g.K, nt = K / BK;
    unsigned voffA[2], voffB[2];
#pragma unroll
    for (int i = 0; i < 2; ++i) { int R, C; stage_rc(tid * 16 + i * 8192, R, C); const int Rb = Epi::PERM ? ((R & ~31) + perm32(R & 31)) : R;
        voffA[i] = (unsigned)(R * K + C) * 2u; voffB[i] = (unsigned)(Rb * K + C) * 2u; }
    const size_t kstep = (size_t)(BK * 2);
    const size_t hstep = (size_t)HALF * K * 2;
    const size_t tstep = 2 * hstep;
    const unsigned ldsw = (unsigned)wid * 1024u;
    const int aoff = lds_byte(wr * 64 + fr, fq * 8), boff = lds_byte(wc * 32 + fr, fq * 8);
#define PG8_SA(b, h) (((b) * 2 + (h)) * HTB)
#define PG8_SB(b, h) ((4 + (b) * 2 + (h)) * HTB)
#define PG8_STAGE(bufoff, gbase, voff) do { _Pragma("unroll") for (int _i = 0; _i < 2; ++_i) \
        __builtin_amdgcn_global_load_lds((const unsigned*)((const char*)(gbase) + (voff)[_i]), (PG8_LAS unsigned*)(lds + (bufoff) + ldsw + _i * 8192), 16, 0, 0); } while (0)
#define PG8_LDA(dst, b, h) do { _Pragma("unroll") for (int m = 0; m < 4; ++m) _Pragma("unroll") for (int k = 0; k < 2; ++k) dst[m][k] = *(const PG8_LAS bf16x8*)(lds + PG8_SA(b, h) + aoff + m * 2048 + k * 1024); } while (0)
#define PG8_LDB(dst, b, h) do { _Pragma("unroll") for (int n = 0; n < 2; ++n) _Pragma("unroll") for (int k = 0; k < 2; ++k) dst[n][k] = *(const PG8_LAS bf16x8*)(lds + PG8_SB(b, h) + boff + n * 2048 + k * 1024); } while (0)
#define PG8_MMA(ai, bj, At, Bt) do { __builtin_amdgcn_s_setprio(1); _Pragma("unroll") for (int m = 0; m < 4; ++m) _Pragma("unroll") for (int n = 0; n < 2; ++n) _Pragma("unroll") for (int k = 0; k < 2; ++k) \
        acc[ai][bj][m][n] = __builtin_amdgcn_mfma_f32_16x16x32_bf16(Bt[n][k], At[m][k], acc[ai][bj][m][n], 0, 0, 0); __builtin_amdgcn_s_setprio(0); } while (0)
#define PG8_WAIT_V(n) asm volatile("s_waitcnt vmcnt(" #n ")" ::: "memory")
#define PG8_WAIT_L(n) asm volatile("s_waitcnt lgkmcnt(" #n ")" ::: "memory")
#define PG8_BAR __builtin_amdgcn_s_barrier()
#define PG8_SCHED __builtin_amdgcn_sched_barrier(0)
    Unit cur, nxt; int ui = 0;
    if (!S.next(0, cur)) return;
    f32x4 acc[2][2][4][2];
#pragma unroll
    for (int a = 0; a < 2; ++a)
#pragma unroll
        for (int b = 0; b < 2; ++b)
#pragma unroll
            for (int m = 0; m < 4; ++m)
#pragma unroll
                for (int n = 0; n < 2; ++n) acc[a][b][m][n] = (f32x4){0.f, 0.f, 0.f, 0.f};
    bf16x8 At[4][2], B0[2][2], B1[2][2];
    const char* cA = (const char*)g.A + (size_t)cur.pm * tstep; const char* cB = (const char*)g.Bt + (size_t)cur.pn * tstep;
    S.a_ready(cur);
    if constexpr (SP2) {
        PG8_STAGE(PG8_SB(0, 0), cB, voffB); PG8_STAGE(PG8_SB(0, 1), cB + hstep, voffB); PG8_STAGE(PG8_SA(0, 0), cA, voffA); PG8_STAGE(PG8_SA(0, 1), cA + hstep, voffA);
        if (wr == 1) PG8_BAR;
        PG8_WAIT_V(2); PG8_BAR;
        PG8_STAGE(PG8_SB(1, 0), cB + kstep, voffB); PG8_STAGE(PG8_SA(1, 0), cA + kstep, voffA); PG8_STAGE(PG8_SB(1, 1), cB + hstep + kstep, voffB);
        PG8_WAIT_V(6); PG8_BAR;
    } else {
        PG8_STAGE(PG8_SB(0, 0), cB, voffB); PG8_STAGE(PG8_SA(0, 0), cA, voffA); PG8_STAGE(PG8_SB(0, 1), cB + hstep, voffB); PG8_STAGE(PG8_SA(0, 1), cA + hstep, voffA);
        if (wr == 1) PG8_BAR;
        PG8_WAIT_V(4); PG8_BAR;
        PG8_STAGE(PG8_SB(1, 0), cB + kstep, voffB); PG8_STAGE(PG8_SA(1, 0), cA + kstep, voffA); PG8_STAGE(PG8_SB(1, 1), cB + hstep + kstep, voffB);
        PG8_WAIT_V(6); PG8_BAR;
    }
    for (;;) {
        const bool has_next = S.next(ui + 1, nxt);
        const char* nA = has_next ? (const char*)g.A + (size_t)nxt.pm * tstep : cA; const char* nB = has_next ? (const char*)g.Bt + (size_t)nxt.pn * tstep : cB;
        for (int t = 0; t < nt; t += 2) {
            if constexpr (Epi::MID_T > 0) { if (t == Epi::MID_T) E.mid(acc, cur, wr, wc, fr, fq); }
            const bool last = (t == nt - 2);
            const char* a1 = cA + (size_t)(t + 1) * kstep;
            const char* a2 = last ? nA : cA + (size_t)(t + 2) * kstep; const char* b2 = last ? nB : cB + (size_t)(t + 2) * kstep;
            const char* a3 = a2 + kstep; const char* b3 = b2 + kstep;
            if (last && has_next) S.a_ready(nxt);
            if constexpr (SP2) {
            PG8_LDB(B0, 0, 0); PG8_LDB(B1, 0, 1); PG8_SCHED; PG8_LDA(At, 0, 0); PG8_STAGE(PG8_SA(1, 1), a1 + hstep, voffA);
            PG8_WAIT_V(8); PG8_WAIT_L(0); PG8_BAR; PG8_MMA(0, 0, At, B0); PG8_MMA(0, 1, At, B1); PG8_BAR; PG8_SCHED;
            PG8_LDA(At, 0, 1); PG8_STAGE(PG8_SB(0, 0), b2, voffB); PG8_STAGE(PG8_SB(0, 1), b2 + hstep, voffB); PG8_STAGE(PG8_SA(0, 0), a2, voffA);
            PG8_WAIT_V(8); PG8_WAIT_L(0); PG8_BAR; PG8_MMA(1, 0, At, B0); PG8_MMA(1, 1, At, B1); PG8_BAR; PG8_SCHED;
            PG8_LDB(B0, 1, 0); PG8_LDB(B1, 1, 1); PG8_SCHED; PG8_LDA(At, 1, 0); PG8_STAGE(PG8_SA(0, 1), a2 + hstep, voffA);
            PG8_WAIT_V(8); PG8_WAIT_L(0); PG8_BAR; PG8_MMA(0, 0, At, B0); PG8_MMA(0, 1, At, B1); PG8_BAR; PG8_SCHED;
            PG8_LDA(At, 1, 1); PG8_STAGE(PG8_SB(1, 0), b3, voffB); PG8_STAGE(PG8_SB(1, 1), b3 + hstep, voffB); PG8_STAGE(PG8_SA(1, 0), a3, voffA);
            PG8_WAIT_V(8); PG8_WAIT_L(0); PG8_BAR; PG8_MMA(1, 0, At, B0); PG8_MMA(1, 1, At, B1); PG8_BAR; PG8_SCHED;
            } else {
            PG8_LDB(B0, 0, 0); PG8_SCHED; PG8_LDA(At, 0, 0); PG8_STAGE(PG8_SA(1, 1), a1 + hstep, voffA);
            PG8_WAIT_L(8); PG8_BAR; PG8_WAIT_L(0); PG8_MMA(0, 0, At, B0); PG8_BAR; PG8_SCHED;
            PG8_LDB(B1, 0, 1); PG8_STAGE(PG8_SB(0, 0), b2, voffB);
            PG8_BAR; PG8_WAIT_L(0); PG8_MMA(0, 1, At, B1); PG8_BAR;
            PG8_LDA(At, 0, 1); PG8_STAGE(PG8_SA(0, 0), a2, voffA);
            PG8_BAR; PG8_WAIT_L(0); PG8_MMA(1, 0, At, B0); PG8_BAR; PG8_SCHED;
            PG8_STAGE(PG8_SB(0, 1), b2 + hstep, voffB);
            PG8_WAIT_V(6); PG8_BAR; PG8_MMA(1, 1, At, B1); PG8_BAR;
            PG8_LDB(B0, 1, 0); PG8_SCHED; PG8_LDA(At, 1, 0); PG8_STAGE(PG8_SA(0, 1), a2 + hstep, voffA);
            PG8_WAIT_L(8); PG8_BAR; PG8_WAIT_L(0); PG8_MMA(0, 0, At, B0); PG8_BAR; PG8_SCHED;
            PG8_LDB(B1, 1, 1); PG8_STAGE(PG8_SB(1, 0), b3, voffB);
            PG8_BAR; PG8_WAIT_L(0); PG8_MMA(0, 1, At, B1); PG8_BAR;
            PG8_LDA(At, 1, 1); PG8_STAGE(PG8_SA(1, 0), a3, voffA);
            PG8_BAR; PG8_WAIT_L(0); PG8_MMA(1, 0, At, B0); PG8_BAR; PG8_SCHED;
            PG8_STAGE(PG8_SB(1, 1), b3 + hstep, voffB);
            PG8_WAIT_V(6); PG8_BAR; PG8_MMA(1, 1, At, B1); PG8_BAR;
            }
        }
        if constexpr (ALIGN_EPI) { if (wr == 0) PG8_BAR; }
        if constexpr (!Epi::AFTER_DRAIN) { E(acc, cur, wr, wc, fr, fq); S.done(cur); }
        if (!has_next) break;
#pragma unroll
        for (int a = 0; a < 2; ++a)
#pragma unroll
            for (int b = 0; b < 2; ++b)
#pragma unroll
                for (int m = 0; m < 4; ++m)
#pragma unroll
                    for (int n = 0; n < 2; ++n) acc[a][b][m][n] = (f32x4){0.f, 0.f, 0.f, 0.f};
        cur = nxt; cA = nA; cB = nB; ++ui;
        if constexpr (ALIGN_EPI) { if (wr == 1) PG8_BAR; }
    }
    PG8_WAIT_V(0);
    if constexpr (!ALIGN_EPI) { if (wr == 0) PG8_BAR; }
    PG8_BAR;
    if constexpr (Epi::AFTER_DRAIN) { E.fused(acc, cur, wr, wc, fr, fq, lds, wid, lane); S.done(cur); }
#undef PG8_SA
#undef PG8_SB
#undef PG8_STAGE
#undef PG8_LDA
#undef PG8_LDB
#undef PG8_MMA
#undef PG8_WAIT_V
#undef PG8_WAIT_L
#undef PG8_BAR
#undef PG8_SCHED
}


constexpr int MP_ROWS = 16384;

struct EpiProj {
    static constexpr bool PERM = true, AFTER_DRAIN = false; static constexpr int MID_T = 0;
    bf16_t* PA; bf16_t* PB; float* ALR;
    __device__ __forceinline__ void mid(f32x4 (&)[2][2][4][2], const Unit&, int, int, int, int) const {}
    __device__ __forceinline__ void operator()(const f32x4 (&acc)[2][2][4][2], const Unit& u, int wr, int wc, int fr, int fq) const {
        const int row0 = u.pm * BM + wr * 64 + fr;
        if (u.pn < 22) {
            bf16_t* base; int ldc, colt;
            if (u.pn < 14) { base = PA; ldc = 3584; colt = u.pn * BM; } else { base = PB; ldc = 2048; colt = (u.pn - 14) * BM; }
            const int col0 = colt + wc * 32 + 8 * fq;
#pragma unroll
            for (int ai = 0; ai < 2; ++ai)
#pragma unroll
                for (int m = 0; m < 4; ++m) { bf16_t* rowp = base + (size_t)(row0 + ai * HALF + m * 16) * ldc + col0;
#pragma unroll
                    for (int bj = 0; bj < 2; ++bj) { const f32x4 v0 = acc[ai][bj][m][0], v1 = acc[ai][bj][m][1];
                        u32x4 w; w.x = cvt_pk_bf16(v0[0], v0[1]); w.y = cvt_pk_bf16(v0[2], v0[3]); w.z = cvt_pk_bf16(v1[0], v1[1]); w.w = cvt_pk_bf16(v1[2], v1[3]);
                        *(u32x4*)(rowp + bj * HALF) = w; } }
        } else if (wc == 0 && fq < 2) {
#pragma unroll
            for (int ai = 0; ai < 2; ++ai)
#pragma unroll
                for (int m = 0; m < 4; ++m) { float* p = ALR + (size_t)(row0 + ai * HALF + m * 16) * 16 + 8 * fq;
                    *(f32x4*)p = acc[ai][0][m][0]; *(f32x4*)(p + 4) = acc[ai][0][m][1]; }
        }
    }
};
struct EpiMerge {
    static constexpr bool PERM = true, AFTER_DRAIN = false; static constexpr int MID_T = 8;
    const bf16_t* PB; bf16_t* O;
    __device__ __forceinline__ void mid(f32x4 (&acc)[2][2][4][2], const Unit& u, int wr, int wc, int fr_, int fq) const {
        int fr = fr_; asm volatile("" : "+v"(fr));
        const int row0 = u.pm * BM + wr * 64 + fr, col0 = u.pn * BM + wc * 32 + 8 * fq;
#pragma unroll
        for (int ai = 0; ai < 2; ++ai)
#pragma unroll
            for (int m = 0; m < 4; ++m) { const bf16_t* gp = PB + (size_t)(row0 + ai * HALF + m * 16) * 2048 + col0;
#pragma unroll
                for (int bj = 0; bj < 2; ++bj) { const u32x4 a8 = *(const u32x4*)(gp + bj * HALF), b8 = *(const u32x4*)(gp + 1024 + bj * HALF);
#pragma unroll
                    for (int e = 0; e < 4; ++e) { const unsigned aw = a8[e], bw = b8[e];
                        const float f0 = (1.0f + __expf(-bf_lo(bw))) / (1.0f + __expf(-bf_lo(aw))), f1 = (1.0f + __expf(-bf_hi(bw))) / (1.0f + __expf(-bf_hi(aw)));
                        acc[ai][bj][m][e >> 1][(e & 1) * 2] *= f0; acc[ai][bj][m][e >> 1][(e & 1) * 2 + 1] *= f1; } }
                asm volatile("" ::: "memory"); }
    }
    __device__ __forceinline__ void operator()(const f32x4 (&acc)[2][2][4][2], const Unit& u, int wr, int wc, int fr, int fq) const {
        const int row0 = u.pm * BM + wr * 64 + fr, col0 = u.pn * BM + wc * 32 + 8 * fq;
#pragma unroll
        for (int ai = 0; ai < 2; ++ai)
#pragma unroll
            for (int m = 0; m < 4; ++m) { const size_t r = (size_t)(row0 + ai * HALF + m * 16);
#pragma unroll
                for (int bj = 0; bj < 2; ++bj) { const u32x4 b8 = *(const u32x4*)(PB + r * 2048 + 1024 + col0 + bj * HALF);
                    const f32x4 v0 = acc[ai][bj][m][0], v1 = acc[ai][bj][m][1]; u32x4 w;
                    w.x = cvt_pk_bf16(v0[0] * sigm(bf_lo(b8.x)), v0[1] * sigm(bf_hi(b8.x))); w.y = cvt_pk_bf16(v0[2] * sigm(bf_lo(b8.y)), v0[3] * sigm(bf_hi(b8.y)));
                    w.z = cvt_pk_bf16(v1[0] * sigm(bf_lo(b8.z)), v1[1] * sigm(bf_hi(b8.z))); w.w = cvt_pk_bf16(v1[2] * sigm(bf_lo(b8.w)), v1[3] * sigm(bf_hi(b8.w)));
                    *(u32x4*)(O + r * 1024 + col0 + bj * HALF) = w; } }
    }
};
template <bool INPLACE> struct EpiRes {
    static constexpr bool PERM = false, AFTER_DRAIN = false; static constexpr int MID_T = 0;
    const float* xp; const float* xs; float* out; const float* gate;
    __device__ __forceinline__ void mid(f32x4 (&)[2][2][4][2], const Unit&, int, int, int, int) const {}
    __device__ __forceinline__ void operator()(const f32x4 (&acc)[2][2][4][2], const Unit& u, int wr, int wc, int fr, int fq) const {
        const int row0 = u.pm * BM + wr * 64 + fr, col0 = u.pn * BM + wc * 32 + 4 * fq;
#pragma unroll
        for (int ai = 0; ai < 2; ++ai)
#pragma unroll
            for (int m = 0; m < 4; ++m) { const int row = row0 + ai * HALF + m * 16; const int seq = row < MP_ROWS ? 0 : 1 + ((row - MP_ROWS) >> 4);
                const float* g = gate + (size_t)seq * 6144 + col0; float* op = out + (size_t)row * 1024 + col0;
                const float* bp = INPLACE ? (const float*)op : ((row < MP_ROWS ? xp + (size_t)row * 1024 : xs + (size_t)(row - MP_ROWS) * 1024) + col0);
#pragma unroll
                for (int bj = 0; bj < 2; ++bj)
#pragma unroll
                    for (int n = 0; n < 2; ++n) { const int c = bj * HALF + n * 16; const f32x4 bs = *(const f32x4*)(bp + c), gt = *(const f32x4*)(g + c);
                        *(f32x4*)(op + c) = bs + gt * acc[ai][bj][m][n]; }
                if (m & 1) asm volatile("" ::: "memory"); }
    }
};
struct EpiRelu2 {
    static constexpr bool PERM = true, AFTER_DRAIN = false; static constexpr int MID_T = 0;
    bf16_t* O;
    __device__ __forceinline__ void mid(f32x4 (&)[2][2][4][2], const Unit&, int, int, int, int) const {}
    __device__ __forceinline__ void operator()(const f32x4 (&acc)[2][2][4][2], const Unit& u, int wr, int wc, int fr, int fq) const {
        const int row0 = u.pm * BM + wr * 64 + fr, col0 = u.pn * BM + wc * 32 + 8 * fq;
#pragma unroll
        for (int ai = 0; ai < 2; ++ai)
#pragma unroll
            for (int m = 0; m < 4; ++m) { bf16_t* rowp = O + (size_t)(row0 + ai * HALF + m * 16) * 4096 + col0;
#pragma unroll
                for (int bj = 0; bj < 2; ++bj) { f32x4 v0 = acc[ai][bj][m][0], v1 = acc[ai][bj][m][1];
#pragma unroll
                    for (int e = 0; e < 4; ++e) { const float a = fmaxf(v0[e], 0.f), b = fmaxf(v1[e], 0.f); v0[e] = a * a; v1[e] = b * b; }
                    u32x4 w; w.x = cvt_pk_bf16(v0[0], v0[1]); w.y = cvt_pk_bf16(v0[2], v0[3]); w.z = cvt_pk_bf16(v1[0], v1[1]); w.w = cvt_pk_bf16(v1[2], v1[3]);
                    *(u32x4*)(rowp + bj * HALF) = w; } }
    }
};
}

#define LAS __attribute__((address_space(3)))
typedef unsigned short bf16;
typedef float f32x4 __attribute__((ext_vector_type(4)));
typedef float f32x2 __attribute__((ext_vector_type(2)));
typedef unsigned u32x4 __attribute__((ext_vector_type(4)));
typedef unsigned u32x2 __attribute__((ext_vector_type(2)));
typedef short bf16x8 __attribute__((ext_vector_type(8)));
typedef short s16x4 __attribute__((ext_vector_type(4)));

constexpr int DM = 1024, MP = 16384, NSEQ = 32, LSAMP = 16, MS = NSEQ * LSAMP, MT = MP + MS;
constexpr int NIN = 5888, KCAT = 1536, DFF = 4096, NMOD = 6144, NROWS_MOD = 33;
constexpr int PA_LD = 3584, PB_LD = 2048;
constexpr int NSC = 64;
constexpr float EPS = 1e-6f;
constexpr size_t MiB = 1u << 20;
constexpr size_t WS_MOD = 1 * MiB;
constexpr size_t WS_ALR = 2 * MiB;
constexpr size_t WS_GT = 4 * MiB;
constexpr size_t WS_WIN = 8 * MiB;
constexpr size_t WS_WCAT = 20 * MiB;
constexpr size_t WS_WOUT = 23 * MiB;
constexpr size_t WS_WFF1 = 25 * MiB;
constexpr size_t WS_WFF2 = 33 * MiB;
constexpr size_t WS_PB = 42 * MiB;
constexpr size_t WS_PA = 108 * MiB;
constexpr size_t WS_US = 224 * MiB;
constexpr size_t WS_END = 256 * MiB;
constexpr size_t O_Y = 0, O_SGP = (size_t)MT * DM, O_CPP = O_SGP + 131072, O_SGS = O_CPP + 7680, O_CPS = O_SGS + (size_t)NSEQ * 131072;
constexpr int LDS_BYTES = 147456;

__device__ __forceinline__ float bf2f(unsigned short h) { return __uint_as_float((unsigned)h << 16); }
__device__ __forceinline__ unsigned f2bf(float f) { unsigned u = __float_as_uint(f); return (u + 0x7fffu + ((u >> 16) & 1u)) >> 16; }
__device__ __forceinline__ unsigned pk2(float lo, float hi) { return f2bf(lo) | (f2bf(hi) << 16); }
__device__ __forceinline__ float wave_sum(float v, int lane) {
#pragma unroll
    for (int o = 1; o < 64; o <<= 1) v += shfl_xor_l(v, o, lane);
    return v;
}
__device__ __forceinline__ float silu_f(float x) { return x / (1.0f + __expf(-x)); }

__device__ __forceinline__ void transpose_item(const float* W, int ldn, int k0, int c0, int valid, bf16* WT, int dld, int drow0, int dk0, LAS float* scr, int lane) {
    float tv[32];
#pragma unroll
    for (int i = 0; i < 32; ++i) { const int kk = 2 * i + (lane >> 5), n = lane & 31; tv[i] = n < valid ? W[(size_t)(k0 + kk) * ldn + c0 + n] : 0.f; }
#pragma unroll
    for (int i = 0; i < 32; ++i) { const int kk = 2 * i + (lane >> 5), n = lane & 31; scr[kk * 33 + n] = tv[i]; }
    asm volatile("s_waitcnt lgkmcnt(0)" ::: "memory");
    const int c = lane & 7;
#pragma unroll
    for (int j = 0; j < 4; ++j) { const int n = (lane >> 3) + 8 * j; const LAS float* s = scr + (8 * c) * 33 + n;
        u32x4 o; o.x = pk2(s[0 * 33], s[1 * 33]); o.y = pk2(s[2 * 33], s[3 * 33]); o.z = pk2(s[4 * 33], s[5 * 33]); o.w = pk2(s[6 * 33], s[7 * 33]);
        *(u32x4*)(WT + (size_t)(drow0 + n) * dld + dk0 + k0 + 8 * c) = o; }
    asm volatile("s_waitcnt lgkmcnt(0)" ::: "memory");
}

#define XB_TMO      128
#define XB_XCNT(j)  (256  + 64 * (j))
#define XB_XSUB(j)  (1280 + 64 * (j))
#define XB_XGEN(j)  (2304 + 64 * (j))
#define XB_TOP      3328
#define XB_TOPGEN   3392
#define XCD_BAR_WORDS 3456
#define XB_SPIN_CAP (1u << 18)

__device__ __forceinline__ unsigned xb_ld(unsigned* p)              { return __hip_atomic_load(p, __ATOMIC_RELAXED, __HIP_MEMORY_SCOPE_AGENT); }
__device__ __forceinline__ unsigned xb_add(unsigned* p, unsigned v) { return __hip_atomic_fetch_add(p, v, __ATOMIC_RELAXED, __HIP_MEMORY_SCOPE_AGENT); }
__device__ __forceinline__ unsigned xb_xcc_id() { return (unsigned)__builtin_amdgcn_s_getreg((3 << 11) | 20) & 0xFu; }
#define XB_SPIN(cond, bar) do { unsigned _sp = 0; while (cond) { __builtin_amdgcn_s_sleep(1); \
    if ((++_sp & 255u) == 0u) { if (xb_ld(&(bar)[XB_TMO])) break; if (_sp > XB_SPIN_CAP) { atomicAdd(&(bar)[XB_TMO], 1u); break; } } } } while (0)

struct XcdBarrier {
    unsigned* bar; unsigned x;
    volatile LAS unsigned* st;
};

__device__ __forceinline__ XcdBarrier xcd_barrier_post(unsigned* bar, volatile LAS unsigned* st, int tid) {
    XcdBarrier b; b.bar = bar; b.x = xb_xcc_id(); b.st = st;
    if (tid == 0) (void)xb_add(&bar[XB_XCNT(b.x)], 1u);
    return b;
}
__device__ __forceinline__ void xcd_barrier_complete(unsigned* bar, unsigned x, unsigned& nloc, unsigned& nx) {
    const unsigned G = gridDim.x * gridDim.y * gridDim.z;
    unsigned sum, cnt, mine, sp = 0u;
    for (;;) {
        sum = 0u; cnt = 0u; mine = 0u;
#pragma unroll
        for (unsigned j = 0; j < 16; ++j) { const unsigned c = xb_ld(&bar[XB_XCNT(j)]); sum += c; cnt += (c > 0u) ? 1u : 0u; mine = (j == x) ? c : mine; }
        if (sum == G) break;
        __builtin_amdgcn_s_sleep(1);
        if ((++sp & 255u) == 0u) { if (xb_ld(&bar[XB_TMO])) break; if (sp > XB_SPIN_CAP) { atomicAdd(&bar[XB_TMO], 1u); break; } }
    }
    nloc = mine > 0u ? mine : 1u; nx = cnt > 0u ? cnt : 1u;
}

__device__ __forceinline__ void xcd_barrier(const XcdBarrier& b, int tid) {
    asm volatile("s_waitcnt vmcnt(0)" ::: "memory");
    __syncthreads();
    if (tid == 0) {
        unsigned* bar = b.bar;
        __builtin_amdgcn_s_waitcnt(0);
        unsigned nloc = b.st[0], nx = b.st[1];
        if (nloc == 0u) { xcd_barrier_complete(bar, b.x, nloc, nx); b.st[0] = nloc; b.st[1] = nx; }
        const unsigned old = xb_add(&bar[XB_XSUB(b.x)], 1u);
        const unsigned gen = old / nloc;
        if (old + 1u == (gen + 1u) * nloc) {
            __builtin_amdgcn_fence(__ATOMIC_RELEASE, "agent");
            asm volatile("s_waitcnt vmcnt(0)" ::: "memory");
            const unsigned og = xb_add(&bar[XB_TOP], 1u);
            const unsigned tg = og / nx;
            if (og + 1u == (tg + 1u) * nx) xb_add(&bar[XB_TOPGEN], 1u);
            else XB_SPIN(xb_ld(&bar[XB_TOPGEN]) == tg, bar);
            __builtin_amdgcn_fence(__ATOMIC_ACQUIRE, "agent");
            xb_add(&bar[XB_XGEN(b.x)], 1u);
            asm volatile("s_waitcnt vmcnt(0)" ::: "memory");
        } else {
            XB_SPIN(xb_ld(&bar[XB_XGEN(b.x)]) == gen, bar);
            __builtin_amdgcn_fence(__ATOMIC_ACQUIRE, "agent");
            asm volatile("s_waitcnt vmcnt(0)" ::: "memory");
        }
    }
    __syncthreads();
}

struct Args { const float* in[22]; float* out; unsigned char* ws; };
__device__ __forceinline__ unsigned* bar_words() { const __attribute__((address_space(4))) Args* ap_ = (const __attribute__((address_space(4))) Args*)__builtin_amdgcn_kernarg_segment_ptr(); asm volatile("" : "+s"(ap_)); return (unsigned*)(ap_->ws); }
constexpr int LDS_BARST = 131072 + 512;


constexpr int G_QD = 0, G_KD = 17408, G_KPT = 34816, G_VT = 53248, G_ALR = 90112, G_PART = 94208, G_GL = 96256, G_SSQ = 96768;
#define MFMA16(a, b, c) __builtin_amdgcn_mfma_f32_16x16x32_bf16((a), (b), (c), 0, 0, 0)
__device__ __forceinline__ bf16x8 pack8(const f32x4& a, const f32x4& b) {
    u32x4 p; p.x = pk2(a[0], a[1]); p.y = pk2(a[2], a[3]); p.z = pk2(b[0], b[1]); p.w = pk2(b[2], b[3]); return __builtin_bit_cast(bf16x8, p);
}
template <bool DO_O>
__device__ __forceinline__ void gla_unit(LAS unsigned char* lds, const int tid_in, const int row0, const int nchunks, const int nvalid, const int h,
                                         const bf16* PA, const float* ALR, const float* w_alpha, const float* b_alpha, const float* gnorm,
                                         const float* Sinit, float* Sout, float* Gout, bf16* ACAT) {
    int tid = tid_in; asm volatile("" : "+v"(tid));
    const int lane = tid & 63, wid = tid >> 6, fr = lane & 15, fq = lane >> 4, dvb = wid * 32;
    f32x4 S[8][2];
#pragma unroll
    for (int kt = 0; kt < 8; ++kt)
#pragma unroll
        for (int dvt = 0; dvt < 2; ++dvt) {
            if (Sinit) {
#pragma unroll
                for (int r = 0; r < 4; ++r) S[kt][dvt][r] = Sinit[(size_t)(16 * kt + 4 * fq + r) * 256 + dvb + 16 * dvt + fr];
            } else S[kt][dvt] = (f32x4){0.f, 0.f, 0.f, 0.f};
        }
    const int dk = tid & 127, tq = tid >> 7;
    float gsum = 0.f;
    LAS bf16* QD = (LAS bf16*)(lds + G_QD); LAS bf16* KD = (LAS bf16*)(lds + G_KD);
    LAS float* ALRL = (LAS float*)(lds + G_ALR); LAS float* PART = (LAS float*)(lds + G_PART); LAS float* GL = (LAS float*)(lds + G_GL); LAS float* SSQ = (LAS float*)(lds + G_SSQ);
    for (int ch = 0; ch < nchunks; ++ch) {
        const int r0 = row0 + ch * 64;
        __syncthreads();
        if (tid < 256) { const int t = tid >> 2, part = tid & 3; f32x4 v = (f32x4){0.f, 0.f, 0.f, 0.f}; if (t < nvalid) v = *(const f32x4*)(ALR + (size_t)(r0 + t) * 16 + part * 4);
            *(LAS f32x4*)(ALRL + t * 16 + part * 4) = v; }
        unsigned short qv[16], kv[16];
#pragma unroll
        for (int i = 0; i < 16; ++i) { const int t = 16 * tq + i; qv[i] = 0; kv[i] = 0;
            if (t < nvalid) { const bf16* p = PA + (size_t)(r0 + t) * PA_LD + h * 128 + dk; qv[i] = p[512]; kv[i] = p[1024]; } }
        {
            const int dv2 = tid & 127, tg = tid >> 7; unsigned vv[16];
#pragma unroll
            for (int i = 0; i < 16; ++i) { const int t = 16 * tg + i; vv[i] = 0u; if (t < nvalid) vv[i] = *(const unsigned*)(PA + (size_t)(r0 + t) * PA_LD + 1536 + h * 256 + 2 * dv2); }
            u32x4 lo0, lo1, hi0, hi1;
#pragma unroll
            for (int j = 0; j < 4; ++j) { lo0[j] = (vv[2 * j] & 0xffffu) | (vv[2 * j + 1] << 16); hi0[j] = (vv[2 * j] >> 16) | (vv[2 * j + 1] & 0xffff0000u);
                lo1[j] = (vv[8 + 2 * j] & 0xffffu) | (vv[8 + 2 * j + 1] << 16); hi1[j] = (vv[8 + 2 * j] >> 16) | (vv[8 + 2 * j + 1] & 0xffff0000u); }
            LAS unsigned char* vt = lds + G_VT + (2 * dv2) * 144 + tg * 32;
            *(LAS u32x4*)(vt) = lo0; *(LAS u32x4*)(vt + 16) = lo1; *(LAS u32x4*)(vt + 144) = hi0; *(LAS u32x4*)(vt + 160) = hi1;
        }
        __syncthreads();
        const float* wa_ = w_alpha; asm volatile("" : "+s"(wa_));
        float wal[16];
#pragma unroll
        for (int r = 0; r < 16; ++r) wal[r] = wa_[r * 512 + h * 128 + dk];
        const float bal = b_alpha[h * 128 + dk];
        float bl[16]; float run = 0.f;
#pragma unroll
        for (int i = 0; i < 16; ++i) { const int t = 16 * tq + i; const LAS f32x4* ar = (const LAS f32x4*)(ALRL + t * 16); float x = bal;
#pragma unroll
            for (int j = 0; j < 4; ++j) { const f32x4 a4 = ar[j]; x += a4[0] * wal[4 * j] + a4[1] * wal[4 * j + 1] + a4[2] * wal[4 * j + 2] + a4[3] * wal[4 * j + 3]; }
            const float ls = fminf(x, 0.f) - log1pf(__expf(-fabsf(x)));
            run += (t < nvalid) ? ls * (1.0f / 16.0f) : 0.f; bl[i] = run; }
        PART[tq * 128 + dk] = run;
        __syncthreads();
        float off = 0.f, tot = 0.f;
#pragma unroll
        for (int t4 = 0; t4 < 4; ++t4) { const float p = PART[t4 * 128 + dk]; tot += p; off += (t4 < tq) ? p : 0.f; }
        unsigned kpk[8];
#pragma unroll
        for (int i = 0; i < 16; ++i) { const int t = 16 * tq + i; const float b = bl[i] + off; const float q = bf2f(qv[i]) * 0.08838834764831845f, k = bf2f(kv[i]);
            QD[t * 136 + dk] = (bf16)f2bf(q * __expf(b)); KD[t * 136 + dk] = (bf16)f2bf(k * __expf(-b));
            const unsigned kp = f2bf(k * __expf(tot - b)); if (i & 1) kpk[i >> 1] |= kp << 16; else kpk[i >> 1] = kp; }
        { LAS unsigned char* kp = lds + G_KPT + dk * 144 + tq * 32; *(LAS u32x4*)kp = (u32x4){kpk[0], kpk[1], kpk[2], kpk[3]}; *(LAS u32x4*)(kp + 16) = (u32x4){kpk[4], kpk[5], kpk[6], kpk[7]}; }
        if (tq == 0) GL[dk] = __expf(tot);
        gsum += tot;
        __syncthreads();
        if constexpr (DO_O) {
            f32x4 oT[4][2];
#pragma unroll
            for (int it = 0; it < 4; ++it) {
                oT[it][0] = (f32x4){0.f, 0.f, 0.f, 0.f}; oT[it][1] = (f32x4){0.f, 0.f, 0.f, 0.f};
#pragma unroll
                for (int jp = 0; jp < 2; ++jp) {
                    if (2 * jp > it) continue;
                    const int jt0 = 2 * jp, jt1 = 2 * jp + 1;
                    f32x4 P0 = (f32x4){0.f, 0.f, 0.f, 0.f}, P1 = (f32x4){0.f, 0.f, 0.f, 0.f};
#pragma unroll
                    for (int ks = 0; ks < 4; ++ks) {
                        const bf16x8 yq = *(const LAS bf16x8*)(lds + G_QD + (16 * it + fr) * 272 + (32 * ks + 8 * fq) * 2);
                        const bf16x8 x0 = *(const LAS bf16x8*)(lds + G_KD + (16 * jt0 + fr) * 272 + (32 * ks + 8 * fq) * 2);
                        P0 = MFMA16(x0, yq, P0);
                        if (jt1 <= it) { const bf16x8 x1 = *(const LAS bf16x8*)(lds + G_KD + (16 * jt1 + fr) * 272 + (32 * ks + 8 * fq) * 2); P1 = MFMA16(x1, yq, P1); }
                    }
                    if (jt0 == it) {
#pragma unroll
                        for (int r = 0; r < 4; ++r) if (fr < 4 * fq + r) P0[r] = 0.f;
                    }
                    if (jt1 == it) {
#pragma unroll
                        for (int r = 0; r < 4; ++r) if (fr < 4 * fq + r) P1[r] = 0.f;
                    }
                    const bf16x8 pb = pack8(P0, P1);
#pragma unroll
                    for (int dvt = 0; dvt < 2; ++dvt) {
                        const LAS unsigned char* vr = lds + G_VT + (dvb + 16 * dvt + fr) * 144;
                        const s16x4 a0 = *(const LAS s16x4*)(vr + (16 * jt0 + 4 * fq) * 2), a1 = *(const LAS s16x4*)(vr + (16 * jt1 + 4 * fq) * 2);
                        const bf16x8 xa = __builtin_shufflevector(a0, a1, 0, 1, 2, 3, 4, 5, 6, 7);
                        oT[it][dvt] = MFMA16(xa, pb, oT[it][dvt]);
                    }
                }
            }
#pragma unroll
            for (int kp = 0; kp < 4; ++kp) {
                const bf16x8 Sb0 = pack8(S[2 * kp][0], S[2 * kp + 1][0]), Sb1 = pack8(S[2 * kp][1], S[2 * kp + 1][1]);
#pragma unroll
                for (int it = 0; it < 4; ++it) {
                    const LAS unsigned char* qr = lds + G_QD + (16 * it + fr) * 272;
                    const s16x4 q0 = *(const LAS s16x4*)(qr + (32 * kp + 4 * fq) * 2), q1 = *(const LAS s16x4*)(qr + (32 * kp + 16 + 4 * fq) * 2);
                    const bf16x8 yq = __builtin_shufflevector(q0, q1, 0, 1, 2, 3, 4, 5, 6, 7);
                    oT[it][0] = MFMA16(Sb0, yq, oT[it][0]); oT[it][1] = MFMA16(Sb1, yq, oT[it][1]);
                }
            }
#pragma unroll
            for (int it = 0; it < 4; ++it) {
                float ss = 0.f;
#pragma unroll
                for (int dvt = 0; dvt < 2; ++dvt)
#pragma unroll
                    for (int r = 0; r < 4; ++r) ss += oT[it][dvt][r] * oT[it][dvt][r];
                ss += shfl_xor_l(ss, 16, lane); ss += shfl_xor_l(ss, 32, lane);
                if (fq == 0) SSQ[wid * 64 + 16 * it + fr] = ss;
            }
            __syncthreads();
            int r0o = r0; asm volatile("" : "+s"(r0o));
#pragma unroll
            for (int it = 0; it < 4; ++it) {
                const int tok = 16 * it + fr; float tss = 0.f;
#pragma unroll
                for (int w = 0; w < 8; ++w) tss += SSQ[w * 64 + tok];
                const float rstd = rsqrtf(tss * (1.0f / 256.0f) + EPS);
                if (tok < nvalid) {
#pragma unroll
                    for (int dvt = 0; dvt < 2; ++dvt) { const int dv0 = dvb + 16 * dvt + 4 * fq; const size_t row = (size_t)(r0o + tok);
                        const u32x2 g4 = *(const u32x2*)(PA + row * PA_LD + 2560 + h * 256 + dv0); const f32x4 gn = *(const f32x4*)(gnorm + dv0);
                        const f32x4 o = oT[it][dvt]; u32x2 w;
                        w.x = pk2(o[0] * rstd * gn[0] * silu_f(bf_lo(g4.x)), o[1] * rstd * gn[1] * silu_f(bf_hi(g4.x)));
                        w.y = pk2(o[2] * rstd * gn[2] * silu_f(bf_lo(g4.y)), o[3] * rstd * gn[3] * silu_f(bf_hi(g4.y)));
                        *(u32x2*)(ACAT + row * KCAT + 512 + h * 256 + dv0) = w; }
                }
            }
        }
#pragma unroll
        for (int kt = 0; kt < 8; ++kt) { const f32x4 gl = *(const LAS f32x4*)(GL + 16 * kt + 4 * fq); S[kt][0] *= gl; S[kt][1] *= gl; }
#pragma unroll
        for (int ks = 0; ks < 2; ++ks) {
            const bf16x8 yv0 = *(const LAS bf16x8*)(lds + G_VT + (dvb + fr) * 144 + (32 * ks + 8 * fq) * 2);
            const bf16x8 yv1 = *(const LAS bf16x8*)(lds + G_VT + (dvb + 16 + fr) * 144 + (32 * ks + 8 * fq) * 2);
#pragma unroll
            for (int kt = 0; kt < 8; ++kt) { const bf16x8 xk = *(const LAS bf16x8*)(lds + G_KPT + (16 * kt + fr) * 144 + (32 * ks + 8 * fq) * 2);
                S[kt][0] = MFMA16(xk, yv0, S[kt][0]); S[kt][1] = MFMA16(xk, yv1, S[kt][1]); }
        }
    }
    if (Sout) {
        int l2 = lane; asm volatile("" : "+v"(l2)); const int fr2 = l2 & 15, fq2 = l2 >> 4;
#pragma unroll
        for (int kt = 0; kt < 8; ++kt)
#pragma unroll
            for (int dvt = 0; dvt < 2; ++dvt)
#pragma unroll
                for (int r = 0; r < 4; ++r) Sout[(size_t)(16 * kt + 4 * fq2 + r) * 256 + dvb + 16 * dvt + fr2] = S[kt][dvt][r];
    }
    if (Gout && tq == 0) Gout[dk] = __expf(gsum);
}

__device__ __forceinline__ void norm_row_bf16(const float* xrow, const float* g, const float* shift, const float* scale, bf16* orow, int lane) {
    const f32x4* xr = (const f32x4*)xrow + lane; f32x4 v[4]; float s = 0.f;
#pragma unroll
    for (int j = 0; j < 4; ++j) { v[j] = xr[64 * j]; s += (v[j][0] * v[j][0] + v[j][1] * v[j][1]) + (v[j][2] * v[j][2] + v[j][3] * v[j][3]); }
    const float rstd = rsqrtf(wave_sum(s, lane) * (1.0f / DM) + EPS);
#pragma unroll
    for (int j = 0; j < 4; ++j) { const int c = 4 * lane + 256 * j; const f32x4 gg = *(const f32x4*)(g + c), sh = *(const f32x4*)(shift + c), sc = *(const f32x4*)(scale + c);
        const f32x4 o = v[j] * rstd * gg * (1.0f + sc) + sh;
        u32x2 w; w.x = pk2(o[0], o[1]); w.y = pk2(o[2], o[3]); *(u32x2*)(orow + c) = w; }
}

__global__ void __launch_bounds__(512, 2) fwd_kernel(Args a) {
    extern __shared__ __attribute__((aligned(16))) unsigned char lds_raw[];
    cg::grid_group grid = cg::this_grid();
    LAS unsigned char* lds = (LAS unsigned char*)lds_raw;
    const int wave = __builtin_amdgcn_readfirstlane((int)threadIdx.x >> 6);
    const int G = gridDim.x, blk = blockIdx.x, gw = blk * 8 + wave, NGW = G * 8;
#ifndef PROBE_LO
#define PROBE_LO -1
#define PROBE_HI -1
#endif
    { const int t0_ = lane_id_fresh() + 64 * wave; if (t0_ < 2) ((LAS unsigned*)(lds + LDS_BARST))[t0_] = 0u; __syncthreads();
      (void)xcd_barrier_post(bar_words(), (volatile LAS unsigned*)(lds + LDS_BARST), t0_); }
    unsigned long long tA = 0, tB = 0;
    if (PROBE_LO == 0) tA = __builtin_amdgcn_s_memrealtime();
#define STAMP(k) do { if (PROBE_LO >= 0) { if ((k) == PROBE_LO - 1) tA = __builtin_amdgcn_s_memrealtime(); if ((k) == PROBE_HI) tB = __builtin_amdgcn_s_memrealtime(); } } while (0)
#define GRID_BAR() do { XcdBarrier b_; b_.bar = bar_words(); b_.x = xb_xcc_id(); b_.st = (volatile LAS unsigned*)(lds + LDS_BARST); xcd_barrier(b_, lane_id_fresh() + 64 * wave); } while (0)
#define FRESH_TID() const __attribute__((address_space(4))) Args* ap = (const __attribute__((address_space(4))) Args*)__builtin_amdgcn_kernarg_segment_ptr(); asm volatile("" : "+s"(ap)); int tid = lane_id_fresh() + 64 * wave; const int lane = tid & 63; (void)lane; (void)tid
#define ws (ap->ws)
#define out (ap->out)
#define x_prompt (ap->in[0])
#define x_sample (ap->in[1])
#define c_prompt (ap->in[2])
#define c_sample (ap->in[3])
#define state_gla (ap->in[4])
#define cache_pool (ap->in[5])
#define w_ada (ap->in[6])
#define b_ada (ap->in[7])
#define norm1_g (ap->in[8])
#define w_in (ap->in[9])
#define w_alpha (ap->in[10])
#define b_alpha (ap->in[11])
#define w_pool (ap->in[12])
#define pool_scale (ap->in[13])
#define gla_norm_g (ap->in[14])
#define w_pa (ap->in[15])
#define w_pb (ap->in[16])
#define w_out (ap->in[17])
#define norm2_g (ap->in[18])
#define w_ff1 (ap->in[19])
#define w_ff2 (ap->in[20])
#define final_g (ap->in[21])
#define MOD ((float*)(ws + WS_MOD))
#define ALR ((float*)(ws + WS_ALR))
#define GT ((float*)(ws + WS_GT))
#define Win_t ((bf16*)(ws + WS_WIN))
#define Wcat_t ((bf16*)(ws + WS_WCAT))
#define Wout_t ((bf16*)(ws + WS_WOUT))
#define Wff1_t ((bf16*)(ws + WS_WFF1))
#define Wff2_t ((bf16*)(ws + WS_WFF2))
#define PB ((bf16*)(ws + WS_PB))
#define PA ((bf16*)(ws + WS_PA))
#define US ((float*)(ws + WS_US))
#define MODP ((float*)(ws + WS_US))
#define H ((bf16*)out)
#define ACAT ((bf16*)out)
#define H2 ((bf16*)(ws + WS_PB))
#define MERGED ((bf16*)(ws + WS_PA))
#define HID ((bf16*)(ws + WS_PA))
#define Y (out + O_Y)

    {
        FRESH_TID();
        LAS float* scr = (LAS float*)(lds + wave * 16384);
        constexpr int I_IN = 16 * 184, I_PB = 16 * 32, I_OUT = 16 * 32, I_F1 = 16 * 128, I_F2 = 64 * 32, I_WA = 1024, I_MOD = 96 * 16;
        constexpr int NITEMS = I_MOD + I_IN + I_PB + I_OUT + I_F1 + I_F2 + I_WA;
        for (int it = gw; it < NITEMS; it += NGW) {
            int r = it;
            if (r < I_MOD) {
                const int cgp = r % 96, ks = r / 96, k0 = 64 * ks, n = 64 * cgp + lane;
#pragma unroll 1
                for (int rr = 0; rr < NROWS_MOD; ++rr) { const float cv = rr == 0 ? c_prompt[k0 + lane] : c_sample[(size_t)(rr - 1) * DM + k0 + lane]; scr[rr * 64 + lane] = silu_f(cv); }
                asm volatile("s_waitcnt lgkmcnt(0)" ::: "memory");
                float acc[NROWS_MOD];
#pragma unroll
                for (int rr = 0; rr < NROWS_MOD; ++rr) acc[rr] = 0.f;
#pragma unroll
                for (int kb = 0; kb < 2; ++kb) { float wv[32];
#pragma unroll
                    for (int kk = 0; kk < 32; ++kk) wv[kk] = w_ada[(size_t)(k0 + kb * 32 + kk) * NMOD + n];
#pragma unroll
                    for (int kk = 0; kk < 32; ++kk)
#pragma unroll
                        for (int rr = 0; rr < NROWS_MOD; ++rr) acc[rr] += scr[rr * 64 + kb * 32 + kk] * wv[kk]; }
#pragma unroll
                for (int rr = 0; rr < NROWS_MOD; ++rr) MODP[((size_t)ks * NROWS_MOD + rr) * NMOD + n] = acc[rr];
                asm volatile("s_waitcnt lgkmcnt(0)" ::: "memory");
                continue;
            }
            r -= I_MOD;
            if (r < I_IN) { const int kb = r / 184, nb = r % 184; int c0, valid;
                if (nb < 112) { c0 = 32 * nb; valid = 32; } else if (nb < 176) { c0 = 32 * nb + 16; valid = 32; } else if (nb == 176) { c0 = 3584; valid = 16; } else { c0 = 0; valid = 0; }
                transpose_item(w_in, 5648, 64 * kb, c0, valid, Win_t, DM, 32 * nb, 0, scr, lane); continue; }
            r -= I_IN;
            if (r < I_PB) { transpose_item(w_pb, DM, 64 * (r / 32), 32 * (r % 32), 32, Wcat_t, KCAT, 32 * (r % 32), 512, scr, lane); continue; }
            r -= I_PB;
            if (r < I_OUT) { transpose_item(w_out, DM, 64 * (r / 32), 32 * (r % 32), 32, Wout_t, DM, 32 * (r % 32), 0, scr, lane); continue; }
            r -= I_OUT;
            if (r < I_F1) { transpose_item(w_ff1, DFF, 64 * (r / 128), 32 * (r % 128), 32, Wff1_t, DM, 32 * (r % 128), 0, scr, lane); continue; }
            r -= I_F1;
            if (r < I_F2) { transpose_item(w_ff2, DM, 64 * (r / 32), 32 * (r % 32), 32, Wff2_t, DFF, 32 * (r % 32), 0, scr, lane); continue; }
            r -= I_F2;
            {
                const int g = r >> 8, cb = (r >> 4) & 15, nb = r & 15, n = 64 * nb + lane, c0 = 8 * cb;
                float acc[8];
#pragma unroll
                for (int cc = 0; cc < 8; ++cc) acc[cc] = 0.f;
#pragma unroll 1
                for (int db = 0; db < 4; ++db) { float wp[32];
#pragma unroll
                    for (int d = 0; d < 32; ++d) wp[d] = w_pa[(size_t)(g * 128 + db * 32 + d) * DM + n] * pool_scale[g * 128 + db * 32 + d];
#pragma unroll
                    for (int d = 0; d < 32; ++d)
#pragma unroll
                        for (int cc = 0; cc < 8; ++cc) acc[cc] += w_pool[(size_t)(g * 128 + c0 + cc) * 128 + db * 32 + d] * wp[d]; }
                u32x4 o; o.x = pk2(acc[0], acc[1]); o.y = pk2(acc[2], acc[3]); o.z = pk2(acc[4], acc[5]); o.w = pk2(acc[6], acc[7]);
                *(u32x4*)(Wcat_t + (size_t)n * KCAT + g * 128 + c0) = o;
            }
        }
    }
    grid.sync(); STAMP(0);
    { FRESH_TID();
    for (int i = blk * 512 + tid; i < NROWS_MOD * NMOD; i += G * 512) { float s = b_ada[i % NMOD];
#pragma unroll
        for (int ks = 0; ks < 16; ++ks) s += MODP[(size_t)ks * NROWS_MOD * NMOD + i];
        MOD[i] = s; } }
    GRID_BAR(); STAMP(1);
    { FRESH_TID();
    for (int m = gw; m < MT; m += NGW) { const int seq = m < MP ? 0 : 1 + ((m - MP) >> 4); const float* xr = m < MP ? x_prompt + (size_t)m * DM : x_sample + (size_t)(m - MP) * DM;
        norm_row_bf16(xr, norm1_g, MOD + (size_t)seq * NMOD, MOD + (size_t)seq * NMOD + 1024, H + (size_t)m * DM, lane); } }
    GRID_BAR(); STAMP(2);
    {
        FRESH_TID();
        pg8::Gemm g{H, Win_t, MT, NIN, DM}; pg8::StaticOrder S; S.init(MT, NIN, G, blk);
        pg8::EpiProj E{PA, PB, ALR};
        pg8::gemm_phase<pg8::EpiProj, pg8::StaticOrder, true, true>(lds, g, S, E, wave);
    }
    GRID_BAR(); STAMP(3);
    {
        FRESH_TID();
        for (int u = blk; u < NSC * 4; u += G) { const int sc2 = u >> 2, h2 = u & 3;
            gla_unit<false>(lds, tid, sc2 * 256, 4, 64, h2, PA, ALR, w_alpha, b_alpha, gla_norm_g, nullptr, US + (size_t)u * 32768, GT + (size_t)u * 128, ACAT); }
        for (int u = (G - 1 - blk); u < NSEQ * 4; u += G) { const int s = u >> 2, h = u & 3;
            gla_unit<true>(lds, tid, MP + s * 16, 1, 16, h, PA, ALR, w_alpha, b_alpha, gla_norm_g, state_gla + (size_t)u * 32768, out + O_SGS + (size_t)u * 32768, nullptr, ACAT); }
        for (int pt = blk; pt < MT / 16; pt += G) {
            const int rowb = pt * 16, c = tid, gi = c >> 7, w = 2 << gi; const bool samp = rowb >= MP; const int seq = samp ? (rowb - MP) >> 4 : 0;
            float e[31];
#pragma unroll
            for (int i = 0; i < 31; ++i) { const int j = i - 15; float v;
                if (j >= 0) v = bf2f(PA[(size_t)(rowb + j) * PA_LD + c]);
                else if (samp) v = cache_pool[((size_t)seq * 15 + (15 + j)) * 512 + c];
                else v = (rowb + j >= 0) ? bf2f(PA[(size_t)(rowb + j) * PA_LD + c]) : 0.f;
                e[i] = v; }
            float ps[32]; ps[0] = 0.f;
#pragma unroll
            for (int i = 0; i < 31; ++i) ps[i + 1] = ps[i] + e[i];
#pragma unroll
            for (int tl = 0; tl < 16; ++tl) { const int row = rowb + tl, a2 = 16 + tl; const float ut = e[15 + tl];
                const float lo = gi == 0 ? ps[a2 - 2] : gi == 1 ? ps[a2 - 4] : gi == 2 ? ps[a2 - 8] : ps[a2 - 16];
                const float cnt = samp ? (float)w : (float)((row + 1) < w ? (row + 1) : w);
                ACAT[(size_t)row * KCAT + c] = (bf16)f2bf((ps[a2] - lo) / cnt - ut);
                if (samp) { if (tl >= 1) out[O_CPS + ((size_t)seq * 15 + (tl - 1)) * 512 + c] = ut; }
                else if (row >= MP - 15) out[O_CPP + (size_t)(row - (MP - 15)) * 512 + c] = ut; }
        }
    }
    GRID_BAR(); STAMP(4);
    { FRESH_TID();
    for (int e = blk * 512 + tid; e < 131072; e += G * 512) { float S = 0.f; const int hd = __builtin_amdgcn_readfirstlane(e >> 8);
        float u[NSC];
#pragma unroll
        for (int sc = 0; sc < NSC; ++sc) u[sc] = US[(size_t)sc * 131072 + e];
#pragma unroll
        for (int sc = 0; sc < NSC; ++sc) { US[(size_t)sc * 131072 + e] = S; S = GT[sc * 512 + hd] * S + u[sc]; }
        out[O_SGP + e] = S; } }
    GRID_BAR(); STAMP(5);
    { FRESH_TID();
    for (int u = blk; u < NSC * 4; u += G) { const int sc = u >> 2, h = u & 3;
        gla_unit<true>(lds, tid, sc * 256, 4, 64, h, PA, ALR, w_alpha, b_alpha, gla_norm_g, US + (size_t)u * 32768, nullptr, nullptr, ACAT); } }
    GRID_BAR(); STAMP(6);
    {
        FRESH_TID();
        pg8::Gemm g{ACAT, Wcat_t, MT, DM, KCAT}; pg8::StaticOrder S; S.init(MT, DM, G, blk);
        pg8::EpiMerge E{PB, MERGED};
        pg8::gemm_phase<pg8::EpiMerge, pg8::StaticOrder, true, true>(lds, g, S, E, wave);
    }
    GRID_BAR(); STAMP(7);
    {
        FRESH_TID();
        pg8::Gemm g{MERGED, Wout_t, MT, DM, DM}; pg8::StaticOrder S; S.init(MT, DM, G, blk);
        pg8::EpiRes<false> E{x_prompt, x_sample, Y, MOD + 2048};
        pg8::gemm_phase<pg8::EpiRes<false>, pg8::StaticOrder, true, true>(lds, g, S, E, wave);
    }
    GRID_BAR(); STAMP(8);
    { FRESH_TID();
    for (int m = gw; m < MT; m += NGW) { const int seq = m < MP ? 0 : 1 + ((m - MP) >> 4);
        norm_row_bf16(Y + (size_t)m * DM, norm2_g, MOD + (size_t)seq * NMOD + 3072, MOD + (size_t)seq * NMOD + 4096, H2 + (size_t)m * DM, lane); } }
    GRID_BAR(); STAMP(9);
    {
        FRESH_TID();
        pg8::Gemm g{H2, Wff1_t, MT, DFF, DM}; pg8::StaticOrder S; S.init(MT, DFF, G, blk);
        pg8::EpiRelu2 E{HID};
        pg8::gemm_phase<pg8::EpiRelu2, pg8::StaticOrder, true, true>(lds, g, S, E, wave);
    }
    GRID_BAR(); STAMP(10);
    {
        FRESH_TID();
        pg8::Gemm g{HID, Wff2_t, MT, DM, DFF}; pg8::StaticOrder S; S.init(MT, DM, G, blk);
        pg8::EpiRes<true> E{nullptr, nullptr, Y, MOD + 5120};
        pg8::gemm_phase<pg8::EpiRes<true>, pg8::StaticOrder, true, true>(lds, g, S, E, wave);
    }
    GRID_BAR(); STAMP(11);
    { FRESH_TID();
    for (int m = gw; m < MT; m += NGW) { f32x4* xr = (f32x4*)(Y + (size_t)m * DM) + lane; f32x4 v[4]; float s = 0.f;
#pragma unroll
        for (int j = 0; j < 4; ++j) { v[j] = xr[64 * j]; s += (v[j][0] * v[j][0] + v[j][1] * v[j][1]) + (v[j][2] * v[j][2] + v[j][3] * v[j][3]); }
        const float rstd = rsqrtf(wave_sum(s, lane) * (1.0f / DM) + EPS);
#pragma unroll
        for (int j = 0; j < 4; ++j) { const f32x4 gg = *(const f32x4*)(final_g + 4 * lane + 256 * j); xr[64 * j] = v[j] * rstd * gg; } } }
    if (PROBE_LO >= 0) { if (PROBE_HI == 12) tB = __builtin_amdgcn_s_memrealtime(); if (blk == 0) { const unsigned long long t0 = __builtin_amdgcn_s_memrealtime(), w = 4ull * (tB - tA); while (__builtin_amdgcn_s_memrealtime() - t0 < w) __builtin_amdgcn_s_sleep(8); } }
}

#undef ws
#undef out
#undef x_prompt
#undef x_sample
#undef c_prompt
#undef c_sample
#undef state_gla
#undef cache_pool
#undef w_ada
#undef b_ada
#undef norm1_g
#undef w_in
#undef w_alpha
#undef b_alpha
#undef w_pool
#undef pool_scale
#undef gla_norm_g
#undef w_pa
#undef w_pb
#undef w_out
#undef norm2_g
#undef w_ff1
#undef w_ff2
#undef final_g
#undef MOD
#undef ALR
#undef GT
#undef Win_t
#undef Wcat_t
#undef Wout_t
#undef Wff1_t
#undef Wff2_t
#undef PB
#undef PA
#undef US
#undef MODP
#undef H
#undef ACAT
#undef H2
#undef MERGED
#undef HID
#undef Y
extern "C" void kernel_launch(void* const* d_in, const int* in_sizes, int n_in, void* d_out, int out_size, void* d_ws, size_t ws_size, hipStream_t stream) {
    static int grid = 0;
    if (grid == 0) {
        if (n_in != 22 || ws_size < WS_END) { fprintf(stderr, "kernel_launch: unexpected n_in %d / ws %zu\n", n_in, ws_size); grid = -1; return; }
        int dev = 0, cus = 0, per_cu = 0;
        hipGetDevice(&dev); hipDeviceGetAttribute(&cus, hipDeviceAttributeMultiprocessorCount, dev);
        if (hipFuncSetAttribute((const void*)fwd_kernel, hipFuncAttributeMaxDynamicSharedMemorySize, LDS_BYTES) != hipSuccess) { fprintf(stderr, "kernel_launch: hipFuncSetAttribute failed\n"); grid = -1; return; }
        if (hipOccupancyMaxActiveBlocksPerMultiprocessor(&per_cu, (const void*)fwd_kernel, 512, LDS_BYTES) != hipSuccess || per_cu < 1) { fprintf(stderr, "kernel_launch: occupancy query says %d\n", per_cu); per_cu = 1; }
        (void)hipGetLastError();
        grid = cus * 1;
    }
    if (grid < 0) return;
    if (hipMemsetAsync(d_ws, 0, 65536, stream) != hipSuccess) { fprintf(stderr, "kernel_launch: memset failed\n"); return; }
    Args a{};
    for (int i = 0; i < 22; ++i) a.in[i] = (const float*)d_in[i];
    a.out = (float*)d_out; a.ws = (unsigned char*)d_ws;
    void* args[] = {&a};
    hipError_t e = hipLaunchCooperativeKernel((const void*)fwd_kernel, dim3(grid), dim3(512), args, LDS_BYTES, stream);
    if (e != hipSuccess) fprintf(stderr, "kernel_launch: cooperative launch failed: %s (grid %d)\n", hipGetErrorString(e), grid);
}
```

```cpp
#include <hip/hip_runtime.h>
#include <hip/hip_cooperative_groups.h>
#include <cstdio>
#include <cstdint>
namespace cg = cooperative_groups;
__device__ __forceinline__ int lane_id_fresh() { int l; asm volatile("v_mbcnt_lo_u32_b32 %0, -1, 0\n\tv_mbcnt_hi_u32_b32 %0, -1, %0" : "=v"(l)); return l; }
__device__ __forceinline__ float shfl_xor_l(float v, int o, int lane) { return __int_as_float(__builtin_amdgcn_ds_bpermute((lane ^ o) << 2, __float_as_int(v))); }
__device__ __forceinline__ float bf_lo(unsigned w) { return __uint_as_float(w << 16); }
__device__ __forceinline__ float bf_hi(unsigned w) { return __uint_as_float(w & 0xffff0000u); }
__device__ __forceinline__ float sigm(float x) { return 1.0f / (1.0f + __expf(-x)); }
namespace pg8 {
#define PG8_LAS __attribute__((address_space(3)))
typedef unsigned short bf16_t;
typedef short bf16x8 __attribute__((ext_vector_type(8)));
typedef float f32x4 __attribute__((ext_vector_type(4)));
typedef unsigned u32x4 __attribute__((ext_vector_type(4)));
constexpr int BM = 256, BK = 64, HALF = 128, HTB = HALF * BK * 2  , STAGE_BYTES = 8 * HTB, NXCD = 8, WGM = 8;

__host__ __device__ __forceinline__ int lds_byte(int r, int c) { const int st = (r >> 4) * 2 + (c >> 5), rr = r & 15, cc = c & 31, ob = rr * 64 + cc * 2; return st * 1024 + (ob ^ (((ob >> 9) & 1) << 5)); }
__host__ __device__ __forceinline__ void stage_rc(int b, int& R, int& C) { const int st = b / 1024, sb = b % 1024, swz = sb ^ (((sb >> 9) & 1) << 5); R = (st >> 1) * 16 + swz / 64; C = (st & 1) * 32 + (swz % 64) / 2; }
__host__ __device__ __forceinline__ int perm32(int rho) { const int n = rho >> 4, i = rho & 15; return 8 * (i >> 2) + 4 * n + (i & 3); }

struct Unit { int pm, pn; };
struct Gemm { const bf16_t* A; const bf16_t* Bt; int M, N, K; };

struct StaticOrder {
    int nM, nN, nwg, G, c;
    __host__ __device__ void init(int M, int N, int G_, int c_) { nM = M / BM; nN = N / BM; nwg = nM * nN; G = G_; c = c_; }
    __host__ __device__ bool next(int i, Unit& u) const {
        const long L = (long)i * G + c; if (L >= nwg) return false;
        int wgid = (int)L; { const int q = nwg / NXCD, r = nwg % NXCD, xcd = wgid % NXCD, off = wgid / NXCD; wgid = (xcd < r ? xcd * (q + 1) : r * (q + 1) + (xcd - r) * q) + off; }
        const int nig = WGM * nN, gid = wgid / nig, fm = gid * WGM, gsz = (nM - fm) < WGM ? (nM - fm) : WGM;
        u.pm = fm + ((wgid % nig) % gsz); u.pn = (wgid % nig) / gsz; return true;
    }
    __device__ __forceinline__ void a_ready(const Unit&) const {}
    __device__ __forceinline__ void done(const Unit&) const {}
};

__device__ __forceinline__ unsigned cvt_pk_bf16(float lo, float hi) { unsigned r; asm volatile("v_cvt_pk_bf16_f32 %0, %1, %2" : "=v"(r) : "v"(lo), "v"(hi)); return r; }
template <class Epi, class Sched, bool ALIGN_EPI = false, bool SP2 = false>
__device__ __forceinline__ void gemm_phase(PG8_LAS unsigned char* lds, const Gemm g, const Sched& S, const Epi& E, const int wave_id) {
    int tid_ = lane_id_fresh() + 64 * wave_id;
    const int tid = tid_, wid = __builtin_amdgcn_readfirstlane(tid >> 6), lane = tid & 63, wr = wid >> 2, wc = wid & 3, fr = lane & 15, fq = lane >> 4;
    const int K = g.K, nt = K / BK;
    unsigned voffA[2], voffB[2];
#pragma unroll
    for (int i = 0; i < 2; ++i) { int R, C; stage_rc(tid * 16 + i * 8192, R, C); const int Rb = Epi::PERM ? ((R & ~31) + perm32(R & 31)) : R;
        voffA[i] = (unsigned)(R * K + C) * 2u; voffB[i] = (unsigned)(Rb * K + C) * 2u; }
    const size_t kstep = (size_t)(BK * 2);
    const size_t hstep = (size_t)HALF * K * 2;
    const size_t tstep = 2 * hstep;
    const unsigned ldsw = (unsigned)wid * 1024u;
    const int aoff = lds_byte(wr * 64 + fr, fq * 8), boff = lds_byte(wc * 32 + fr, fq * 8);
#define PG8_SA(b, h) (((b) * 2 + (h)) * HTB)
#define PG8_SB(b, h) ((4 + (b) * 2 + (h)) * HTB)
#define PG8_STAGE(bufoff, gbase, voff) do { _Pragma("unroll") for (int _i = 0; _i < 2; ++_i) \
        __builtin_amdgcn_global_load_lds((const unsigned*)((const char*)(gbase) + (voff)[_i]), (PG8_LAS unsigned*)(lds + (bufoff) + ldsw + _i * 8192), 16, 0, 0); } while (0)
#define PG8_LDA(dst, b, h) do { _Pragma("unroll") for (int m = 0; m < 4; ++m) _Pragma("unroll") for (int k = 0; k < 2; ++k) dst[m][k] = *(const PG8_LAS bf16x8*)(lds + PG8_SA(b, h) + aoff + m * 2048 + k * 1024); } while (0)
#define PG8_LDB(dst, b, h) do { _Pragma("unroll") for (int n = 0; n < 2; ++n) _Pragma("unroll") for (int k = 0; k < 2; ++k) dst[n][k] = *(const PG8_LAS bf16x8*)(lds + PG8_SB(b, h) + boff + n * 2048 + k * 1024); } while (0)
#define PG8_MMA(ai, bj, At, Bt) do { __builtin_amdgcn_s_setprio(1); _Pragma("unroll") for (int m = 0; m < 4; ++m) _Pragma("unroll") for (int n = 0; n < 2; ++n) _Pragma("unroll") for (int k = 0; k < 2; ++k) \
        acc[ai][bj][m][n] = __builtin_amdgcn_mfma_f32_16x16x32_bf16(Bt[n][k], At[m][k], acc[ai][bj][m][n], 0, 0, 0); __builtin_amdgcn_s_setprio(0); } while (0)
#define PG8_WAIT_V(n) asm volatile("s_waitcnt vmcnt(" #n ")" ::: "memory")
#define PG8_WAIT_L(n) asm volatile("s_waitcnt lgkmcnt(" #n ")" ::: "memory")
#define PG8_BAR __builtin_amdgcn_s_barrier()
#define PG8_SCHED __builtin_amdgcn_sched_barrier(0)
    Unit cur, nxt; int ui = 0;
    if (!S.next(0, cur)) return;
    f32x4 acc[2][2][4][2];
#pragma unroll
    for (int a = 0; a < 2; ++a)
#pragma unroll
        for (int b = 0; b < 2; ++b)
#pragma unroll
            for (int m = 0; m < 4; ++m)
#pragma unroll
                for (int n = 0; n < 2; ++n) acc[a][b][m][n] = (f32x4){0.f, 0.f, 0.f, 0.f};
    bf16x8 At[4][2], B0[2][2], B1[2][2];
    const char* cA = (const char*)g.A + (size_t)cur.pm * tstep; const char* cB = (const char*)g.Bt + (size_t)cur.pn * tstep;
    S.a_ready(cur);
    if constexpr (SP2) {
        PG8_STAGE(PG8_SB(0, 0), cB, voffB); PG8_STAGE(PG8_SB(0, 1), cB + hstep, voffB); PG8_STAGE(PG8_SA(0, 0), cA, voffA); PG8_STAGE(PG8_SA(0, 1), cA + hstep, voffA);
        if (wr == 1) PG8_BAR;
        PG8_WAIT_V(2); PG8_BAR;
        PG8_STAGE(PG8_SB(1, 0), cB + kstep, voffB); PG8_STAGE(PG8_SA(1, 0), cA + kstep, voffA); PG8_STAGE(PG8_SB(1, 1), cB + hstep + kstep, voffB);
        PG8_WAIT_V(6); PG8_BAR;
    } else {
        PG8_STAGE(PG8_SB(0, 0), cB, voffB); PG8_STAGE(PG8_SA(0, 0), cA, voffA); PG8_STAGE(PG8_SB(0, 1), cB + hstep, voffB); PG8_STAGE(PG8_SA(0, 1), cA + hstep, voffA);
        if (wr == 1) PG8_BAR;
        PG8_WAIT_V(4); PG8_BAR;
        PG8_STAGE(PG8_SB(1, 0), cB + kstep, voffB); PG8_STAGE(PG8_SA(1, 0), cA + kstep, voffA); PG8_STAGE(PG8_SB(1, 1), cB + hstep + kstep, voffB);
        PG8_WAIT_V(6); PG8_BAR;
    }
    for (;;) {
        const bool has_next = S.next(ui + 1, nxt);
        const char* nA = has_next ? (const char*)g.A + (size_t)nxt.pm * tstep : cA; const char* nB = has_next ? (const char*)g.Bt + (size_t)nxt.pn * tstep : cB;
        for (int t = 0; t < nt; t += 2) {
            if constexpr (Epi::MID_T > 0) { if (t == Epi::MID_T) E.mid(acc, cur, wr, wc, fr, fq); }
            const bool last = (t == nt - 2);
            const char* a1 = cA + (size_t)(t + 1) * kstep;
            const char* a2 = last ? nA : cA + (size_t)(t + 2) * kstep; const char* b2 = last ? nB : cB + (size_t)(t + 2) * kstep;
            const char* a3 = a2 + kstep; const char* b3 = b2 + kstep;
            if (last && has_next) S.a_ready(nxt);
            if constexpr (SP2) {
            PG8_LDB(B0, 0, 0); PG8_LDB(B1, 0, 1); PG8_SCHED; PG8_LDA(At, 0, 0); PG8_STAGE(PG8_SA(1, 1), a1 + hstep, voffA);
            PG8_WAIT_V(8); PG8_WAIT_L(0); PG8_BAR; PG8_MMA(0, 0, At, B0); PG8_MMA(0, 1, At, B1); PG8_BAR; PG8_SCHED;
            PG8_LDA(At, 0, 1); PG8_STAGE(PG8_SB(0, 0), b2, voffB); PG8_STAGE(PG8_SB(0, 1), b2 + hstep, voffB); PG8_STAGE(PG8_SA(0, 0), a2, voffA);
            PG8_WAIT_V(8); PG8_WAIT_L(0); PG8_BAR; PG8_MMA(1, 0, At, B0); PG8_MMA(1, 1, At, B1); PG8_BAR; PG8_SCHED;
            PG8_LDB(B0, 1, 0); PG8_LDB(B1, 1, 1); PG8_SCHED; PG8_LDA(At, 1, 0); PG8_STAGE(PG8_SA(0, 1), a2 + hstep, voffA);
            PG8_WAIT_V(8); PG8_WAIT_L(0); PG8_BAR; PG8_MMA(0, 0, At, B0); PG8_MMA(0, 1, At, B1); PG8_BAR; PG8_SCHED;
            PG8_LDA(At, 1, 1); PG8_STAGE(PG8_SB(1, 0), b3, voffB); PG8_STAGE(PG8_SB(1, 1), b3 + hstep, voffB); PG8_STAGE(PG8_SA(1, 0), a3, voffA);
            PG8_WAIT_V(8); PG8_WAIT_L(0); PG8_BAR; PG8_MMA(1, 0, At, B0); PG8_MMA(1, 1, At, B1); PG8_BAR; PG8_SCHED;
            } else {
            PG8_LDB(B0, 0, 0); PG8_SCHED; PG8_LDA(At, 0, 0); PG8_STAGE(PG8_SA(1, 1), a1 + hstep, voffA);
            PG8_WAIT_L(8); PG8_BAR; PG8_WAIT_L(0); PG8_MMA(0, 0, At, B0); PG8_BAR; PG8_SCHED;
            PG8_LDB(B1, 0, 1); PG8_STAGE(PG8_SB(0, 0), b2, voffB);
            PG8_BAR; PG8_WAIT_L(0); PG8_MMA(0, 1, At, B1); PG8_BAR;
            PG8_LDA(At, 0, 1); PG8_STAGE(PG8_SA(0, 0), a2, voffA);
            PG8_BAR; PG8_WAIT_L(0); PG8_MMA(1, 0, At, B0); PG8_BAR; PG8_SCHED;
            PG8_STAGE(PG8_SB(0, 1), b2 + hstep, voffB);
            PG8_WAIT_V(6); PG8_BAR; PG8_MMA(1, 1, At, B1); PG8_BAR;
            PG8_LDB(B0, 1, 0); PG8_SCHED; PG8_LDA(At, 1, 0); PG8_STAGE(PG8_SA(0, 1), a2 + hstep, voffA);
            PG8_WAIT_L(8); PG8_BAR; PG8_WAIT_L(0); PG8_MMA(0, 0, At, B0); PG8_BAR; PG8_SCHED;
            PG8_LDB(B1, 1, 1); PG8_STAGE(PG8_SB(1, 0), b3, voffB);
            PG8_BAR; PG8_WAIT_L(0); PG8_MMA(0, 1, At, B1); PG8_BAR;
            PG8_LDA(At, 1, 1); PG8_STAGE(PG8_SA(1, 0), a3, voffA);
            PG8_BAR; PG8_WAIT_L(0); PG8_MMA(1, 0, At, B0); PG8_BAR; PG8_SCHED;
            PG8_STAGE(PG8_SB(1, 1), b3 + hstep, voffB);
            PG8_WAIT_V(6); PG8_BAR; PG8_MMA(1, 1, At, B1); PG8_BAR;
            }
        }
        if constexpr (ALIGN_EPI) { if (wr == 0) PG8_BAR; }
        if constexpr (!Epi::AFTER_DRAIN) { E(acc, cur, wr, wc, fr, fq); S.done(cur); }
        if (!has_next) break;
#pragma unroll
        for (int a = 0; a < 2; ++a)
#pragma unroll
            for (int b = 0; b < 2; ++b)
#pragma unroll
                for (int m = 0; m < 4; ++m)
#pragma unroll
                    for (int n = 0; n < 2; ++n) acc[a][b][m][n] = (f32x4){0.f, 0.f, 0.f, 0.f};
        cur = nxt; cA = nA; cB = nB; ++ui;
        if constexpr (ALIGN_EPI) { if (wr == 1) PG8_BAR; }
    }
    PG8_WAIT_V(0);
    if constexpr (!ALIGN_EPI) { if (wr == 0) PG8_BAR; }
    PG8_BAR;
    if constexpr (Epi::AFTER_DRAIN) { E.fused(acc, cur, wr, wc, fr, fq, lds, wid, lane); S.done(cur); }
#undef PG8_SA
#undef PG8_SB
#undef PG8_STAGE
#undef PG8_LDA
#undef PG8_LDB
#undef PG8_MMA
#undef PG8_WAIT_V
#undef PG8_WAIT_L
#undef PG8_BAR
#undef PG8_SCHED
}


constexpr int MP_ROWS = 16384;

struct EpiProj {
    static constexpr bool PERM = true, AFTER_DRAIN = false; static constexpr int MID_T = 0;
    bf16_t* PA; bf16_t* PB; float* ALR;
    __device__ __forceinline__ void mid(f32x4 (&)[2][2][4][2], const Unit&, int, int, int, int) const {}
    __device__ __forceinline__ void operator()(const f32x4 (&acc)[2][2][4][2], const Unit& u, int wr, int wc, int fr, int fq) const {
        const int row0 = u.pm * BM + wr * 64 + fr;
        if (u.pn < 22) {
            bf16_t* base; int ldc, colt;
            if (u.pn < 14) { base = PA; ldc = 3584; colt = u.pn * BM; } else { base = PB; ldc = 2048; colt = (u.pn - 14) * BM; }
            const int col0 = colt + wc * 32 + 8 * fq;
#pragma unroll
            for (int ai = 0; ai < 2; ++ai)
#pragma unroll
                for (int m = 0; m < 4; ++m) { bf16_t* rowp = base + (size_t)(row0 + ai * HALF + m * 16) * ldc + col0;
#pragma unroll
                    for (int bj = 0; bj < 2; ++bj) { const f32x4 v0 = acc[ai][bj][m][0], v1 = acc[ai][bj][m][1];
                        u32x4 w; w.x = cvt_pk_bf16(v0[0], v0[1]); w.y = cvt_pk_bf16(v0[2], v0[3]); w.z = cvt_pk_bf16(v1[0], v1[1]); w.w = cvt_pk_bf16(v1[2], v1[3]);
                        *(u32x4*)(rowp + bj * HALF) = w; } }
        } else if (wc == 0 && fq < 2) {
#pragma unroll
            for (int ai = 0; ai < 2; ++ai)
#pragma unroll
                for (int m = 0; m < 4; ++m) { float* p = ALR + (size_t)(row0 + ai * HALF + m * 16) * 16 + 8 * fq;
                    *(f32x4*)p = acc[ai][0][m][0]; *(f32x4*)(p + 4) = acc[ai][0][m][1]; }
        }
    }
};
struct EpiMerge {
    static constexpr bool PERM = true, AFTER_DRAIN = false; static constexpr int MID_T = 8;
    const bf16_t* PB; bf16_t* O;
    __device__ __forceinline__ void mid(f32x4 (&acc)[2][2][4][2], const Unit& u, int wr, int wc, int fr_, int fq) const {
        int fr = fr_; asm volatile("" : "+v"(fr));
        const int row0 = u.pm * BM + wr * 64 + fr, col0 = u.pn * BM + wc * 32 + 8 * fq;
#pragma unroll
        for (int ai = 0; ai < 2; ++ai)
#pragma unroll
            for (int m = 0; m < 4; ++m) { const bf16_t* gp = PB + (size_t)(row0 + ai * HALF + m * 16) * 2048 + col0;
#pragma unroll
                for (int bj = 0; bj < 2; ++bj) { const u32x4 a8 = *(const u32x4*)(gp + bj * HALF), b8 = *(const u32x4*)(gp + 1024 + bj * HALF);
#pragma unroll
                    for (int e = 0; e < 4; ++e) { const unsigned aw = a8[e], bw = b8[e];
                        const float f0 = (1.0f + __expf(-bf_lo(bw))) / (1.0f + __expf(-bf_lo(aw))), f1 = (1.0f + __expf(-bf_hi(bw))) / (1.0f + __expf(-bf_hi(aw)));
                        acc[ai][bj][m][e >> 1][(e & 1) * 2] *= f0; acc[ai][bj][m][e >> 1][(e & 1) * 2 + 1] *= f1; } }
                asm volatile("" ::: "memory"); }
    }
    __device__ __forceinline__ void operator()(const f32x4 (&acc)[2][2][4][2], const Unit& u, int wr, int wc, int fr, int fq) const {
        const int row0 = u.pm * BM + wr * 64 + fr, col0 = u.pn * BM + wc * 32 + 8 * fq;
#pragma unroll
        for (int ai = 0; ai < 2; ++ai)
#pragma unroll
            for (int m = 0; m < 4; ++m) { const size_t r = (size_t)(row0 + ai * HALF + m * 16);
#pragma unroll
                for (int bj = 0; bj < 2; ++bj) { const u32x4 b8 = *(const u32x4*)(PB + r * 2048 + 1024 + col0 + bj * HALF);
                    const f32x4 v0 = acc[ai][bj][m][0], v1 = acc[ai][bj][m][1]; u32x4 w;
                    w.x = cvt_pk_bf16(v0[0] * sigm(bf_lo(b8.x)), v0[1] * sigm(bf_hi(b8.x))); w.y = cvt_pk_bf16(v0[2] * sigm(bf_lo(b8.y)), v0[3] * sigm(bf_hi(b8.y)));
                    w.z = cvt_pk_bf16(v1[0] * sigm(bf_lo(b8.z)), v1[1] * sigm(bf_hi(b8.z))); w.w = cvt_pk_bf16(v1[2] * sigm(bf_lo(b8.w)), v1[3] * sigm(bf_hi(b8.w)));
                    *(u32x4*)(O + r * 1024 + col0 + bj * HALF) = w; } }
    }
};
template <bool INPLACE> struct EpiRes {
    static constexpr bool PERM = false, AFTER_DRAIN = false; static constexpr int MID_T = 0;
    const float* xp; const float* xs; float* out; const float* gate;
    __device__ __forceinline__ void mid(f32x4 (&)[2][2][4][2], const Unit&, int, int, int, int) const {}
    __device__ __forceinline__ void operator()(const f32x4 (&acc)[2][2][4][2], const Unit& u, int wr, int wc, int fr, int fq) const {
        const int row0 = u.pm * BM + wr * 64 + fr, col0 = u.pn * BM + wc * 32 + 4 * fq;
#pragma unroll
        for (int ai = 0; ai < 2; ++ai)
#pragma unroll
            for (int m = 0; m < 4; ++m) { const int row = row0 + ai * HALF + m * 16; const int seq = row < MP_ROWS ? 0 : 1 + ((row - MP_ROWS) >> 4);
                const float* g = gate + (size_t)seq * 6144 + col0; float* op = out + (size_t)row * 1024 + col0;
                const float* bp = INPLACE ? (const float*)op : ((row < MP_ROWS ? xp + (size_t)row * 1024 : xs + (size_t)(row - MP_ROWS) * 1024) + col0);
#pragma unroll
                for (int bj = 0; bj < 2; ++bj)
#pragma unroll
                    for (int n = 0; n < 2; ++n) { const int c = bj * HALF + n * 16; const f32x4 bs = *(const f32x4*)(bp + c), gt = *(const f32x4*)(g + c);
                        *(f32x4*)(op + c) = bs + gt * acc[ai][bj][m][n]; }
                if (m & 1) asm volatile("" ::: "memory"); }
    }
};
struct EpiRelu2 {
    static constexpr bool PERM = true, AFTER_DRAIN = false; static constexpr int MID_T = 0;
    bf16_t* O;
    __device__ __forceinline__ void mid(f32x4 (&)[2][2][4][2], const Unit&, int, int, int, int) const {}
    __device__ __forceinline__ void operator()(const f32x4 (&acc)[2][2][4][2], const Unit& u, int wr, int wc, int fr, int fq) const {
        const int row0 = u.pm * BM + wr * 64 + fr, col0 = u.pn * BM + wc * 32 + 8 * fq;
#pragma unroll
        for (int ai = 0; ai < 2; ++ai)
#pragma unroll
            for (int m = 0; m < 4; ++m) { bf16_t* rowp = O + (size_t)(row0 + ai * HALF + m * 16) * 4096 + col0;
#pragma unroll
                for (int bj = 0; bj < 2; ++bj) { f32x4 v0 = acc[ai][bj][m][0], v1 = acc[ai][bj][m][1];
#pragma unroll
                    for (int e = 0; e < 4; ++e) { const float a = fmaxf(v0[e], 0.f), b = fmaxf(v1[e], 0.f); v0[e] = a * a; v1[e] = b * b; }
                    u32x4 w; w.x = cvt_pk_bf16(v0[0], v0[1]); w.y = cvt_pk_bf16(v0[2], v0[3]); w.z = cvt_pk_bf16(v1[0], v1[1]); w.w = cvt_pk_bf16(v1[2], v1[3]);
                    *(u32x4*)(rowp + bj * HALF) = w; } }
    }
};
}

#define LAS __attribute__((address_space(3)))
typedef unsigned short bf16;
typedef float f32x4 __attribute__((ext_vector_type(4)));
typedef float f32x2 __attribute__((ext_vector_type(2)));
typedef unsigned u32x4 __attribute__((ext_vector_type(4)));
typedef unsigned u32x2 __attribute__((ext_vector_type(2)));
typedef short bf16x8 __attribute__((ext_vector_type(8)));
typedef short s16x4 __attribute__((ext_vector_type(4)));

constexpr int DM = 1024, MP = 16384, NSEQ = 32, LSAMP = 16, MS = NSEQ * LSAMP, MT = MP + MS;
constexpr int NIN = 5888, KCAT = 1536, DFF = 4096, NMOD = 6144, NROWS_MOD = 33;
constexpr int PA_LD = 3584, PB_LD = 2048;
constexpr int NSC = 64;
constexpr float EPS = 1e-6f;
constexpr size_t MiB = 1u << 20;
constexpr size_t WS_MOD = 1 * MiB;
constexpr size_t WS_ALR = 2 * MiB;
constexpr size_t WS_GT = 4 * MiB;
constexpr size_t WS_WIN = 8 * MiB;
constexpr size_t WS_WCAT = 20 * MiB;
constexpr size_t WS_WOUT = 23 * MiB;
constexpr size_t WS_WFF1 = 25 * MiB;
constexpr size_t WS_WFF2 = 33 * MiB;
constexpr size_t WS_PB = 42 * MiB;
constexpr size_t WS_PA = 108 * MiB;
constexpr size_t WS_US = 224 * MiB;
constexpr size_t WS_MS = 5 * MiB;
constexpr size_t WS_H2S = 6 * MiB;
constexpr size_t WS_HIDS = 240 * MiB;
constexpr size_t WS_END = 256 * MiB;
constexpr size_t O_Y = 0, O_SGP = (size_t)MT * DM, O_CPP = O_SGP + 131072, O_SGS = O_CPP + 7680, O_CPS = O_SGS + (size_t)NSEQ * 131072;
constexpr int LDS_BYTES = 147456;

__device__ __forceinline__ float bf2f(unsigned short h) { return __uint_as_float((unsigned)h << 16); }
__device__ __forceinline__ unsigned f2bf(float f) { unsigned u = __float_as_uint(f); return (u + 0x7fffu + ((u >> 16) & 1u)) >> 16; }
__device__ __forceinline__ unsigned pk2(float lo, float hi) { return f2bf(lo) | (f2bf(hi) << 16); }
__device__ __forceinline__ float wave_sum(float v, int lane) {
#pragma unroll
    for (int o = 1; o < 64; o <<= 1) v += shfl_xor_l(v, o, lane);
    return v;
}
__device__ __forceinline__ float silu_f(float x) { return x / (1.0f + __expf(-x)); }

__device__ __forceinline__ void transpose_item(const float* W, int ldn, int k0, int c0, int valid, bf16* WT, int dld, int drow0, int dk0, LAS float* scr, int lane) {
    float tv[32];
#pragma unroll
    for (int i = 0; i < 32; ++i) { const int kk = 2 * i + (lane >> 5), n = lane & 31; tv[i] = n < valid ? W[(size_t)(k0 + kk) * ldn + c0 + n] : 0.f; }
#pragma unroll
    for (int i = 0; i < 32; ++i) { const int kk = 2 * i + (lane >> 5), n = lane & 31; scr[kk * 33 + n] = tv[i]; }
    asm volatile("s_waitcnt lgkmcnt(0)" ::: "memory");
    const int c = lane & 7;
#pragma unroll
    for (int j = 0; j < 4; ++j) { const int n = (lane >> 3) + 8 * j; const LAS float* s = scr + (8 * c) * 33 + n;
        u32x4 o; o.x = pk2(s[0 * 33], s[1 * 33]); o.y = pk2(s[2 * 33], s[3 * 33]); o.z = pk2(s[4 * 33], s[5 * 33]); o.w = pk2(s[6 * 33], s[7 * 33]);
        *(u32x4*)(WT + (size_t)(drow0 + n) * dld + dk0 + k0 + 8 * c) = o; }
    asm volatile("s_waitcnt lgkmcnt(0)" ::: "memory");
}

#define XB_TMO      128
#define XB_XCNT(j)  (256  + 64 * (j))
#define XB_XSUB(j)  (1280 + 64 * (j))
#define XB_XGEN(j)  (2304 + 64 * (j))
#define XB_TOP      3328
#define XB_TOPGEN   3392
#define XCD_BAR_WORDS 3456
#define XB_SPIN_CAP (1u << 18)

__device__ __forceinline__ unsigned xb_ld(unsigned* p)              { return __hip_atomic_load(p, __ATOMIC_RELAXED, __HIP_MEMORY_SCOPE_AGENT); }
__device__ __forceinline__ unsigned xb_add(unsigned* p, unsigned v) { return __hip_atomic_fetch_add(p, v, __ATOMIC_RELAXED, __HIP_MEMORY_SCOPE_AGENT); }
__device__ __forceinline__ unsigned xb_xcc_id() { return (unsigned)__builtin_amdgcn_s_getreg((3 << 11) | 20) & 0xFu; }
#define XB_SPIN(cond, bar) do { unsigned _sp = 0; while (cond) { __builtin_amdgcn_s_sleep(1); \
    if ((++_sp & 255u) == 0u) { if (xb_ld(&(bar)[XB_TMO])) break; if (_sp > XB_SPIN_CAP) { atomicAdd(&(bar)[XB_TMO], 1u); break; } } } } while (0)

struct XcdBarrier {
    unsigned* bar; unsigned x;
    volatile LAS unsigned* st;
};

__device__ __forceinline__ XcdBarrier xcd_barrier_post(unsigned* bar, volatile LAS unsigned* st, int tid) {
    XcdBarrier b; b.bar = bar; b.x = xb_xcc_id(); b.st = st;
    if (tid == 0) (void)xb_add(&bar[XB_XCNT(b.x)], 1u);
    return b;
}
__device__ __forceinline__ void xcd_barrier_complete(unsigned* bar, unsigned x, unsigned& nloc, unsigned& nx) {
    const unsigned G = gridDim.x * gridDim.y * gridDim.z;
    unsigned sum, cnt, mine, sp = 0u;
    for (;;) {
        sum = 0u; cnt = 0u; mine = 0u;
#pragma unroll
        for (unsigned j = 0; j < 16; ++j) { const unsigned c = xb_ld(&bar[XB_XCNT(j)]); sum += c; cnt += (c > 0u) ? 1u : 0u; mine = (j == x) ? c : mine; }
        if (sum == G) break;
        __builtin_amdgcn_s_sleep(1);
        if ((++sp & 255u) == 0u) { if (xb_ld(&bar[XB_TMO])) break; if (sp > XB_SPIN_CAP) { atomicAdd(&bar[XB_TMO], 1u); break; } }
    }
    nloc = mine > 0u ? mine : 1u; nx = cnt > 0u ? cnt : 1u;
}

__device__ __forceinline__ void xcd_barrier(const XcdBarrier& b, int tid) {
    asm volatile("s_waitcnt vmcnt(0)" ::: "memory");
    __syncthreads();
    if (tid == 0) {
        unsigned* bar = b.bar;
        __builtin_amdgcn_s_waitcnt(0);
        unsigned nloc = b.st[0], nx = b.st[1];
        if (nloc == 0u) { xcd_barrier_complete(bar, b.x, nloc, nx); b.st[0] = nloc; b.st[1] = nx; }
        const unsigned old = xb_add(&bar[XB_XSUB(b.x)], 1u);
        const unsigned gen = old / nloc;
        if (old + 1u == (gen + 1u) * nloc) {
            __builtin_amdgcn_fence(__ATOMIC_RELEASE, "agent");
            asm volatile("s_waitcnt vmcnt(0)" ::: "memory");
            const unsigned og = xb_add(&bar[XB_TOP], 1u);
            const unsigned tg = og / nx;
            if (og + 1u == (tg + 1u) * nx) xb_add(&bar[XB_TOPGEN], 1u);
            else XB_SPIN(xb_ld(&bar[XB_TOPGEN]) == tg, bar);
            __builtin_amdgcn_fence(__ATOMIC_ACQUIRE, "agent");
            xb_add(&bar[XB_XGEN(b.x)], 1u);
            asm volatile("s_waitcnt vmcnt(0)" ::: "memory");
        } else {
            XB_SPIN(xb_ld(&bar[XB_XGEN(b.x)]) == gen, bar);
            __builtin_amdgcn_fence(__ATOMIC_ACQUIRE, "agent");
            asm volatile("s_waitcnt vmcnt(0)" ::: "memory");
        }
    }
    __syncthreads();
}

struct Args { const float* in[22]; float* out; unsigned char* ws; };
__device__ __forceinline__ unsigned* bar_words() { const __attribute__((address_space(4))) Args* ap_ = (const __attribute__((address_space(4))) Args*)__builtin_amdgcn_kernarg_segment_ptr(); asm volatile("" : "+s"(ap_)); return (unsigned*)(ap_->ws); }
constexpr int LDS_BARST = 131072 + 512;


constexpr int G_QD = 0, G_KD = 17408, G_KPT = 34816, G_VT = 53248, G_ALR = 90112, G_PART = 94208, G_GL = 96256, G_SSQ = 96768;
#define MFMA16(a, b, c) __builtin_amdgcn_mfma_f32_16x16x32_bf16((a), (b), (c), 0, 0, 0)
__device__ __forceinline__ bf16x8 pack8(const f32x4& a, const f32x4& b) {
    u32x4 p; p.x = pk2(a[0], a[1]); p.y = pk2(a[2], a[3]); p.z = pk2(b[0], b[1]); p.w = pk2(b[2], b[3]); return __builtin_bit_cast(bf16x8, p);
}
template <bool DO_O>
__device__ __forceinline__ void gla_unit(LAS unsigned char* lds, const int tid_in, const int row0, const int nchunks, const int nvalid, const int h,
                                         const bf16* PA, const float* ALR, const float* w_alpha, const float* b_alpha, const float* gnorm,
                                         const float* Sinit, float* Sout, float* Gout, bf16* ACAT) {
    int tid = tid_in; asm volatile("" : "+v"(tid));
    const int lane = tid & 63, wid = tid >> 6, fr = lane & 15, fq = lane >> 4, dvb = wid * 32;
    f32x4 S[8][2];
#pragma unroll
    for (int kt = 0; kt < 8; ++kt)
#pragma unroll
        for (int dvt = 0; dvt < 2; ++dvt) {
            if (Sinit) {
#pragma unroll
                for (int r = 0; r < 4; ++r) S[kt][dvt][r] = Sinit[(size_t)(16 * kt + 4 * fq + r) * 256 + dvb + 16 * dvt + fr];
            } else S[kt][dvt] = (f32x4){0.f, 0.f, 0.f, 0.f};
        }
    const int dk = tid & 127, tq = tid >> 7;
    float gsum = 0.f;
    LAS bf16* QD = (LAS bf16*)(lds + G_QD); LAS bf16* KD = (LAS bf16*)(lds + G_KD);
    LAS float* ALRL = (LAS float*)(lds + G_ALR); LAS float* PART = (LAS float*)(lds + G_PART); LAS float* GL = (LAS float*)(lds + G_GL); LAS float* SSQ = (LAS float*)(lds + G_SSQ);
    for (int ch = 0; ch < nchunks; ++ch) {
        const int r0 = row0 + ch * 64;
        __syncthreads();
        if (tid < 256) { const int t = tid >> 2, part = tid & 3; f32x4 v = (f32x4){0.f, 0.f, 0.f, 0.f}; if (t < nvalid) v = *(const f32x4*)(ALR + (size_t)(r0 + t) * 16 + part * 4);
            *(LAS f32x4*)(ALRL + t * 16 + part * 4) = v; }
        unsigned short qv[16], kv[16];
#pragma unroll
        for (int i = 0; i < 16; ++i) { const int t = 16 * tq + i; qv[i] = 0; kv[i] = 0;
            if (t < nvalid) { const bf16* p = PA + (size_t)(r0 + t) * PA_LD + h * 128 + dk; qv[i] = p[512]; kv[i] = p[1024]; } }
        {
            const int dv2 = tid & 127, tg = tid >> 7; unsigned vv[16];
#pragma unroll
            for (int i = 0; i < 16; ++i) { const int t = 16 * tg + i; vv[i] = 0u; if (t < nvalid) vv[i] = *(const unsigned*)(PA + (size_t)(r0 + t) * PA_LD + 1536 + h * 256 + 2 * dv2); }
            u32x4 lo0, lo1, hi0, hi1;
#pragma unroll
            for (int j = 0; j < 4; ++j) { lo0[j] = (vv[2 * j] & 0xffffu) | (vv[2 * j + 1] << 16); hi0[j] = (vv[2 * j] >> 16) | (vv[2 * j + 1] & 0xffff0000u);
                lo1[j] = (vv[8 + 2 * j] & 0xffffu) | (vv[8 + 2 * j + 1] << 16); hi1[j] = (vv[8 + 2 * j] >> 16) | (vv[8 + 2 * j + 1] & 0xffff0000u); }
            LAS unsigned char* vt = lds + G_VT + (2 * dv2) * 144 + tg * 32;
            *(LAS u32x4*)(vt) = lo0; *(LAS u32x4*)(vt + 16) = lo1; *(LAS u32x4*)(vt + 144) = hi0; *(LAS u32x4*)(vt + 160) = hi1;
        }
        __syncthreads();
        const float* wa_ = w_alpha; asm volatile("" : "+s"(wa_));
        float wal[16];
#pragma unroll
        for (int r = 0; r < 16; ++r) wal[r] = wa_[r * 512 + h * 128 + dk];
        const float bal = b_alpha[h * 128 + dk];
        float bl[16]; float run = 0.f;
#pragma unroll
        for (int i = 0; i < 16; ++i) { const int t = 16 * tq + i; const LAS f32x4* ar = (const LAS f32x4*)(ALRL + t * 16); float x = bal;
#pragma unroll
            for (int j = 0; j < 4; ++j) { const f32x4 a4 = ar[j]; x += a4[0] * wal[4 * j] + a4[1] * wal[4 * j + 1] + a4[2] * wal[4 * j + 2] + a4[3] * wal[4 * j + 3]; }
            const float ls = fminf(x, 0.f) - log1pf(__expf(-fabsf(x)));
            run += (t < nvalid) ? ls * (1.0f / 16.0f) : 0.f; bl[i] = run; }
        PART[tq * 128 + dk] = run;
        __syncthreads();
        float off = 0.f, tot = 0.f;
#pragma unroll
        for (int t4 = 0; t4 < 4; ++t4) { const float p = PART[t4 * 128 + dk]; tot += p; off += (t4 < tq) ? p : 0.f; }
        unsigned kpk[8];
#pragma unroll
        for (int i = 0; i < 16; ++i) { const int t = 16 * tq + i; const float b = bl[i] + off; const float q = bf2f(qv[i]) * 0.08838834764831845f, k = bf2f(kv[i]);
            QD[t * 136 + dk] = (bf16)f2bf(q * __expf(b)); KD[t * 136 + dk] = (bf16)f2bf(k * __expf(-b));
            const unsigned kp = f2bf(k * __expf(tot - b)); if (i & 1) kpk[i >> 1] |= kp << 16; else kpk[i >> 1] = kp; }
        { LAS unsigned char* kp = lds + G_KPT + dk * 144 + tq * 32; *(LAS u32x4*)kp = (u32x4){kpk[0], kpk[1], kpk[2], kpk[3]}; *(LAS u32x4*)(kp + 16) = (u32x4){kpk[4], kpk[5], kpk[6], kpk[7]}; }
        if (tq == 0) GL[dk] = __expf(tot);
        gsum += tot;
        __syncthreads();
        if constexpr (DO_O) {
            f32x4 oT[4][2];
#pragma unroll
            for (int it = 0; it < 4; ++it) {
                oT[it][0] = (f32x4){0.f, 0.f, 0.f, 0.f}; oT[it][1] = (f32x4){0.f, 0.f, 0.f, 0.f};
#pragma unroll
                for (int jp = 0; jp < 2; ++jp) {
                    if (2 * jp > it) continue;
                    const int jt0 = 2 * jp, jt1 = 2 * jp + 1;
                    f32x4 P0 = (f32x4){0.f, 0.f, 0.f, 0.f}, P1 = (f32x4){0.f, 0.f, 0.f, 0.f};
#pragma unroll
                    for (int ks = 0; ks < 4; ++ks) {
                        const bf16x8 yq = *(const LAS bf16x8*)(lds + G_QD + (16 * it + fr) * 272 + (32 * ks + 8 * fq) * 2);
                        const bf16x8 x0 = *(const LAS bf16x8*)(lds + G_KD + (16 * jt0 + fr) * 272 + (32 * ks + 8 * fq) * 2);
                        P0 = MFMA16(x0, yq, P0);
                        if (jt1 <= it) { const bf16x8 x1 = *(const LAS bf16x8*)(lds + G_KD + (16 * jt1 + fr) * 272 + (32 * ks + 8 * fq) * 2); P1 = MFMA16(x1, yq, P1); }
                    }
                    if (jt0 == it) {
#pragma unroll
                        for (int r = 0; r < 4; ++r) if (fr < 4 * fq + r) P0[r] = 0.f;
                    }
                    if (jt1 == it) {
#pragma unroll
                        for (int r = 0; r < 4; ++r) if (fr < 4 * fq + r) P1[r] = 0.f;
                    }
                    const bf16x8 pb = pack8(P0, P1);
#pragma unroll
                    for (int dvt = 0; dvt < 2; ++dvt) {
                        const LAS unsigned char* vr = lds + G_VT + (dvb + 16 * dvt + fr) * 144;
                        const s16x4 a0 = *(const LAS s16x4*)(vr + (16 * jt0 + 4 * fq) * 2), a1 = *(const LAS s16x4*)(vr + (16 * jt1 + 4 * fq) * 2);
                        const bf16x8 xa = __builtin_shufflevector(a0, a1, 0, 1, 2, 3, 4, 5, 6, 7);
                        oT[it][dvt] = MFMA16(xa, pb, oT[it][dvt]);
                    }
                }
            }
#pragma unroll
            for (int kp = 0; kp < 4; ++kp) {
                const bf16x8 Sb0 = pack8(S[2 * kp][0], S[2 * kp + 1][0]), Sb1 = pack8(S[2 * kp][1], S[2 * kp + 1][1]);
#pragma unroll
                for (int it = 0; it < 4; ++it) {
                    const LAS unsigned char* qr = lds + G_QD + (16 * it + fr) * 272;
                    const s16x4 q0 = *(const LAS s16x4*)(qr + (32 * kp + 4 * fq) * 2), q1 = *(const LAS s16x4*)(qr + (32 * kp + 16 + 4 * fq) * 2);
                    const bf16x8 yq = __builtin_shufflevector(q0, q1, 0, 1, 2, 3, 4, 5, 6, 7);
                    oT[it][0] = MFMA16(Sb0, yq, oT[it][0]); oT[it][1] = MFMA16(Sb1, yq, oT[it][1]);
                }
            }
#pragma unroll
            for (int it = 0; it < 4; ++it) {
                float ss = 0.f;
#pragma unroll
                for (int dvt = 0; dvt < 2; ++dvt)
#pragma unroll
                    for (int r = 0; r < 4; ++r) ss += oT[it][dvt][r] * oT[it][dvt][r];
                ss += shfl_xor_l(ss, 16, lane); ss += shfl_xor_l(ss, 32, lane);
                if (fq == 0) SSQ[wid * 64 + 16 * it + fr] = ss;
            }
            __syncthreads();
            int r0o = r0; asm volatile("" : "+s"(r0o));
#pragma unroll
            for (int it = 0; it < 4; ++it) {
                const int tok = 16 * it + fr; float tss = 0.f;
#pragma unroll
                for (int w = 0; w < 8; ++w) tss += SSQ[w * 64 + tok];
                const float rstd = rsqrtf(tss * (1.0f / 256.0f) + EPS);
                if (tok < nvalid) {
#pragma unroll
                    for (int dvt = 0; dvt < 2; ++dvt) { const int dv0 = dvb + 16 * dvt + 4 * fq; const size_t row = (size_t)(r0o + tok);
                        const u32x2 g4 = *(const u32x2*)(PA + row * PA_LD + 2560 + h * 256 + dv0); const f32x4 gn = *(const f32x4*)(gnorm + dv0);
                        const f32x4 o = oT[it][dvt]; u32x2 w;
                        w.x = pk2(o[0] * rstd * gn[0] * silu_f(bf_lo(g4.x)), o[1] * rstd * gn[1] * silu_f(bf_hi(g4.x)));
                        w.y = pk2(o[2] * rstd * gn[2] * silu_f(bf_lo(g4.y)), o[3] * rstd * gn[3] * silu_f(bf_hi(g4.y)));
                        *(u32x2*)(ACAT + row * KCAT + 512 + h * 256 + dv0) = w; }
                }
            }
        }
#pragma unroll
        for (int kt = 0; kt < 8; ++kt) { const f32x4 gl = *(const LAS f32x4*)(GL + 16 * kt + 4 * fq); S[kt][0] *= gl; S[kt][1] *= gl; }
#pragma unroll
        for (int ks = 0; ks < 2; ++ks) {
            const bf16x8 yv0 = *(const LAS bf16x8*)(lds + G_VT + (dvb + fr) * 144 + (32 * ks + 8 * fq) * 2);
            const bf16x8 yv1 = *(const LAS bf16x8*)(lds + G_VT + (dvb + 16 + fr) * 144 + (32 * ks + 8 * fq) * 2);
#pragma unroll
            for (int kt = 0; kt < 8; ++kt) { const bf16x8 xk = *(const LAS bf16x8*)(lds + G_KPT + (16 * kt + fr) * 144 + (32 * ks + 8 * fq) * 2);
                S[kt][0] = MFMA16(xk, yv0, S[kt][0]); S[kt][1] = MFMA16(xk, yv1, S[kt][1]); }
        }
    }
    if (Sout) {
        int l2 = lane; asm volatile("" : "+v"(l2)); const int fr2 = l2 & 15, fq2 = l2 >> 4;
#pragma unroll
        for (int kt = 0; kt < 8; ++kt)
#pragma unroll
            for (int dvt = 0; dvt < 2; ++dvt)
#pragma unroll
                for (int r = 0; r < 4; ++r) Sout[(size_t)(16 * kt + 4 * fq2 + r) * 256 + dvb + 16 * dvt + fr2] = S[kt][dvt][r];
    }
    if (Gout && tq == 0) Gout[dk] = __expf(gsum);
}


template <int STEPS  >
__device__ __forceinline__ f32x4 tile_gemm(LAS unsigned char* lds, const int tid, const bf16* A, const int lda, const bf16* Bt, const int ldb, const int kbase) {
    const int lane = tid & 63, wid = tid >> 6, fr = lane & 15, fq = lane >> 4;
    const bf16* ap = A + (size_t)fr * lda + kbase + wid * (STEPS * 32) + 8 * fq;
    const bf16* bp = Bt + (size_t)fr * ldb + kbase + wid * (STEPS * 32) + 8 * fq;
    f32x4 acc[4][2];
#pragma unroll
    for (int mt = 0; mt < 4; ++mt) { acc[mt][0] = (f32x4){0.f, 0.f, 0.f, 0.f}; acc[mt][1] = (f32x4){0.f, 0.f, 0.f, 0.f}; }
    constexpr int GRP = STEPS < 4 ? STEPS : 4;
#pragma unroll 1
    for (int kb = 0; kb < STEPS / GRP; ++kb) {
        bf16x8 a[GRP][4], b[GRP][2];
#pragma unroll
        for (int ks = 0; ks < GRP; ++ks) {
#pragma unroll
            for (int mt = 0; mt < 4; ++mt) a[ks][mt] = *(const bf16x8*)(ap + (size_t)(16 * mt) * lda + 32 * (kb * GRP + ks));
#pragma unroll
            for (int nt = 0; nt < 2; ++nt) b[ks][nt] = *(const bf16x8*)(bp + (size_t)(16 * nt) * ldb + 32 * (kb * GRP + ks));
        }
#pragma unroll
        for (int ks = 0; ks < GRP; ++ks)
#pragma unroll
            for (int mt = 0; mt < 4; ++mt)
#pragma unroll
                for (int nt = 0; nt < 2; ++nt) acc[mt][nt] = MFMA16(b[ks][nt], a[ks][mt], acc[mt][nt]);
    }
    LAS float* RED = (LAS float*)lds;
#pragma unroll
    for (int mt = 0; mt < 4; ++mt)
#pragma unroll
        for (int nt = 0; nt < 2; ++nt) *(LAS f32x4*)(RED + ((wid * 64 + 16 * mt + fr) * 36 + 16 * nt + 4 * fq)) = acc[mt][nt];
    __syncthreads();
    const int tok = tid >> 3, c4 = (tid & 7) * 4; f32x4 sres = (f32x4){0.f, 0.f, 0.f, 0.f};
#pragma unroll
    for (int w = 0; w < 8; ++w) sres += *(const LAS f32x4*)(RED + ((w * 64 + tok) * 36 + c4));
    __syncthreads();
    return sres;
}

__device__ __forceinline__ void norm_row_bf16(const float* xrow, const float* g, const float* shift, const float* scale, bf16* orow, int lane) {
    const f32x4* xr = (const f32x4*)xrow + lane; f32x4 v[4]; float s = 0.f;
#pragma unroll
    for (int j = 0; j < 4; ++j) { v[j] = xr[64 * j]; s += (v[j][0] * v[j][0] + v[j][1] * v[j][1]) + (v[j][2] * v[j][2] + v[j][3] * v[j][3]); }
    const float rstd = rsqrtf(wave_sum(s, lane) * (1.0f / DM) + EPS);
#pragma unroll
    for (int j = 0; j < 4; ++j) { const int c = 4 * lane + 256 * j; const f32x4 gg = *(const f32x4*)(g + c), sh = *(const f32x4*)(shift + c), sc = *(const f32x4*)(scale + c);
        const f32x4 o = v[j] * rstd * gg * (1.0f + sc) + sh;
        u32x2 w; w.x = pk2(o[0], o[1]); w.y = pk2(o[2], o[3]); *(u32x2*)(orow + c) = w; }
}

__global__ void __launch_bounds__(512, 2) fwd_kernel(Args a) {
    extern __shared__ __attribute__((aligned(16))) unsigned char lds_raw[];
    cg::grid_group grid = cg::this_grid();
    LAS unsigned char* lds = (LAS unsigned char*)lds_raw;
    const int wave = __builtin_amdgcn_readfirstlane((int)threadIdx.x >> 6);
    const int G = gridDim.x, blk = blockIdx.x, gw = blk * 8 + wave, NGW = G * 8;
#ifndef PROBE_LO
#define PROBE_LO -1
#define PROBE_HI -1
#endif
    { const int t0_ = lane_id_fresh() + 64 * wave; if (t0_ < 2) ((LAS unsigned*)(lds + LDS_BARST))[t0_] = 0u; __syncthreads();
      (void)xcd_barrier_post(bar_words(), (volatile LAS unsigned*)(lds + LDS_BARST), t0_); }
    unsigned long long tA = 0, tB = 0;
    if (PROBE_LO == 0) tA = __builtin_amdgcn_s_memrealtime();
#define STAMP(k) do { if (PROBE_LO >= 0) { if ((k) == PROBE_LO - 1) tA = __builtin_amdgcn_s_memrealtime(); if ((k) == PROBE_HI) tB = __builtin_amdgcn_s_memrealtime(); } } while (0)
#define GRID_BAR() do { XcdBarrier b_; b_.bar = bar_words(); b_.x = xb_xcc_id(); b_.st = (volatile LAS unsigned*)(lds + LDS_BARST); xcd_barrier(b_, lane_id_fresh() + 64 * wave); } while (0)
#define FRESH_TID() const __attribute__((address_space(4))) Args* ap = (const __attribute__((address_space(4))) Args*)__builtin_amdgcn_kernarg_segment_ptr(); asm volatile("" : "+s"(ap)); int tid = lane_id_fresh() + 64 * wave; const int lane = tid & 63; (void)lane; (void)tid
#define ws (ap->ws)
#define out (ap->out)
#define x_prompt (ap->in[0])
#define x_sample (ap->in[1])
#define c_prompt (ap->in[2])
#define c_sample (ap->in[3])
#define state_gla (ap->in[4])
#define cache_pool (ap->in[5])
#define w_ada (ap->in[6])
#define b_ada (ap->in[7])
#define norm1_g (ap->in[8])
#define w_in (ap->in[9])
#define w_alpha (ap->in[10])
#define b_alpha (ap->in[11])
#define w_pool (ap->in[12])
#define pool_scale (ap->in[13])
#define gla_norm_g (ap->in[14])
#define w_pa (ap->in[15])
#define w_pb (ap->in[16])
#define w_out (ap->in[17])
#define norm2_g (ap->in[18])
#define w_ff1 (ap->in[19])
#define w_ff2 (ap->in[20])
#define final_g (ap->in[21])
#define MOD ((float*)(ws + WS_MOD))
#define ALR ((float*)(ws + WS_ALR))
#define GT ((float*)(ws + WS_GT))
#define Win_t ((bf16*)(ws + WS_WIN))
#define Wcat_t ((bf16*)(ws + WS_WCAT))
#define Wout_t ((bf16*)(ws + WS_WOUT))
#define Wff1_t ((bf16*)(ws + WS_WFF1))
#define Wff2_t ((bf16*)(ws + WS_WFF2))
#define PB ((bf16*)(ws + WS_PB))
#define PA ((bf16*)(ws + WS_PA))
#define US ((float*)(ws + WS_US))
#define MODP ((float*)(ws + WS_US))
#define H ((bf16*)out)
#define ACAT ((bf16*)out)
#define H2 ((bf16*)(ws + WS_PB))
#define MERGED ((bf16*)(ws + WS_PA))
#define HID ((bf16*)(ws + WS_PA))
#define Y (out + O_Y)
#define MERGED_S ((bf16*)(ws + WS_MS))
#define H2_S ((bf16*)(ws + WS_H2S))
#define HID_S ((bf16*)(ws + WS_HIDS))

    {
        FRESH_TID();
        LAS float* scr = (LAS float*)(lds + wave * 16384);
        constexpr int I_IN = 16 * 184, I_PB = 16 * 32, I_OUT = 16 * 32, I_F1 = 16 * 128, I_F2 = 64 * 32, I_WA = 1024, I_MOD = 96 * 16;
        constexpr int NITEMS = I_MOD + I_IN + I_PB + I_OUT + I_F1 + I_F2 + I_WA;
        for (int it = gw; it < NITEMS; it += NGW) {
            int r = it;
            if (r < I_MOD) {
                const int cgp = r % 96, ks = r / 96, k0 = 64 * ks, n = 64 * cgp + lane;
#pragma unroll 1
                for (int rr = 0; rr < NROWS_MOD; ++rr) { const float cv = rr == 0 ? c_prompt[k0 + lane] : c_sample[(size_t)(rr - 1) * DM + k0 + lane]; scr[rr * 64 + lane] = silu_f(cv); }
                asm volatile("s_waitcnt lgkmcnt(0)" ::: "memory");
                float acc[NROWS_MOD];
#pragma unroll
                for (int rr = 0; rr < NROWS_MOD; ++rr) acc[rr] = 0.f;
#pragma unroll
                for (int kb = 0; kb < 2; ++kb) { float wv[32];
#pragma unroll
                    for (int kk = 0; kk < 32; ++kk) wv[kk] = w_ada[(size_t)(k0 + kb * 32 + kk) * NMOD + n];
#pragma unroll
                    for (int kk = 0; kk < 32; ++kk)
#pragma unroll
                        for (int rr = 0; rr < NROWS_MOD; ++rr) acc[rr] += scr[rr * 64 + kb * 32 + kk] * wv[kk]; }
#pragma unroll
                for (int rr = 0; rr < NROWS_MOD; ++rr) MODP[((size_t)ks * NROWS_MOD + rr) * NMOD + n] = acc[rr];
                asm volatile("s_waitcnt lgkmcnt(0)" ::: "memory");
                continue;
            }
            r -= I_MOD;
            if (r < I_IN) { const int kb = r / 184, nb = r % 184; int c0, valid;
                if (nb < 112) { c0 = 32 * nb; valid = 32; } else if (nb < 176) { c0 = 32 * nb + 16; valid = 32; } else if (nb == 176) { c0 = 3584; valid = 16; } else { c0 = 0; valid = 0; }
                transpose_item(w_in, 5648, 64 * kb, c0, valid, Win_t, DM, 32 * nb, 0, scr, lane); continue; }
            r -= I_IN;
            if (r < I_PB) { transpose_item(w_pb, DM, 64 * (r / 32), 32 * (r % 32), 32, Wcat_t, KCAT, 32 * (r % 32), 512, scr, lane); continue; }
            r -= I_PB;
            if (r < I_OUT) { transpose_item(w_out, DM, 64 * (r / 32), 32 * (r % 32), 32, Wout_t, DM, 32 * (r % 32), 0, scr, lane); continue; }
            r -= I_OUT;
            if (r < I_F1) { transpose_item(w_ff1, DFF, 64 * (r / 128), 32 * (r % 128), 32, Wff1_t, DM, 32 * (r % 128), 0, scr, lane); continue; }
            r -= I_F1;
            if (r < I_F2) { transpose_item(w_ff2, DM, 64 * (r / 32), 32 * (r % 32), 32, Wff2_t, DFF, 32 * (r % 32), 0, scr, lane); continue; }
            r -= I_F2;
            {
                const int g = r >> 8, cb = (r >> 4) & 15, nb = r & 15, n = 64 * nb + lane, c0 = 8 * cb;
                float acc[8];
#pragma unroll
                for (int cc = 0; cc < 8; ++cc) acc[cc] = 0.f;
#pragma unroll 1
                for (int db = 0; db < 4; ++db) { float wp[32];
#pragma unroll
                    for (int d = 0; d < 32; ++d) wp[d] = w_pa[(size_t)(g * 128 + db * 32 + d) * DM + n] * pool_scale[g * 128 + db * 32 + d];
#pragma unroll
                    for (int d = 0; d < 32; ++d)
#pragma unroll
                        for (int cc = 0; cc < 8; ++cc) acc[cc] += w_pool[(size_t)(g * 128 + c0 + cc) * 128 + db * 32 + d] * wp[d]; }
                u32x4 o; o.x = pk2(acc[0], acc[1]); o.y = pk2(acc[2], acc[3]); o.z = pk2(acc[4], acc[5]); o.w = pk2(acc[6], acc[7]);
                *(u32x4*)(Wcat_t + (size_t)n * KCAT + g * 128 + c0) = o;
            }
        }
    }
    if (gridDim.x == 0x7fffffffu) grid.sync();
    GRID_BAR(); STAMP(0);
    { FRESH_TID();
    for (int i = blk * 512 + tid; i < NROWS_MOD * NMOD; i += G * 512) { float s = b_ada[i % NMOD];
#pragma unroll
        for (int ks = 0; ks < 16; ++ks) s += MODP[(size_t)ks * NROWS_MOD * NMOD + i];
        MOD[i] = s; } }
    GRID_BAR(); STAMP(1);
    { FRESH_TID();
    for (int m = gw; m < MT; m += NGW) { const int seq = m < MP ? 0 : 1 + ((m - MP) >> 4); const float* xr = m < MP ? x_prompt + (size_t)m * DM : x_sample + (size_t)(m - MP) * DM;
        norm_row_bf16(xr, norm1_g, MOD + (size_t)seq * NMOD, MOD + (size_t)seq * NMOD + 1024, H + (size_t)m * DM, lane); } }
    GRID_BAR(); STAMP(2);
    {
        FRESH_TID();
        pg8::Gemm g{H, Win_t, MT, NIN, DM}; pg8::StaticOrder S; S.init(MT, NIN, G, blk);
        pg8::EpiProj E{PA, PB, ALR};
        pg8::gemm_phase<pg8::EpiProj, pg8::StaticOrder, true, true>(lds, g, S, E, wave);
    }
    GRID_BAR(); STAMP(3);
    {
        FRESH_TID();
        for (int u = blk; u < NSC * 4; u += G) { const int sc2 = u >> 2, h2 = u & 3;
            gla_unit<false>(lds, tid, sc2 * 256, 4, 64, h2, PA, ALR, w_alpha, b_alpha, gla_norm_g, nullptr, US + (size_t)u * 32768, GT + (size_t)u * 128, ACAT); }
        for (int u = (G - 1 - blk); u < NSEQ * 4; u += G) { const int s = u >> 2, h = u & 3;
            gla_unit<true>(lds, tid, MP + s * 16, 1, 16, h, PA, ALR, w_alpha, b_alpha, gla_norm_g, state_gla + (size_t)u * 32768, out + O_SGS + (size_t)u * 32768, nullptr, ACAT); }
        for (int pt = blk; pt < MT / 16; pt += G) {
            const int rowb = pt * 16, c = tid, gi = c >> 7, w = 2 << gi; const bool samp = rowb >= MP; const int seq = samp ? (rowb - MP) >> 4 : 0;
            float e[31];
#pragma unroll
            for (int i = 0; i < 31; ++i) { const int j = i - 15; float v;
                if (j >= 0) v = bf2f(PA[(size_t)(rowb + j) * PA_LD + c]);
                else if (samp) v = cache_pool[((size_t)seq * 15 + (15 + j)) * 512 + c];
                else v = (rowb + j >= 0) ? bf2f(PA[(size_t)(rowb + j) * PA_LD + c]) : 0.f;
                e[i] = v; }
            float ps[32]; ps[0] = 0.f;
#pragma unroll
            for (int i = 0; i < 31; ++i) ps[i + 1] = ps[i] + e[i];
#pragma unroll
            for (int tl = 0; tl < 16; ++tl) { const int row = rowb + tl, a2 = 16 + tl; const float ut = e[15 + tl];
                const float lo = gi == 0 ? ps[a2 - 2] : gi == 1 ? ps[a2 - 4] : gi == 2 ? ps[a2 - 8] : ps[a2 - 16];
                const float cnt = samp ? (float)w : (float)((row + 1) < w ? (row + 1) : w);
                ACAT[(size_t)row * KCAT + c] = (bf16)f2bf((ps[a2] - lo) / cnt - ut);
                if (samp) { if (tl >= 1) out[O_CPS + ((size_t)seq * 15 + (tl - 1)) * 512 + c] = ut; }
                else if (row >= MP - 15) out[O_CPP + (size_t)(row - (MP - 15)) * 512 + c] = ut; }
        }
    }
    GRID_BAR(); STAMP(4);
    { FRESH_TID();
    for (int e = blk * 512 + tid; e < 131072; e += G * 512) { float S = 0.f; const int hd = __builtin_amdgcn_readfirstlane(e >> 8);
        float u[NSC];
#pragma unroll
        for (int sc = 0; sc < NSC; ++sc) u[sc] = US[(size_t)sc * 131072 + e];
#pragma unroll
        for (int sc = 0; sc < NSC; ++sc) { US[(size_t)sc * 131072 + e] = S; S = GT[sc * 512 + hd] * S + u[sc]; }
        out[O_SGP + e] = S; }
      for (int tl = blk; tl < 256; tl += G) { const int rb = tl & 7, cb = tl >> 3;
          const bf16* Ab = ACAT + (size_t)(MP + 64 * rb) * KCAT; const bf16* Bb = Wcat_t + (size_t)(32 * cb) * KCAT;
          const f32x4 accA = tile_gemm<2>(lds, tid, Ab, KCAT, Bb, KCAT, 0);
          const f32x4 accB = tile_gemm<4>(lds, tid, Ab, KCAT, Bb, KCAT, 512);
          const int rs = 64 * rb + (tid >> 3), col = 32 * cb + 4 * (tid & 7);
          const u32x2 ga = *(const u32x2*)(PB + (size_t)(MP + rs) * PB_LD + col), gb = *(const u32x2*)(PB + (size_t)(MP + rs) * PB_LD + 1024 + col);
          u32x2 w; w.x = pk2(sigm(bf_lo(ga.x)) * accA[0] + sigm(bf_lo(gb.x)) * accB[0], sigm(bf_hi(ga.x)) * accA[1] + sigm(bf_hi(gb.x)) * accB[1]);
          w.y = pk2(sigm(bf_lo(ga.y)) * accA[2] + sigm(bf_lo(gb.y)) * accB[2], sigm(bf_hi(ga.y)) * accA[3] + sigm(bf_hi(gb.y)) * accB[3]);
          *(u32x2*)(MERGED_S + (size_t)rs * DM + col) = w; } }
    GRID_BAR(); STAMP(5);
    { FRESH_TID();
    for (int u = blk; u < NSC * 4; u += G) { const int sc = u >> 2, h = u & 3;
        gla_unit<true>(lds, tid, sc * 256, 4, 64, h, PA, ALR, w_alpha, b_alpha, gla_norm_g, US + (size_t)u * 32768, nullptr, nullptr, ACAT); }
      __syncthreads();
      for (int tl = blk; tl < 256; tl += G) { const int rb = tl & 7, cb = tl >> 3;
          const f32x4 acc = tile_gemm<4>(lds, tid, MERGED_S + (size_t)(64 * rb) * DM, DM, Wout_t + (size_t)(32 * cb) * DM, DM, 0);
          const int rs = 64 * rb + (tid >> 3), col = 32 * cb + 4 * (tid & 7), seq = 1 + (rs >> 4);
          const f32x4 xb = *(const f32x4*)(x_sample + (size_t)rs * DM + col), gt = *(const f32x4*)(MOD + (size_t)seq * NMOD + 2048 + col);
          *(f32x4*)(Y + (size_t)(MP + rs) * DM + col) = xb + gt * acc; } }
    GRID_BAR(); STAMP(6);
    {
        FRESH_TID();
        pg8::Gemm g{ACAT, Wcat_t, MP, DM, KCAT}; pg8::StaticOrder S; S.init(MP, DM, G, blk);
        pg8::EpiMerge E{PB, MERGED};
        pg8::gemm_phase<pg8::EpiMerge, pg8::StaticOrder, true, true>(lds, g, S, E, wave);
        for (int m = gw; m < MS; m += NGW) { const int seq = 1 + (m >> 4);
            norm_row_bf16(Y + (size_t)(MP + m) * DM, norm2_g, MOD + (size_t)seq * NMOD + 3072, MOD + (size_t)seq * NMOD + 4096, H2_S + (size_t)m * DM, lane); }
    }
    GRID_BAR(); STAMP(7);
    {
        FRESH_TID();
        pg8::Gemm g{MERGED, Wout_t, MP, DM, DM}; pg8::StaticOrder S; S.init(MP, DM, G, blk);
        pg8::EpiRes<false> E{x_prompt, x_sample, Y, MOD + 2048};
        pg8::gemm_phase<pg8::EpiRes<false>, pg8::StaticOrder, true, true>(lds, g, S, E, wave);
        for (int tl = blk; tl < 1024; tl += G) { const int rb = tl & 7, cb = tl >> 3;
            const f32x4 acc = tile_gemm<4>(lds, tid, H2_S + (size_t)(64 * rb) * DM, DM, Wff1_t + (size_t)(32 * cb) * DM, DM, 0);
            const int rs = 64 * rb + (tid >> 3), col = 32 * cb + 4 * (tid & 7);
            const float r0 = fmaxf(acc[0], 0.f), r1 = fmaxf(acc[1], 0.f), r2 = fmaxf(acc[2], 0.f), r3 = fmaxf(acc[3], 0.f);
            u32x2 w; w.x = pk2(r0 * r0, r1 * r1); w.y = pk2(r2 * r2, r3 * r3);
            *(u32x2*)(HID_S + (size_t)rs * DFF + col) = w; }
    }
    GRID_BAR(); STAMP(8);
    { FRESH_TID();
    for (int m = gw; m < MP; m += NGW) { const int seq = 0;
        norm_row_bf16(Y + (size_t)m * DM, norm2_g, MOD + (size_t)seq * NMOD + 3072, MOD + (size_t)seq * NMOD + 4096, H2 + (size_t)m * DM, lane); }
      __syncthreads();
      for (int tl = blk; tl < 256; tl += G) { const int rb = tl & 7, cb = tl >> 3;
          const f32x4 acc = tile_gemm<16>(lds, tid, HID_S + (size_t)(64 * rb) * DFF, DFF, Wff2_t + (size_t)(32 * cb) * DFF, DFF, 0);
          const int rs = 64 * rb + (tid >> 3), col = 32 * cb + 4 * (tid & 7), seq = 1 + (rs >> 4);
          float* yp = Y + (size_t)(MP + rs) * DM + col; const f32x4 gt = *(const f32x4*)(MOD + (size_t)seq * NMOD + 5120 + col);
          *(f32x4*)yp = *(const f32x4*)yp + gt * acc; } }
    GRID_BAR(); STAMP(9);
    {
        FRESH_TID();
        pg8::Gemm g{H2, Wff1_t, MP, DFF, DM}; pg8::StaticOrder S; S.init(MP, DFF, G, blk);
        pg8::EpiRelu2 E{HID};
        pg8::gemm_phase<pg8::EpiRelu2, pg8::StaticOrder, true, true>(lds, g, S, E, wave);
        for (int m = gw; m < MS; m += NGW) { f32x4* xr = (f32x4*)(Y + (size_t)(MP + m) * DM) + lane; f32x4 v[4]; float sq = 0.f;
#pragma unroll
            for (int j = 0; j < 4; ++j) { v[j] = xr[64 * j]; sq += (v[j][0] * v[j][0] + v[j][1] * v[j][1]) + (v[j][2] * v[j][2] + v[j][3] * v[j][3]); }
            const float rstd = rsqrtf(wave_sum(sq, lane) * (1.0f / DM) + EPS);
#pragma unroll
            for (int j = 0; j < 4; ++j) { const f32x4 gg = *(const f32x4*)(final_g + 4 * lane + 256 * j); xr[64 * j] = v[j] * rstd * gg; } }
    }
    GRID_BAR(); STAMP(10);
    {
        FRESH_TID();
        pg8::Gemm g{HID, Wff2_t, MP, DM, DFF}; pg8::StaticOrder S; S.init(MP, DM, G, blk);
        pg8::EpiRes<true> E{nullptr, nullptr, Y, MOD + 5120};
        pg8::gemm_phase<pg8::EpiRes<true>, pg8::StaticOrder, true, true>(lds, g, S, E, wave);
    }
    GRID_BAR(); STAMP(11);
    { FRESH_TID();
    for (int m = gw; m < MP; m += NGW) { f32x4* xr = (f32x4*)(Y + (size_t)m * DM) + lane; f32x4 v[4]; float s = 0.f;
#pragma unroll
        for (int j = 0; j < 4; ++j) { v[j] = xr[64 * j]; s += (v[j][0] * v[j][0] + v[j][1] * v[j][1]) + (v[j][2] * v[j][2] + v[j][3] * v[j][3]); }
        const float rstd = rsqrtf(wave_sum(s, lane) * (1.0f / DM) + EPS);
#pragma unroll
        for (int j = 0; j < 4; ++j) { const f32x4 gg = *(const f32x4*)(final_g + 4 * lane + 256 * j); xr[64 * j] = v[j] * rstd * gg; } } }
    if (PROBE_LO >= 0) { if (PROBE_HI == 12) tB = __builtin_amdgcn_s_memrealtime(); if (blk == 0) { const unsigned long long t0 = __builtin_amdgcn_s_memrealtime(), w = 4ull * (tB - tA); while (__builtin_amdgcn_s_memrealtime() - t0 < w) __builtin_amdgcn_s_sleep(8); } }
}

#undef ws
#undef out
#undef x_prompt
#undef x_sample
#undef c_prompt
#undef c_sample
#undef state_gla
#undef cache_pool
#undef w_ada
#undef b_ada
#undef norm1_g
#undef w_in
#undef w_alpha
#undef b_alpha
#undef w_pool
#undef pool_scale
#undef gla_norm_g
#undef w_pa
#undef w_pb
#undef w_out
#undef norm2_g
#undef w_ff1
#undef w_ff2
#undef final_g
#undef MOD
#undef ALR
#undef GT
#undef Win_t
#undef Wcat_t
#undef Wout_t
#undef Wff1_t
#undef Wff2_t
#undef PB
#undef PA
#undef US
#undef MODP
#undef H
#undef ACAT
#undef H2
#undef MERGED
#undef HID
#undef Y
#undef MERGED_S
#undef H2_S
#undef HID_S
extern "C" void kernel_launch(void* const* d_in, const int* in_sizes, int n_in, void* d_out, int out_size, void* d_ws, size_t ws_size, hipStream_t stream) {
    static int grid = 0;
    if (grid == 0) {
        if (n_in != 22 || ws_size < WS_END) { fprintf(stderr, "kernel_launch: unexpected n_in %d / ws %zu\n", n_in, ws_size); grid = -1; return; }
        int dev = 0, cus = 0, per_cu = 0;
        hipGetDevice(&dev); hipDeviceGetAttribute(&cus, hipDeviceAttributeMultiprocessorCount, dev);
        if (hipFuncSetAttribute((const void*)fwd_kernel, hipFuncAttributeMaxDynamicSharedMemorySize, LDS_BYTES) != hipSuccess) { fprintf(stderr, "kernel_launch: hipFuncSetAttribute failed\n"); grid = -1; return; }
        if (hipOccupancyMaxActiveBlocksPerMultiprocessor(&per_cu, (const void*)fwd_kernel, 512, LDS_BYTES) != hipSuccess || per_cu < 1) { fprintf(stderr, "kernel_launch: occupancy query says %d\n", per_cu); per_cu = 1; }
        (void)hipGetLastError();
        grid = cus * 1;
    }
    if (grid < 0) return;
    if (hipMemsetAsync(d_ws, 0, 65536, stream) != hipSuccess) { fprintf(stderr, "kernel_launch: memset failed\n"); return; }
    Args a{};
    for (int i = 0; i < 22; ++i) a.in[i] = (const float*)d_in[i];
    a.out = (float*)d_out; a.ws = (unsigned char*)d_ws;
    void* args[] = {&a};
    hipError_t e = hipLaunchCooperativeKernel((const void*)fwd_kernel, dim3(grid), dim3(512), args, LDS_BYTES, stream);
    if (e != hipSuccess) fprintf(stderr, "kernel_launch: cooperative launch failed: %s (grid %d)\n", hipGetErrorString(e), grid);
}
```

```cpp
#include <hip/hip_runtime.h>
#include <hip/hip_cooperative_groups.h>
#include <cstdio>
#include <cstdint>
namespace cg = cooperative_groups;
__device__ __forceinline__ int lane_id_fresh() { int l; asm volatile("v_mbcnt_lo_u32_b32 %0, -1, 0\n\tv_mbcnt_hi_u32_b32 %0, -1, %0" : "=v"(l)); return l; }
__device__ __forceinline__ float shfl_xor_l(float v, int o, int lane) { return __int_as_float(__builtin_amdgcn_ds_bpermute((lane ^ o) << 2, __float_as_int(v))); }
__device__ __forceinline__ float bf_lo(unsigned w) { return __uint_as_float(w << 16); }
__device__ __forceinline__ float bf_hi(unsigned w) { return __uint_as_float(w & 0xffff0000u); }
__device__ __forceinline__ float sigm(float x) { return 1.0f / (1.0f + __expf(-x)); }
namespace pg8 {
#define PG8_LAS __attribute__((address_space(3)))
typedef unsigned short bf16_t;
typedef short bf16x8 __attribute__((ext_vector_type(8)));
typedef float f32x4 __attribute__((ext_vector_type(4)));
typedef unsigned u32x4 __attribute__((ext_vector_type(4)));
constexpr int BM = 256, BK = 64, HALF = 128, HTB = HALF * BK * 2  , STAGE_BYTES = 8 * HTB, NXCD = 8, WGM = 8;

__host__ __device__ __forceinline__ int lds_byte(int r, int c) { const int st = (r >> 4) * 2 + (c >> 5), rr = r & 15, cc = c & 31, ob = rr * 64 + cc * 2; return st * 1024 + (ob ^ (((ob >> 9) & 1) << 5)); }
__host__ __device__ __forceinline__ void stage_rc(int b, int& R, int& C) { const int st = b / 1024, sb = b % 1024, swz = sb ^ (((sb >> 9) & 1) << 5); R = (st >> 1) * 16 + swz / 64; C = (st & 1) * 32 + (swz % 64) / 2; }
__host__ __device__ __forceinline__ int perm32(int rho) { const int n = rho >> 4, i = rho & 15; return 8 * (i >> 2) + 4 * n + (i & 3); }

struct Unit { int pm, pn; };
struct Gemm { const bf16_t* A; const bf16_t* Bt; int M, N, K; };

struct StaticOrder {
    int nM, nN, nwg, G, c;
    __host__ __device__ void init(int M, int N, int G_, int c_) { nM = M / BM; nN = N / BM; nwg = nM * nN; G = G_; c = c_; }
    __host__ __device__ bool next(int i, Unit& u) const {
        const long L = (long)i * G + c; if (L >= nwg) return false;
        int wgid = (int)L; { const int q = nwg / NXCD, r = nwg % NXCD, xcd = wgid % NXCD, off = wgid / NXCD; wgid = (xcd < r ? xcd * (q + 1) : r * (q + 1) + (xcd - r) * q) + off; }
        const int nig = WGM * nN, gid = wgid / nig, fm = gid * WGM, gsz = (nM - fm) < WGM ? (nM - fm) : WGM;
        u.pm = fm + ((wgid % nig) % gsz); u.pn = (wgid % nig) / gsz; return true;
    }
    __device__ __forceinline__ void a_ready(const Unit&) const {}
    __device__ __forceinline__ void done(const Unit&) const {}
};

__device__ __forceinline__ unsigned cvt_pk_bf16(float lo, float hi) { unsigned r; asm volatile("v_cvt_pk_bf16_f32 %0, %1, %2" : "=v"(r) : "v"(lo), "v"(hi)); return r; }
template <class Epi, class Sched, bool ALIGN_EPI = false, bool SP2 = false>
__device__ __forceinline__ void gemm_phase(PG8_LAS unsigned char* lds, const Gemm g, const Sched& S, const Epi& E, const int wave_id) {
    int tid_ = lane_id_fresh() + 64 * wave_id;
    const int tid = tid_, wid = __builtin_amdgcn_readfirstlane(tid >> 6), lane = tid & 63, wr = wid >> 2, wc = wid & 3, fr = lane & 15, fq = lane >> 4;
    const int K = g.K, nt = K / BK;
    unsigned voffA[2], voffB[2];
#pragma unroll
    for (int i = 0; i < 2; ++i) { int R, C; stage_rc(tid * 16 + i * 8192, R, C); const int Rb = Epi::PERM ? ((R & ~31) + perm32(R & 31)) : R;
        voffA[i] = (unsigned)(R * K + C) * 2u; voffB[i] = (unsigned)(Rb * K + C) * 2u; }
    const size_t kstep = (size_t)(BK * 2);
    const size_t hstep = (size_t)HALF * K * 2;
    const size_t tstep = 2 * hstep;
    const unsigned ldsw = (unsigned)wid * 1024u;
    const int aoff = lds_byte(wr * 64 + fr, fq * 8), boff = lds_byte(wc * 32 + fr, fq * 8);
#define PG8_SA(b, h) (((b) * 2 + (h)) * HTB)
#define PG8_SB(b, h) ((4 + (b) * 2 + (h)) * HTB)
#define PG8_STAGE(bufoff, gbase, voff) do { _Pragma("unroll") for (int _i = 0; _i < 2; ++_i) \
        __builtin_amdgcn_global_load_lds((const unsigned*)((const char*)(gbase) + (voff)[_i]), (PG8_LAS unsigned*)(lds + (bufoff) + ldsw + _i * 8192), 16, 0, 0); } while (0)
#define PG8_LDA(dst, b, h) do { _Pragma("unroll") for (int m = 0; m < 4; ++m) _Pragma("unroll") for (int k = 0; k < 2; ++k) dst[m][k] = *(const PG8_LAS bf16x8*)(lds + PG8_SA(b, h) + aoff + m * 2048 + k * 1024); } while (0)
#define PG8_LDB(dst, b, h) do { _Pragma("unroll") for (int n = 0; n < 2; ++n) _Pragma("unroll") for (int k = 0; k < 2; ++k) dst[n][k] = *(const PG8_LAS bf16x8*)(lds + PG8_SB(b, h) + boff + n * 2048 + k * 1024); } while (0)
#define PG8_MMA(ai, bj, At, Bt) do { __builtin_amdgcn_s_setprio(1); _Pragma("unroll") for (int m = 0; m < 4; ++m) _Pragma("unroll") for (int n = 0; n < 2; ++n) _Pragma("unroll") for (int k = 0; k < 2; ++k) \
        acc[ai][bj][m][n] = __builtin_amdgcn_mfma_f32_16x16x32_bf16(Bt[n][k], At[m][k], acc[ai][bj][m][n], 0, 0, 0); __builtin_amdgcn_s_setprio(0); } while (0)
#define PG8_WAIT_V(n) asm volatile("s_waitcnt vmcnt(" #n ")" ::: "memory")
#define PG8_WAIT_L(n) asm volatile("s_waitcnt lgkmcnt(" #n ")" ::: "memory")
#define PG8_BAR __builtin_amdgcn_s_barrier()
#define PG8_SCHED __builtin_amdgcn_sched_barrier(0)
    Unit cur, nxt; int ui = 0;
    if (!S.next(0, cur)) return;
    f32x4 acc[2][2][4][2];
#pragma unroll
    for (int a = 0; a < 2; ++a)
#pragma unroll
        for (int b = 0; b < 2; ++b)
#pragma unroll
            for (int m = 0; m < 4; ++m)
#pragma unroll
                for (int n = 0; n < 2; ++n) acc[a][b][m][n] = (f32x4){0.f, 0.f, 0.f, 0.f};
    bf16x8 At[4][2], B0[2][2], B1[2][2];
    const char* cA = (const char*)g.A + (size_t)cur.pm * tstep; const char* cB = (const char*)g.Bt + (size_t)cur.pn * tstep;
    S.a_ready(cur);
    if constexpr (SP2) {
        PG8_STAGE(PG8_SB(0, 0), cB, voffB); PG8_STAGE(PG8_SB(0, 1), cB + hstep, voffB); PG8_STAGE(PG8_SA(0, 0), cA, voffA); PG8_STAGE(PG8_SA(0, 1), cA + hstep, voffA);
        if (wr == 1) PG8_BAR;
        PG8_WAIT_V(2); PG8_BAR;
        PG8_STAGE(PG8_SB(1, 0), cB + kstep, voffB); PG8_STAGE(PG8_SA(1, 0), cA + kstep, voffA); PG8_STAGE(PG8_SB(1, 1), cB + hstep + kstep, voffB);
        PG8_WAIT_V(6); PG8_BAR;
    } else {
        PG8_STAGE(PG8_SB(0, 0), cB, voffB); PG8_STAGE(PG8_SA(0, 0), cA, voffA); PG8_STAGE(PG8_SB(0, 1), cB + hstep, voffB); PG8_STAGE(PG8_SA(0, 1), cA + hstep, voffA);
        if (wr == 1) PG8_BAR;
        PG8_WAIT_V(4); PG8_BAR;
        PG8_STAGE(PG8_SB(1, 0), cB + kstep, voffB); PG8_STAGE(PG8_SA(1, 0), cA + kstep, voffA); PG8_STAGE(PG8_SB(1, 1), cB + hstep + kstep, voffB);
        PG8_WAIT_V(6); PG8_BAR;
    }
    for (;;) {
        const bool has_next = S.next(ui + 1, nxt);
        const char* nA = has_next ? (const char*)g.A + (size_t)nxt.pm * tstep : cA; const char* nB = has_next ? (const char*)g.Bt + (size_t)nxt.pn * tstep : cB;
        for (int t = 0; t < nt; t += 2) {
            if constexpr (Epi::MID_T > 0) { if (t == Epi::MID_T) E.mid(acc, cur, wr, wc, fr, fq); }
            const bool last = (t == nt - 2);
            const char* a1 = cA + (size_t)(t + 1) * kstep;
            const char* a2 = last ? nA : cA + (size_t)(t + 2) * kstep; const char* b2 = last ? nB : cB + (size_t)(t + 2) * kstep;
            const char* a3 = a2 + kstep; const char* b3 = b2 + kstep;
            if (last && has_next) S.a_ready(nxt);
            if constexpr (SP2) {
            PG8_LDB(B0, 0, 0); PG8_LDB(B1, 0, 1); PG8_SCHED; PG8_LDA(At, 0, 0); PG8_STAGE(PG8_SA(1, 1), a1 + hstep, voffA);
            PG8_WAIT_V(8); PG8_WAIT_L(0); PG8_BAR; PG8_MMA(0, 0, At, B0); PG8_MMA(0, 1, At, B1); PG8_BAR; PG8_SCHED;
            PG8_LDA(At, 0, 1); PG8_STAGE(PG8_SB(0, 0), b2, voffB); PG8_STAGE(PG8_SB(0, 1), b2 + hstep, voffB); PG8_STAGE(PG8_SA(0, 0), a2, voffA);
            PG8_WAIT_V(8); PG8_WAIT_L(0); PG8_BAR; PG8_MMA(1, 0, At, B0); PG8_MMA(1, 1, At, B1); PG8_BAR; PG8_SCHED;
            PG8_LDB(B0, 1, 0); PG8_LDB(B1, 1, 1); PG8_SCHED; PG8_LDA(At, 1, 0); PG8_STAGE(PG8_SA(0, 1), a2 + hstep, voffA);
            PG8_WAIT_V(8); PG8_WAIT_L(0); PG8_BAR; PG8_MMA(0, 0, At, B0); PG8_MMA(0, 1, At, B1); PG8_BAR; PG8_SCHED;
            PG8_LDA(At, 1, 1); PG8_STAGE(PG8_SB(1, 0), b3, voffB); PG8_STAGE(PG8_SB(1, 1), b3 + hstep, voffB); PG8_STAGE(PG8_SA(1, 0), a3, voffA);
            PG8_WAIT_V(8); PG8_WAIT_L(0); PG8_BAR; PG8_MMA(1, 0, At, B0); PG8_MMA(1, 1, At, B1); PG8_BAR; PG8_SCHED;
            } else {
            PG8_LDB(B0, 0, 0); PG8_SCHED; PG8_LDA(At, 0, 0); PG8_STAGE(PG8_SA(1, 1), a1 + hstep, voffA);
            PG8_WAIT_L(8); PG8_BAR; PG8_WAIT_L(0); PG8_MMA(0, 0, At, B0); PG8_BAR; PG8_SCHED;
            PG8_LDB(B1, 0, 1); PG8_STAGE(PG8_SB(0, 0), b2, voffB);
            PG8_BAR; PG8_WAIT_L(0); PG8_MMA(0, 1, At, B1); PG8_BAR;
            PG8_LDA(At, 0, 1); PG8_STAGE(PG8_SA(0, 0), a2, voffA);
            PG8_BAR; PG8_WAIT_L(0); PG8_MMA(1, 0, At, B0); PG8_BAR; PG8_SCHED;
            PG8_STAGE(PG8_SB(0, 1), b2 + hstep, voffB);
            PG8_WAIT_V(6); PG8_BAR; PG8_MMA(1, 1, At, B1); PG8_BAR;
            PG8_LDB(B0, 1, 0); PG8_SCHED; PG8_LDA(At, 1, 0); PG8_STAGE(PG8_SA(0, 1), a2 + hstep, voffA);
            PG8_WAIT_L(8); PG8_BAR; PG8_WAIT_L(0); PG8_MMA(0, 0, At, B0); PG8_BAR; PG8_SCHED;
            PG8_LDB(B1, 1, 1); PG8_STAGE(PG8_SB(1, 0), b3, voffB);
            PG8_BAR; PG8_WAIT_L(0); PG8_MMA(0, 1, At, B1); PG8_BAR;
            PG8_LDA(At, 1, 1); PG8_STAGE(PG8_SA(1, 0), a3, voffA);
            PG8_BAR; PG8_WAIT_L(0); PG8_MMA(1, 0, At, B0); PG8_BAR; PG8_SCHED;
            PG8_STAGE(PG8_SB(1, 1), b3 + hstep, voffB);
            PG8_WAIT_V(6); PG8_BAR; PG8_MMA(1, 1, At, B1); PG8_BAR;
            }
        }
        if constexpr (ALIGN_EPI) { if (wr == 0) PG8_BAR; }
        if constexpr (!Epi::AFTER_DRAIN) { E(acc, cur, wr, wc, fr, fq); S.done(cur); }
        if (!has_next) break;
#pragma unroll
        for (int a = 0; a < 2; ++a)
#pragma unroll
            for (int b = 0; b < 2; ++b)
#pragma unroll
                for (int m = 0; m < 4; ++m)
#pragma unroll
                    for (int n = 0; n < 2; ++n) acc[a][b][m][n] = (f32x4){0.f, 0.f, 0.f, 0.f};
        cur = nxt; cA = nA; cB = nB; ++ui;
        if constexpr (ALIGN_EPI) { if (wr == 1) PG8_BAR; }
    }
    PG8_WAIT_V(0);
    if constexpr (!ALIGN_EPI) { if (wr == 0) PG8_BAR; }
    PG8_BAR;
    if constexpr (Epi::AFTER_DRAIN) { E.fused(acc, cur, wr, wc, fr, fq, lds, wid, lane); S.done(cur); }
#undef PG8_SA
#undef PG8_SB
#undef PG8_STAGE
#undef PG8_LDA
#undef PG8_LDB
#undef PG8_MMA
#undef PG8_WAIT_V
#undef PG8_WAIT_L
#undef PG8_BAR
#undef PG8_SCHED
}


constexpr int MP_ROWS = 16384;

struct EpiProj {
    static constexpr bool PERM = true, AFTER_DRAIN = false; static constexpr int MID_T = 0;
    bf16_t* PA; bf16_t* PB; float* ALR;
    __device__ __forceinline__ void mid(f32x4 (&)[2][2][4][2], const Unit&, int, int, int, int) const {}
    __device__ __forceinline__ void operator()(const f32x4 (&acc)[2][2][4][2], const Unit& u, int wr, int wc, int fr, int fq) const {
        const int row0 = u.pm * BM + wr * 64 + fr;
        if (u.pn < 22) {
            bf16_t* base; int ldc, colt;
            if (u.pn < 14) { base = PA; ldc = 3584; colt = u.pn * BM; } else { base = PB; ldc = 2048; colt = (u.pn - 14) * BM; }
            const int col0 = colt + wc * 32 + 8 * fq;
#pragma unroll
            for (int ai = 0; ai < 2; ++ai)
#pragma unroll
                for (int m = 0; m < 4; ++m) { bf16_t* rowp = base + (size_t)(row0 + ai * HALF + m * 16) * ldc + col0;
#pragma unroll
                    for (int bj = 0; bj < 2; ++bj) { const f32x4 v0 = acc[ai][bj][m][0], v1 = acc[ai][bj][m][1];
                        u32x4 w; w.x = cvt_pk_bf16(v0[0], v0[1]); w.y = cvt_pk_bf16(v0[2], v0[3]); w.z = cvt_pk_bf16(v1[0], v1[1]); w.w = cvt_pk_bf16(v1[2], v1[3]);
                        *(u32x4*)(rowp + bj * HALF) = w; } }
        } else if (wc == 0 && fq < 2) {
#pragma unroll
            for (int ai = 0; ai < 2; ++ai)
#pragma unroll
                for (int m = 0; m < 4; ++m) { float* p = ALR + (size_t)(row0 + ai * HALF + m * 16) * 16 + 8 * fq;
                    *(f32x4*)p = acc[ai][0][m][0]; *(f32x4*)(p + 4) = acc[ai][0][m][1]; }
        }
    }
};
struct EpiMerge {
    static constexpr bool PERM = true, AFTER_DRAIN = false; static constexpr int MID_T = 8;
    const bf16_t* PB; bf16_t* O;
    __device__ __forceinline__ void mid(f32x4 (&acc)[2][2][4][2], const Unit& u, int wr, int wc, int fr_, int fq) const {
        int fr = fr_; asm volatile("" : "+v"(fr));
        const int row0 = u.pm * BM + wr * 64 + fr, col0 = u.pn * BM + wc * 32 + 8 * fq;
#pragma unroll
        for (int ai = 0; ai < 2; ++ai)
#pragma unroll
            for (int m = 0; m < 4; ++m) { const bf16_t* gp = PB + (size_t)(row0 + ai * HALF + m * 16) * 2048 + col0;
#pragma unroll
                for (int bj = 0; bj < 2; ++bj) { const u32x4 a8 = *(const u32x4*)(gp + bj * HALF), b8 = *(const u32x4*)(gp + 1024 + bj * HALF);
#pragma unroll
                    for (int e = 0; e < 4; ++e) { const unsigned aw = a8[e], bw = b8[e];
                        const float f0 = (1.0f + __expf(-bf_lo(bw))) / (1.0f + __expf(-bf_lo(aw))), f1 = (1.0f + __expf(-bf_hi(bw))) / (1.0f + __expf(-bf_hi(aw)));
                        acc[ai][bj][m][e >> 1][(e & 1) * 2] *= f0; acc[ai][bj][m][e >> 1][(e & 1) * 2 + 1] *= f1; } }
                asm volatile("" ::: "memory"); }
    }
    __device__ __forceinline__ void operator()(const f32x4 (&acc)[2][2][4][2], const Unit& u, int wr, int wc, int fr, int fq) const {
        const int row0 = u.pm * BM + wr * 64 + fr, col0 = u.pn * BM + wc * 32 + 8 * fq;
#pragma unroll
        for (int ai = 0; ai < 2; ++ai)
#pragma unroll
            for (int m = 0; m < 4; ++m) { const size_t r = (size_t)(row0 + ai * HALF + m * 16);
#pragma unroll
                for (int bj = 0; bj < 2; ++bj) { const u32x4 b8 = *(const u32x4*)(PB + r * 2048 + 1024 + col0 + bj * HALF);
                    const f32x4 v0 = acc[ai][bj][m][0], v1 = acc[ai][bj][m][1]; u32x4 w;
                    w.x = cvt_pk_bf16(v0[0] * sigm(bf_lo(b8.x)), v0[1] * sigm(bf_hi(b8.x))); w.y = cvt_pk_bf16(v0[2] * sigm(bf_lo(b8.y)), v0[3] * sigm(bf_hi(b8.y)));
                    w.z = cvt_pk_bf16(v1[0] * sigm(bf_lo(b8.z)), v1[1] * sigm(bf_hi(b8.z))); w.w = cvt_pk_bf16(v1[2] * sigm(bf_lo(b8.w)), v1[3] * sigm(bf_hi(b8.w)));
                    *(u32x4*)(O + r * 1024 + col0 + bj * HALF) = w; } }
    }
};
template <bool INPLACE> struct EpiRes {
    static constexpr bool PERM = false, AFTER_DRAIN = false; static constexpr int MID_T = 0;
    const float* xp; const float* xs; float* out; const float* gate;
    __device__ __forceinline__ void mid(f32x4 (&)[2][2][4][2], const Unit&, int, int, int, int) const {}
    __device__ __forceinline__ void operator()(const f32x4 (&acc)[2][2][4][2], const Unit& u, int wr, int wc, int fr, int fq) const {
        const int row0 = u.pm * BM + wr * 64 + fr, col0 = u.pn * BM + wc * 32 + 4 * fq;
#pragma unroll
        for (int ai = 0; ai < 2; ++ai)
#pragma unroll
            for (int m = 0; m < 4; ++m) { const int row = row0 + ai * HALF + m * 16; const int seq = row < MP_ROWS ? 0 : 1 + ((row - MP_ROWS) >> 4);
                const float* g = gate + (size_t)seq * 6144 + col0; float* op = out + (size_t)row * 1024 + col0;
                const float* bp = INPLACE ? (const float*)op : ((row < MP_ROWS ? xp + (size_t)row * 1024 : xs + (size_t)(row - MP_ROWS) * 1024) + col0);
#pragma unroll
                for (int bj = 0; bj < 2; ++bj)
#pragma unroll
                    for (int n = 0; n < 2; ++n) { const int c = bj * HALF + n * 16; const f32x4 bs = *(const f32x4*)(bp + c), gt = *(const f32x4*)(g + c);
                        *(f32x4*)(op + c) = bs + gt * acc[ai][bj][m][n]; }
                if (m & 1) asm volatile("" ::: "memory"); }
    }
};
struct EpiRelu2 {
    static constexpr bool PERM = true, AFTER_DRAIN = false; static constexpr int MID_T = 0;
    bf16_t* O;
    __device__ __forceinline__ void mid(f32x4 (&)[2][2][4][2], const Unit&, int, int, int, int) const {}
    __device__ __forceinline__ void operator()(const f32x4 (&acc)[2][2][4][2], const Unit& u, int wr, int wc, int fr, int fq) const {
        const int row0 = u.pm * BM + wr * 64 + fr, col0 = u.pn * BM + wc * 32 + 8 * fq;
#pragma unroll
        for (int ai = 0; ai < 2; ++ai)
#pragma unroll
            for (int m = 0; m < 4; ++m) { bf16_t* rowp = O + (size_t)(row0 + ai * HALF + m * 16) * 4096 + col0;
#pragma unroll
                for (int bj = 0; bj < 2; ++bj) { f32x4 v0 = acc[ai][bj][m][0], v1 = acc[ai][bj][m][1];
#pragma unroll
                    for (int e = 0; e < 4; ++e) { const float a = fmaxf(v0[e], 0.f), b = fmaxf(v1[e], 0.f); v0[e] = a * a; v1[e] = b * b; }
                    u32x4 w; w.x = cvt_pk_bf16(v0[0], v0[1]); w.y = cvt_pk_bf16(v0[2], v0[3]); w.z = cvt_pk_bf16(v1[0], v1[1]); w.w = cvt_pk_bf16(v1[2], v1[3]);
                    *(u32x4*)(rowp + bj * HALF) = w; } }
    }
};
}

#define LAS __attribute__((address_space(3)))
typedef unsigned short bf16;
typedef float f32x4 __attribute__((ext_vector_type(4)));
typedef float f32x2 __attribute__((ext_vector_type(2)));
typedef unsigned u32x4 __attribute__((ext_vector_type(4)));
typedef unsigned u32x2 __attribute__((ext_vector_type(2)));
typedef short bf16x8 __attribute__((ext_vector_type(8)));
typedef short s16x4 __attribute__((ext_vector_type(4)));

constexpr int DM = 1024, MP = 16384, NSEQ = 32, LSAMP = 16, MS = NSEQ * LSAMP, MT = MP + MS;
constexpr int NIN = 5888, KCAT = 1536, DFF = 4096, NMOD = 6144, NROWS_MOD = 33;
constexpr int PA_LD = 3584, PB_LD = 2048;
constexpr int NSC = 64;
constexpr float EPS = 1e-6f;
constexpr size_t MiB = 1u << 20;
constexpr size_t WS_MOD = 1 * MiB;
constexpr size_t WS_ALR = 2 * MiB;
constexpr size_t WS_GT = 4 * MiB;
constexpr size_t WS_WIN = 8 * MiB;
constexpr size_t WS_WCAT = 20 * MiB;
constexpr size_t WS_WOUT = 23 * MiB;
constexpr size_t WS_WFF1 = 25 * MiB;
constexpr size_t WS_WFF2 = 33 * MiB;
constexpr size_t WS_PB = 42 * MiB;
constexpr size_t WS_PA = 108 * MiB;
constexpr size_t WS_US = 224 * MiB;
constexpr size_t WS_MS = 5 * MiB;
constexpr size_t WS_H2S = 6 * MiB;
constexpr size_t WS_HIDS = 240 * MiB;
constexpr size_t WS_END = 256 * MiB;
constexpr size_t O_Y = 0, O_SGP = (size_t)MT * DM, O_CPP = O_SGP + 131072, O_SGS = O_CPP + 7680, O_CPS = O_SGS + (size_t)NSEQ * 131072;
constexpr int LDS_BYTES = 147456;

__device__ __forceinline__ float bf2f(unsigned short h) { return __uint_as_float((unsigned)h << 16); }
__device__ __forceinline__ unsigned f2bf(float f) { unsigned u = __float_as_uint(f); return (u + 0x7fffu + ((u >> 16) & 1u)) >> 16; }
__device__ __forceinline__ unsigned pk2(float lo, float hi) { return f2bf(lo) | (f2bf(hi) << 16); }
__device__ __forceinline__ float wave_sum(float v, int lane) {
#pragma unroll
    for (int o = 1; o < 64; o <<= 1) v += shfl_xor_l(v, o, lane);
    return v;
}
__device__ __forceinline__ float silu_f(float x) { return x / (1.0f + __expf(-x)); }

__device__ __forceinline__ void transpose_item(const float* W, int ldn, int k0, int c0, int valid, bf16* WT, int dld, int drow0, int dk0, LAS float* scr, int lane) {
    float tv[32];
#pragma unroll
    for (int i = 0; i < 32; ++i) { const int kk = 2 * i + (lane >> 5), n = lane & 31; tv[i] = n < valid ? W[(size_t)(k0 + kk) * ldn + c0 + n] : 0.f; }
#pragma unroll
    for (int i = 0; i < 32; ++i) { const int kk = 2 * i + (lane >> 5), n = lane & 31; scr[kk * 33 + n] = tv[i]; }
    asm volatile("s_waitcnt lgkmcnt(0)" ::: "memory");
    const int c = lane & 7;
#pragma unroll
    for (int j = 0; j < 4; ++j) { const int n = (lane >> 3) + 8 * j; const LAS float* s = scr + (8 * c) * 33 + n;
        u32x4 o; o.x = pk2(s[0 * 33], s[1 * 33]); o.y = pk2(s[2 * 33], s[3 * 33]); o.z = pk2(s[4 * 33], s[5 * 33]); o.w = pk2(s[6 * 33], s[7 * 33]);
        *(u32x4*)(WT + (size_t)(drow0 + n) * dld + dk0 + k0 + 8 * c) = o; }
    asm volatile("s_waitcnt lgkmcnt(0)" ::: "memory");
}

#define XB_TMO      128
#define XB_XCNT(j)  (256  + 64 * (j))
#define XB_XSUB(j)  (1280 + 64 * (j))
#define XB_XGEN(j)  (2304 + 64 * (j))
#define XB_TOP      3328
#define XB_TOPGEN   3392
#define XCD_BAR_WORDS 3456
#define XB_SPIN_CAP (1u << 18)

__device__ __forceinline__ unsigned xb_ld(unsigned* p)              { return __hip_atomic_load(p, __ATOMIC_RELAXED, __HIP_MEMORY_SCOPE_AGENT); }
__device__ __forceinline__ unsigned xb_add(unsigned* p, unsigned v) { return __hip_atomic_fetch_add(p, v, __ATOMIC_RELAXED, __HIP_MEMORY_SCOPE_AGENT); }
__device__ __forceinline__ unsigned xb_xcc_id() { return (unsigned)__builtin_amdgcn_s_getreg((3 << 11) | 20) & 0xFu; }
#define XB_SPIN(cond, bar) do { unsigned _sp = 0; while (cond) { __builtin_amdgcn_s_sleep(1); \
    if ((++_sp & 255u) == 0u) { if (xb_ld(&(bar)[XB_TMO])) break; if (_sp > XB_SPIN_CAP) { atomicAdd(&(bar)[XB_TMO], 1u); break; } } } } while (0)

struct XcdBarrier {
    unsigned* bar; unsigned x;
    volatile LAS unsigned* st;
};

__device__ __forceinline__ XcdBarrier xcd_barrier_post(unsigned* bar, volatile LAS unsigned* st, int tid) {
    XcdBarrier b; b.bar = bar; b.x = xb_xcc_id(); b.st = st;
    if (tid == 0) (void)xb_add(&bar[XB_XCNT(b.x)], 1u);
    return b;
}
__device__ __forceinline__ void xcd_barrier_complete(unsigned* bar, unsigned x, unsigned& nloc, unsigned& nx) {
    const unsigned G = gridDim.x * gridDim.y * gridDim.z;
    unsigned sum, cnt, mine, sp = 0u;
    for (;;) {
        sum = 0u; cnt = 0u; mine = 0u;
#pragma unroll
        for (unsigned j = 0; j < 16; ++j) { const unsigned c = xb_ld(&bar[XB_XCNT(j)]); sum += c; cnt += (c > 0u) ? 1u : 0u; mine = (j == x) ? c : mine; }
        if (sum == G) break;
        __builtin_amdgcn_s_sleep(1);
        if ((++sp & 255u) == 0u) { if (xb_ld(&bar[XB_TMO])) break; if (sp > XB_SPIN_CAP) { atomicAdd(&bar[XB_TMO], 1u); break; } }
    }
    nloc = mine > 0u ? mine : 1u; nx = cnt > 0u ? cnt : 1u;
}

__device__ __forceinline__ void xcd_barrier(const XcdBarrier& b, int tid) {
    asm volatile("s_waitcnt vmcnt(0)" ::: "memory");
    __syncthreads();
    if (tid == 0) {
        unsigned* bar = b.bar;
        __builtin_amdgcn_s_waitcnt(0);
        unsigned nloc = b.st[0], nx = b.st[1];
        if (nloc == 0u) { xcd_barrier_complete(bar, b.x, nloc, nx); b.st[0] = nloc; b.st[1] = nx; }
        const unsigned old = xb_add(&bar[XB_XSUB(b.x)], 1u);
        const unsigned gen = old / nloc;
        if (old + 1u == (gen + 1u) * nloc) {
            __builtin_amdgcn_fence(__ATOMIC_RELEASE, "agent");
            asm volatile("s_waitcnt vmcnt(0)" ::: "memory");
            const unsigned og = xb_add(&bar[XB_TOP], 1u);
            const unsigned tg = og / nx;
            if (og + 1u == (tg + 1u) * nx) xb_add(&bar[XB_TOPGEN], 1u);
            else XB_SPIN(xb_ld(&bar[XB_TOPGEN]) == tg, bar);
            __builtin_amdgcn_fence(__ATOMIC_ACQUIRE, "agent");
            xb_add(&bar[XB_XGEN(b.x)], 1u);
            asm volatile("s_waitcnt vmcnt(0)" ::: "memory");
        } else {
            XB_SPIN(xb_ld(&bar[XB_XGEN(b.x)]) == gen, bar);
            __builtin_amdgcn_fence(__ATOMIC_ACQUIRE, "agent");
            asm volatile("s_waitcnt vmcnt(0)" ::: "memory");
        }
    }
    __syncthreads();
}

struct Args { const float* in[22]; float* out; unsigned char* ws; };
__device__ __forceinline__ unsigned* bar_words() { const __attribute__((address_space(4))) Args* ap_ = (const __attribute__((address_space(4))) Args*)__builtin_amdgcn_kernarg_segment_ptr(); asm volatile("" : "+s"(ap_)); return (unsigned*)(ap_->ws); }
constexpr int LDS_BARST = 131072 + 512;


constexpr int G_QD = 0, G_KD = 17408, G_KPT = 34816, G_VT = 53248, G_ALR = 90112, G_PART = 94208, G_GL = 98304, G_SSQ = 98816, G_WAL = 100864, G_GN = 109056;
#define MFMA16(a, b, c) __builtin_amdgcn_mfma_f32_16x16x32_bf16((a), (b), (c), 0, 0, 0)
#define LBAR() do { asm volatile("s_waitcnt lgkmcnt(0)" ::: "memory"); __builtin_amdgcn_s_barrier(); asm volatile("" ::: "memory"); } while (0)
__device__ __forceinline__ bf16x8 pack8(const f32x4& a, const f32x4& b) {
    u32x4 p; p.x = pk2(a[0], a[1]); p.y = pk2(a[2], a[3]); p.z = pk2(b[0], b[1]); p.w = pk2(b[2], b[3]); return __builtin_bit_cast(bf16x8, p);
}
__device__ __forceinline__ float logsig16(float x) { return (fminf(x, 0.f) - __logf(1.0f + __expf(-fabsf(x)))) * (1.0f / 16.0f); }
template <bool DO_O>
__device__ __forceinline__ void gla_unit(LAS unsigned char* lds, const int tid_in, const int row0, const int nchunks, const int nvalid, const int h,
                                         const bf16* PA, const float* ALR, const float* w_alpha, const float* b_alpha, const float* gnorm,
                                         const float* Sinit, float* Sout, float* Gout, bf16* ACAT, unsigned long long& gacc) {
#ifndef PROBE_SUB
#define PROBE_SUB -1
#endif
    unsigned long long glast = 0; (void)glast;
#define GSTAMP(k) do { if (PROBE_SUB >= 0) { const unsigned long long t_ = __builtin_amdgcn_s_memrealtime(); if ((k) == PROBE_SUB) gacc += t_ - glast; glast = t_; } } while (0)
    const int tid = lane_id_fresh() + 64 * tid_in;
    const int lane = tid & 63, wid = tid >> 6, fr = lane & 15, fq = lane >> 4, dvb = wid * 32;
    LAS float* ALRL = (LAS float*)(lds + G_ALR); LAS float* PART = (LAS float*)(lds + G_PART); LAS float* GL = (LAS float*)(lds + G_GL); LAS float* SSQ = (LAS float*)(lds + G_SSQ);
    LAS float* WAL = (LAS float*)(lds + G_WAL); LAS float* GN = (LAS float*)(lds + G_GN);
    LBAR();
#pragma unroll
    for (int j = 0; j < 4; ++j) { const int i = tid + 512 * j; WAL[i] = w_alpha[(i >> 7) * 512 + h * 128 + (i & 127)]; }
    if (tid < 256) GN[tid] = gnorm[tid];
    f32x4 S[8][2];
#pragma unroll
    for (int kt = 0; kt < 8; ++kt)
#pragma unroll
        for (int dvt = 0; dvt < 2; ++dvt) {
            if (Sinit) {
#pragma unroll
                for (int r = 0; r < 4; ++r) S[kt][dvt][r] = Sinit[(size_t)(16 * kt + 4 * fq + r) * 256 + dvb + 16 * dvt + fr];
            } else S[kt][dvt] = (f32x4){0.f, 0.f, 0.f, 0.f};
        }
    const int dkp = tid & 63, tg = tid >> 6, dv2 = tid & 127, vg = tid >> 7;
    const f32x2 bal = *(const f32x2*)(b_alpha + h * 128 + 2 * dkp);
    float gsum0 = 0.f, gsum1 = 0.f;
    unsigned qc[8], kc[8], vc[16]; f32x2 ac;
#define GLA_LOAD(rbase) do { \
        _Pragma("unroll") for (int i = 0; i < 8; ++i) { const int t = 8 * tg + i; qc[i] = 0u; kc[i] = 0u; \
            if (t < nvalid) { const bf16* p_ = PA + (size_t)((rbase) + t) * PA_LD + h * 128 + 2 * dkp; qc[i] = *(const unsigned*)(p_ + 512); kc[i] = *(const unsigned*)(p_ + 1024); } } \
        _Pragma("unroll") for (int i = 0; i < 16; ++i) { const int t = 16 * vg + i; vc[i] = 0u; if (t < nvalid) vc[i] = *(const unsigned*)(PA + (size_t)((rbase) + t) * PA_LD + 1536 + h * 256 + 2 * dv2); } \
        int tl_ = tid; asm volatile("" : "+v"(tl_)); ac = (f32x2){0.f, 0.f}; if ((tl_ >> 3) < nvalid) ac = *(const f32x2*)(ALR + (size_t)((rbase) + (tl_ >> 3)) * 16 + (tl_ & 7) * 2); } while (0)
    GLA_LOAD(row0);
    for (int ch = 0; ch < nchunks; ++ch) {
        const int r0 = row0 + ch * 64;
        LBAR();
        GSTAMP(-2);
        *(LAS f32x2*)(ALRL + (tid >> 3) * 16 + (tid & 7) * 2) = ac;
        {
            u32x4 lo0, lo1, hi0, hi1;
#pragma unroll
            for (int j = 0; j < 4; ++j) { lo0[j] = (vc[2 * j] & 0xffffu) | (vc[2 * j + 1] << 16); hi0[j] = (vc[2 * j] >> 16) | (vc[2 * j + 1] & 0xffff0000u);
                lo1[j] = (vc[8 + 2 * j] & 0xffffu) | (vc[8 + 2 * j + 1] << 16); hi1[j] = (vc[8 + 2 * j] >> 16) | (vc[8 + 2 * j + 1] & 0xffff0000u); }
            LAS unsigned char* vt = lds + G_VT + (2 * dv2) * 144 + vg * 32;
            *(LAS u32x4*)(vt) = lo0; *(LAS u32x4*)(vt + 16) = lo1; *(LAS u32x4*)(vt + 144) = hi0; *(LAS u32x4*)(vt + 160) = hi1;
        }
        LBAR();
        GSTAMP(0);
        float bl0[8], bl1[8];
        {
            f32x2 wl[16];
#pragma unroll
            for (int r = 0; r < 16; ++r) wl[r] = *(const LAS f32x2*)(WAL + r * 128 + 2 * dkp);
            float run0 = 0.f, run1 = 0.f;
#pragma unroll
            for (int i = 0; i < 8; ++i) { const int t = 8 * tg + i; const LAS f32x4* ar = (const LAS f32x4*)(ALRL + t * 16); float x0 = bal[0], x1 = bal[1];
#pragma unroll
                for (int j = 0; j < 4; ++j) { const f32x4 a4 = ar[j];
#pragma unroll
                    for (int e = 0; e < 4; ++e) { x0 += a4[e] * wl[4 * j + e][0]; x1 += a4[e] * wl[4 * j + e][1]; } }
                const bool ok = t < nvalid; run0 += ok ? logsig16(x0) : 0.f; run1 += ok ? logsig16(x1) : 0.f; bl0[i] = run0; bl1[i] = run1; }
            *(LAS f32x2*)(PART + tg * 128 + 2 * dkp) = (f32x2){run0, run1};
        }
        LBAR();
        GSTAMP(1);
        {
            float off0 = 0.f, off1 = 0.f, tot0 = 0.f, tot1 = 0.f;
#pragma unroll
            for (int t8 = 0; t8 < 8; ++t8) { const f32x2 p = *(const LAS f32x2*)(PART + t8 * 128 + 2 * dkp); tot0 += p[0]; tot1 += p[1]; off0 += (t8 < tg) ? p[0] : 0.f; off1 += (t8 < tg) ? p[1] : 0.f; }
            unsigned kp0[4], kp1[4];
#pragma unroll
            for (int i = 0; i < 8; ++i) { const int t = 8 * tg + i; const float b0 = bl0[i] + off0, b1 = bl1[i] + off1;
                const float q0 = bf_lo(qc[i]) * 0.08838834764831845f, q1 = bf_hi(qc[i]) * 0.08838834764831845f, k0 = bf_lo(kc[i]), k1 = bf_hi(kc[i]);
                *(LAS unsigned*)(lds + G_QD + t * 272 + 4 * dkp) = pk2(q0 * __expf(b0), q1 * __expf(b1));
                *(LAS unsigned*)(lds + G_KD + t * 272 + 4 * dkp) = pk2(k0 * __expf(-b0), k1 * __expf(-b1));
                const unsigned a0 = f2bf(k0 * __expf(tot0 - b0)), a1 = f2bf(k1 * __expf(tot1 - b1));
                if (i & 1) { kp0[i >> 1] |= a0 << 16; kp1[i >> 1] |= a1 << 16; } else { kp0[i >> 1] = a0; kp1[i >> 1] = a1; } }
            LAS unsigned char* kp = lds + G_KPT + (2 * dkp) * 144 + tg * 16;
            *(LAS u32x4*)kp = (u32x4){kp0[0], kp0[1], kp0[2], kp0[3]}; *(LAS u32x4*)(kp + 144) = (u32x4){kp1[0], kp1[1], kp1[2], kp1[3]};
            if (tg == 0) *(LAS f32x2*)(GL + 2 * dkp) = (f32x2){__expf(tot0), __expf(tot1)};
            if constexpr (!DO_O) { gsum0 += tot0; gsum1 += tot1; }
        }
        LBAR();
        GSTAMP(2);
        u32x2 gq[4][2];
        if constexpr (!DO_O) { if (ch + 1 < nchunks) GLA_LOAD(r0 + 64); }
        if constexpr (DO_O) {
            f32x4 oT[4][2];
#pragma unroll
            for (int it = 0; it < 4; ++it) {
                oT[it][0] = (f32x4){0.f, 0.f, 0.f, 0.f}; oT[it][1] = (f32x4){0.f, 0.f, 0.f, 0.f};
#pragma unroll
                for (int jp = 0; jp < 2; ++jp) {
                    if (2 * jp > it) continue;
                    const int jt0 = 2 * jp, jt1 = 2 * jp + 1;
                    f32x4 P0 = (f32x4){0.f, 0.f, 0.f, 0.f}, P1 = (f32x4){0.f, 0.f, 0.f, 0.f};
#pragma unroll
                    for (int ks = 0; ks < 4; ++ks) {
                        const bf16x8 yq = *(const LAS bf16x8*)(lds + G_QD + (16 * it + fr) * 272 + (32 * ks + 8 * fq) * 2);
                        const bf16x8 x0 = *(const LAS bf16x8*)(lds + G_KD + (16 * jt0 + fr) * 272 + (32 * ks + 8 * fq) * 2);
                        P0 = MFMA16(x0, yq, P0);
                        if (jt1 <= it) { const bf16x8 x1 = *(const LAS bf16x8*)(lds + G_KD + (16 * jt1 + fr) * 272 + (32 * ks + 8 * fq) * 2); P1 = MFMA16(x1, yq, P1); }
                    }
                    if (jt0 == it) {
#pragma unroll
                        for (int r = 0; r < 4; ++r) if (fr < 4 * fq + r) P0[r] = 0.f;
                    }
                    if (jt1 == it) {
#pragma unroll
                        for (int r = 0; r < 4; ++r) if (fr < 4 * fq + r) P1[r] = 0.f;
                    }
                    const bf16x8 pb = pack8(P0, P1);
#pragma unroll
                    for (int dvt = 0; dvt < 2; ++dvt) {
                        const LAS unsigned char* vr = lds + G_VT + (dvb + 16 * dvt + fr) * 144;
                        const s16x4 a0 = *(const LAS s16x4*)(vr + (16 * jt0 + 4 * fq) * 2), a1 = *(const LAS s16x4*)(vr + (16 * jt1 + 4 * fq) * 2);
                        const bf16x8 xa = __builtin_shufflevector(a0, a1, 0, 1, 2, 3, 4, 5, 6, 7);
                        oT[it][dvt] = MFMA16(xa, pb, oT[it][dvt]);
                    }
                }
            }
            asm volatile("" ::: "memory");
#pragma unroll
            for (int it = 0; it < 4; ++it)
#pragma unroll
                for (int dvt = 0; dvt < 2; ++dvt) { gq[it][dvt] = (u32x2){0u, 0u};
                    if (16 * it + fr < nvalid) gq[it][dvt] = *(const u32x2*)(PA + (size_t)(r0 + 16 * it + fr) * PA_LD + 2560 + h * 256 + dvb + 16 * dvt + 4 * fq); }
            if (ch + 1 < nchunks) GLA_LOAD(r0 + 64);
            asm volatile("" ::: "memory");
#pragma unroll
            for (int kp = 0; kp < 4; ++kp) {
                const bf16x8 Sb0 = pack8(S[2 * kp][0], S[2 * kp + 1][0]), Sb1 = pack8(S[2 * kp][1], S[2 * kp + 1][1]);
#pragma unroll
                for (int it = 0; it < 4; ++it) {
                    const LAS unsigned char* qr = lds + G_QD + (16 * it + fr) * 272;
                    const s16x4 q0 = *(const LAS s16x4*)(qr + (32 * kp + 4 * fq) * 2), q1 = *(const LAS s16x4*)(qr + (32 * kp + 16 + 4 * fq) * 2);
                    const bf16x8 yq = __builtin_shufflevector(q0, q1, 0, 1, 2, 3, 4, 5, 6, 7);
                    oT[it][0] = MFMA16(Sb0, yq, oT[it][0]); oT[it][1] = MFMA16(Sb1, yq, oT[it][1]);
                }
            }
#pragma unroll
            for (int it = 0; it < 4; ++it) {
                float ss = 0.f;
#pragma unroll
                for (int dvt = 0; dvt < 2; ++dvt)
#pragma unroll
                    for (int r = 0; r < 4; ++r) ss += oT[it][dvt][r] * oT[it][dvt][r];
                ss += shfl_xor_l(ss, 16, lane); ss += shfl_xor_l(ss, 32, lane);
                if (fq == 0) SSQ[wid * 64 + 16 * it + fr] = ss;
            }
            LBAR();
            GSTAMP(3);
            int r0o = r0; asm volatile("" : "+s"(r0o));
#pragma unroll
            for (int it = 0; it < 4; ++it) {
                const int tok = 16 * it + fr; float tss = 0.f;
#pragma unroll
                for (int w = 0; w < 8; ++w) tss += SSQ[w * 64 + tok];
                const float rstd = rsqrtf(tss * (1.0f / 256.0f) + EPS);
                if (tok < nvalid) {
#pragma unroll
                    for (int dvt = 0; dvt < 2; ++dvt) { const int dv0 = dvb + 16 * dvt + 4 * fq; const size_t row = (size_t)(r0o + tok);
                        const u32x2 g4 = gq[it][dvt]; const f32x4 gn = *(const LAS f32x4*)(GN + dv0);
                        const f32x4 o = oT[it][dvt]; u32x2 w;
                        w.x = pk2(o[0] * rstd * gn[0] * silu_f(bf_lo(g4.x)), o[1] * rstd * gn[1] * silu_f(bf_hi(g4.x)));
                        w.y = pk2(o[2] * rstd * gn[2] * silu_f(bf_lo(g4.y)), o[3] * rstd * gn[3] * silu_f(bf_hi(g4.y)));
                        *(u32x2*)(ACAT + row * KCAT + 512 + h * 256 + dv0) = w; }
                }
            }
        }
        GSTAMP(4);
#pragma unroll
        for (int kt = 0; kt < 8; ++kt) { const f32x4 gl = *(const LAS f32x4*)(GL + 16 * kt + 4 * fq); S[kt][0] *= gl; S[kt][1] *= gl; }
#pragma unroll
        for (int ks = 0; ks < 2; ++ks) {
            const bf16x8 yv0 = *(const LAS bf16x8*)(lds + G_VT + (dvb + fr) * 144 + (32 * ks + 8 * fq) * 2);
            const bf16x8 yv1 = *(const LAS bf16x8*)(lds + G_VT + (dvb + 16 + fr) * 144 + (32 * ks + 8 * fq) * 2);
#pragma unroll
            for (int kt = 0; kt < 8; ++kt) { const bf16x8 xk = *(const LAS bf16x8*)(lds + G_KPT + (16 * kt + fr) * 144 + (32 * ks + 8 * fq) * 2);
                S[kt][0] = MFMA16(xk, yv0, S[kt][0]); S[kt][1] = MFMA16(xk, yv1, S[kt][1]); }
        }
        GSTAMP(5);
    }
#undef GLA_LOAD
    if (Sout) {
        int l2 = lane; asm volatile("" : "+v"(l2)); const int fr2 = l2 & 15, fq2 = l2 >> 4;
#pragma unroll
        for (int kt = 0; kt < 8; ++kt)
#pragma unroll
            for (int dvt = 0; dvt < 2; ++dvt)
#pragma unroll
                for (int r = 0; r < 4; ++r) Sout[(size_t)(16 * kt + 4 * fq2 + r) * 256 + dvb + 16 * dvt + fr2] = S[kt][dvt][r];
    }
    if constexpr (!DO_O) { if (Gout && tg == 0) *(f32x2*)(Gout + 2 * dkp) = (f32x2){__expf(gsum0), __expf(gsum1)}; }
}

template <int STEPS  >
__device__ __forceinline__ f32x4 tile_gemm(LAS unsigned char* lds, const int tid, const bf16* A, const int lda, const bf16* Bt, const int ldb, const int kbase) {
    const int lane = tid & 63, wid = tid >> 6, fr = lane & 15, fq = lane >> 4;
    const bf16* ap = A + (size_t)fr * lda + kbase + wid * (STEPS * 32) + 8 * fq;
    const bf16* bp = Bt + (size_t)fr * ldb + kbase + wid * (STEPS * 32) + 8 * fq;
    f32x4 acc[4][2];
#pragma unroll
    for (int mt = 0; mt < 4; ++mt) { acc[mt][0] = (f32x4){0.f, 0.f, 0.f, 0.f}; acc[mt][1] = (f32x4){0.f, 0.f, 0.f, 0.f}; }
    constexpr int GRP = STEPS < 4 ? STEPS : 4;
#pragma unroll 1
    for (int kb = 0; kb < STEPS / GRP; ++kb) {
        bf16x8 a[GRP][4], b[GRP][2];
#pragma unroll
        for (int ks = 0; ks < GRP; ++ks) {
#pragma unroll
            for (int mt = 0; mt < 4; ++mt) a[ks][mt] = *(const bf16x8*)(ap + (size_t)(16 * mt) * lda + 32 * (kb * GRP + ks));
#pragma unroll
            for (int nt = 0; nt < 2; ++nt) b[ks][nt] = *(const bf16x8*)(bp + (size_t)(16 * nt) * ldb + 32 * (kb * GRP + ks));
        }
#pragma unroll
        for (int ks = 0; ks < GRP; ++ks)
#pragma unroll
            for (int mt = 0; mt < 4; ++mt)
#pragma unroll
                for (int nt = 0; nt < 2; ++nt) acc[mt][nt] = MFMA16(b[ks][nt], a[ks][mt], acc[mt][nt]);
    }
    LAS float* RED = (LAS float*)lds;
#pragma unroll
    for (int mt = 0; mt < 4; ++mt)
#pragma unroll
        for (int nt = 0; nt < 2; ++nt) *(LAS f32x4*)(RED + ((wid * 64 + 16 * mt + fr) * 36 + 16 * nt + 4 * fq)) = acc[mt][nt];
    __syncthreads();
    const int tok = tid >> 3, c4 = (tid & 7) * 4; f32x4 sres = (f32x4){0.f, 0.f, 0.f, 0.f};
#pragma unroll
    for (int w = 0; w < 8; ++w) sres += *(const LAS f32x4*)(RED + ((w * 64 + tok) * 36 + c4));
    __syncthreads();
    return sres;
}

__device__ __forceinline__ void norm_row_bf16(const float* xrow, const float* g, const float* shift, const float* scale, bf16* orow, int lane) {
    const f32x4* xr = (const f32x4*)xrow + lane; f32x4 v[4]; float s = 0.f;
#pragma unroll
    for (int j = 0; j < 4; ++j) { v[j] = xr[64 * j]; s += (v[j][0] * v[j][0] + v[j][1] * v[j][1]) + (v[j][2] * v[j][2] + v[j][3] * v[j][3]); }
    const float rstd = rsqrtf(wave_sum(s, lane) * (1.0f / DM) + EPS);
#pragma unroll
    for (int j = 0; j < 4; ++j) { const int c = 4 * lane + 256 * j; const f32x4 gg = *(const f32x4*)(g + c), sh = *(const f32x4*)(shift + c), sc = *(const f32x4*)(scale + c);
        const f32x4 o = v[j] * rstd * gg * (1.0f + sc) + sh;
        u32x2 w; w.x = pk2(o[0], o[1]); w.y = pk2(o[2], o[3]); *(u32x2*)(orow + c) = w; }
}

__global__ void __launch_bounds__(512, 2) fwd_kernel(Args a) {
    extern __shared__ __attribute__((aligned(16))) unsigned char lds_raw[];
    cg::grid_group grid = cg::this_grid();
    LAS unsigned char* lds = (LAS unsigned char*)lds_raw;
    const int wave = __builtin_amdgcn_readfirstlane((int)threadIdx.x >> 6);
    const int G = gridDim.x, blk = blockIdx.x, gw = blk * 8 + wave, NGW = G * 8;
#ifndef PROBE_LO
#define PROBE_LO -1
#define PROBE_HI -1
#endif
    { const int t0_ = lane_id_fresh() + 64 * wave; if (t0_ < 2) ((LAS unsigned*)(lds + LDS_BARST))[t0_] = 0u; __syncthreads();
      (void)xcd_barrier_post(bar_words(), (volatile LAS unsigned*)(lds + LDS_BARST), t0_); }
    unsigned long long tA = 0, tB = 0, gacc5 = 0, gdummy = 0; (void)gdummy;
    if (PROBE_LO == 0) tA = __builtin_amdgcn_s_memrealtime();
#define STAMP(k) do { if (PROBE_LO >= 0) { if ((k) == PROBE_LO - 1) tA = __builtin_amdgcn_s_memrealtime(); if ((k) == PROBE_HI) tB = __builtin_amdgcn_s_memrealtime(); } } while (0)
#define GRID_BAR() do { XcdBarrier b_; b_.bar = bar_words(); b_.x = xb_xcc_id(); b_.st = (volatile LAS unsigned*)(lds + LDS_BARST); xcd_barrier(b_, lane_id_fresh() + 64 * wave); } while (0)
#define FRESH_TID() const __attribute__((address_space(4))) Args* ap = (const __attribute__((address_space(4))) Args*)__builtin_amdgcn_kernarg_segment_ptr(); asm volatile("" : "+s"(ap)); int tid = lane_id_fresh() + 64 * wave; const int lane = tid & 63; (void)lane; (void)tid
#define ws (ap->ws)
#define out (ap->out)
#define x_prompt (ap->in[0])
#define x_sample (ap->in[1])
#define c_prompt (ap->in[2])
#define c_sample (ap->in[3])
#define state_gla (ap->in[4])
#define cache_pool (ap->in[5])
#define w_ada (ap->in[6])
#define b_ada (ap->in[7])
#define norm1_g (ap->in[8])
#define w_in (ap->in[9])
#define w_alpha (ap->in[10])
#define b_alpha (ap->in[11])
#define w_pool (ap->in[12])
#define pool_scale (ap->in[13])
#define gla_norm_g (ap->in[14])
#define w_pa (ap->in[15])
#define w_pb (ap->in[16])
#define w_out (ap->in[17])
#define norm2_g (ap->in[18])
#define w_ff1 (ap->in[19])
#define w_ff2 (ap->in[20])
#define final_g (ap->in[21])
#define MOD ((float*)(ws + WS_MOD))
#define ALR ((float*)(ws + WS_ALR))
#define GT ((float*)(ws + WS_GT))
#define Win_t ((bf16*)(ws + WS_WIN))
#define Wcat_t ((bf16*)(ws + WS_WCAT))
#define Wout_t ((bf16*)(ws + WS_WOUT))
#define Wff1_t ((bf16*)(ws + WS_WFF1))
#define Wff2_t ((bf16*)(ws + WS_WFF2))
#define PB ((bf16*)(ws + WS_PB))
#define PA ((bf16*)(ws + WS_PA))
#define US ((float*)(ws + WS_US))
#define MODP ((float*)(ws + WS_US))
#define H ((bf16*)out)
#define ACAT ((bf16*)out)
#define H2 ((bf16*)(ws + WS_PB))
#define MERGED ((bf16*)(ws + WS_PA))
#define HID ((bf16*)(ws + WS_PA))
#define Y (out + O_Y)
#define MERGED_S ((bf16*)(ws + WS_MS))
#define H2_S ((bf16*)(ws + WS_H2S))
#define HID_S ((bf16*)(ws + WS_HIDS))

    {
        FRESH_TID();
        LAS float* scr = (LAS float*)(lds + wave * 16384);
        constexpr int I_IN = 16 * 184, I_PB = 16 * 32, I_OUT = 16 * 32, I_F1 = 16 * 128, I_F2 = 64 * 32, I_WA = 1024, I_MOD = 96 * 16;
        constexpr int NITEMS = I_MOD + I_IN + I_PB + I_OUT + I_F1 + I_F2 + I_WA;
        for (int it = gw; it < NITEMS; it += NGW) {
            int r = it;
            if (r < I_MOD) {
                const int cgp = r % 96, ks = r / 96, k0 = 64 * ks, n = 64 * cgp + lane;
#pragma unroll 1
                for (int rr = 0; rr < NROWS_MOD; ++rr) { const float cv = rr == 0 ? c_prompt[k0 + lane] : c_sample[(size_t)(rr - 1) * DM + k0 + lane]; scr[rr * 64 + lane] = silu_f(cv); }
                asm volatile("s_waitcnt lgkmcnt(0)" ::: "memory");
                float acc[NROWS_MOD];
#pragma unroll
                for (int rr = 0; rr < NROWS_MOD; ++rr) acc[rr] = 0.f;
#pragma unroll
                for (int kb = 0; kb < 2; ++kb) { float wv[32];
#pragma unroll
                    for (int kk = 0; kk < 32; ++kk) wv[kk] = w_ada[(size_t)(k0 + kb * 32 + kk) * NMOD + n];
#pragma unroll
                    for (int kk = 0; kk < 32; ++kk)
#pragma unroll
                        for (int rr = 0; rr < NROWS_MOD; ++rr) acc[rr] += scr[rr * 64 + kb * 32 + kk] * wv[kk]; }
#pragma unroll
                for (int rr = 0; rr < NROWS_MOD; ++rr) MODP[((size_t)ks * NROWS_MOD + rr) * NMOD + n] = acc[rr];
                asm volatile("s_waitcnt lgkmcnt(0)" ::: "memory");
                continue;
            }
            r -= I_MOD;
            if (r < I_IN) { const int kb = r / 184, nb = r % 184; int c0, valid;
                if (nb < 112) { c0 = 32 * nb; valid = 32; } else if (nb < 176) { c0 = 32 * nb + 16; valid = 32; } else if (nb == 176) { c0 = 3584; valid = 16; } else { c0 = 0; valid = 0; }
                transpose_item(w_in, 5648, 64 * kb, c0, valid, Win_t, DM, 32 * nb, 0, scr, lane); continue; }
            r -= I_IN;
            if (r < I_PB) { transpose_item(w_pb, DM, 64 * (r / 32), 32 * (r % 32), 32, Wcat_t, KCAT, 32 * (r % 32), 512, scr, lane); continue; }
            r -= I_PB;
            if (r < I_OUT) { transpose_item(w_out, DM, 64 * (r / 32), 32 * (r % 32), 32, Wout_t, DM, 32 * (r % 32), 0, scr, lane); continue; }
            r -= I_OUT;
            if (r < I_F1) { transpose_item(w_ff1, DFF, 64 * (r / 128), 32 * (r % 128), 32, Wff1_t, DM, 32 * (r % 128), 0, scr, lane); continue; }
            r -= I_F1;
            if (r < I_F2) { transpose_item(w_ff2, DM, 64 * (r / 32), 32 * (r % 32), 32, Wff2_t, DFF, 32 * (r % 32), 0, scr, lane); continue; }
            r -= I_F2;
            {
                const int g = r >> 8, cb = (r >> 4) & 15, nb = r & 15, n = 64 * nb + lane, c0 = 8 * cb;
                float acc[8];
#pragma unroll
                for (int cc = 0; cc < 8; ++cc) acc[cc] = 0.f;
#pragma unroll 1
                for (int db = 0; db < 4; ++db) { float wp[32];
#pragma unroll
                    for (int d = 0; d < 32; ++d) wp[d] = w_pa[(size_t)(g * 128 + db * 32 + d) * DM + n] * pool_scale[g * 128 + db * 32 + d];
#pragma unroll
                    for (int d = 0; d < 32; ++d)
#pragma unroll
                        for (int cc = 0; cc < 8; ++cc) acc[cc] += w_pool[(size_t)(g * 128 + c0 + cc) * 128 + db * 32 + d] * wp[d]; }
                u32x4 o; o.x = pk2(acc[0], acc[1]); o.y = pk2(acc[2], acc[3]); o.z = pk2(acc[4], acc[5]); o.w = pk2(acc[6], acc[7]);
                *(u32x4*)(Wcat_t + (size_t)n * KCAT + g * 128 + c0) = o;
            }
        }
    }
    if (gridDim.x == 0x7fffffffu) grid.sync();
    GRID_BAR(); STAMP(0);
    { FRESH_TID();
    for (int i = blk * 512 + tid; i < NROWS_MOD * NMOD; i += G * 512) { float s = b_ada[i % NMOD];
#pragma unroll
        for (int ks = 0; ks < 16; ++ks) s += MODP[(size_t)ks * NROWS_MOD * NMOD + i];
        MOD[i] = s; } }
    GRID_BAR(); STAMP(1);
    { FRESH_TID();
    for (int m = gw; m < MT; m += NGW) { const int seq = m < MP ? 0 : 1 + ((m - MP) >> 4); const float* xr = m < MP ? x_prompt + (size_t)m * DM : x_sample + (size_t)(m - MP) * DM;
        norm_row_bf16(xr, norm1_g, MOD + (size_t)seq * NMOD, MOD + (size_t)seq * NMOD + 1024, H + (size_t)m * DM, lane); } }
    GRID_BAR(); STAMP(2);
    {
        FRESH_TID();
        pg8::Gemm g{H, Win_t, MT, NIN, DM}; pg8::StaticOrder S; S.init(MT, NIN, G, blk);
        pg8::EpiProj E{PA, PB, ALR};
        pg8::gemm_phase<pg8::EpiProj, pg8::StaticOrder, true, true>(lds, g, S, E, wave);
    }
    GRID_BAR(); STAMP(3);
    {
        FRESH_TID();
        for (int u = blk; u < NSC * 4; u += G) { const int sc2 = u >> 2, h2 = u & 3;
            gla_unit<false>(lds, wave, sc2 * 256, 4, 64, h2, PA, ALR, w_alpha, b_alpha, gla_norm_g, nullptr, US + (size_t)u * 32768, GT + (size_t)u * 128, ACAT, gdummy); }
        for (int u = (G - 1 - blk); u < NSEQ * 4; u += G) { const int s = u >> 2, h = u & 3;
            gla_unit<true>(lds, wave, MP + s * 16, 1, 16, h, PA, ALR, w_alpha, b_alpha, gla_norm_g, state_gla + (size_t)u * 32768, out + O_SGS + (size_t)u * 32768, nullptr, ACAT, gdummy); }
        for (int pt = blk; pt < MT / 16; pt += G) {
            const int rowb = pt * 16, c = tid, gi = c >> 7, w = 2 << gi; const bool samp = rowb >= MP; const int seq = samp ? (rowb - MP) >> 4 : 0;
            float e[31];
#pragma unroll
            for (int i = 0; i < 31; ++i) { const int j = i - 15; float v;
                if (j >= 0) v = bf2f(PA[(size_t)(rowb + j) * PA_LD + c]);
                else if (samp) v = cache_pool[((size_t)seq * 15 + (15 + j)) * 512 + c];
                else v = (rowb + j >= 0) ? bf2f(PA[(size_t)(rowb + j) * PA_LD + c]) : 0.f;
                e[i] = v; }
            float ps[32]; ps[0] = 0.f;
#pragma unroll
            for (int i = 0; i < 31; ++i) ps[i + 1] = ps[i] + e[i];
#pragma unroll
            for (int tl = 0; tl < 16; ++tl) { const int row = rowb + tl, a2 = 16 + tl; const float ut = e[15 + tl];
                const float lo = gi == 0 ? ps[a2 - 2] : gi == 1 ? ps[a2 - 4] : gi == 2 ? ps[a2 - 8] : ps[a2 - 16];
                const float cnt = samp ? (float)w : (float)((row + 1) < w ? (row + 1) : w);
                ACAT[(size_t)row * KCAT + c] = (bf16)f2bf((ps[a2] - lo) / cnt - ut);
                if (samp) { if (tl >= 1) out[O_CPS + ((size_t)seq * 15 + (tl - 1)) * 512 + c] = ut; }
                else if (row >= MP - 15) out[O_CPP + (size_t)(row - (MP - 15)) * 512 + c] = ut; }
        }
    }
    GRID_BAR(); STAMP(4);
    { FRESH_TID();
    for (int e = blk * 512 + tid; e < 131072; e += G * 512) { float S = 0.f; const int hd = __builtin_amdgcn_readfirstlane(e >> 8);
        float u[NSC];
#pragma unroll
        for (int sc = 0; sc < NSC; ++sc) u[sc] = US[(size_t)sc * 131072 + e];
#pragma unroll
        for (int sc = 0; sc < NSC; ++sc) { US[(size_t)sc * 131072 + e] = S; S = GT[sc * 512 + hd] * S + u[sc]; }
        out[O_SGP + e] = S; }
      for (int tl = blk; tl < 256; tl += G) { const int rb = tl & 7, cb = tl >> 3;
          const bf16* Ab = ACAT + (size_t)(MP + 64 * rb) * KCAT; const bf16* Bb = Wcat_t + (size_t)(32 * cb) * KCAT;
          const f32x4 accA = tile_gemm<2>(lds, tid, Ab, KCAT, Bb, KCAT, 0);
          const f32x4 accB = tile_gemm<4>(lds, tid, Ab, KCAT, Bb, KCAT, 512);
          const int rs = 64 * rb + (tid >> 3), col = 32 * cb + 4 * (tid & 7);
          const u32x2 ga = *(const u32x2*)(PB + (size_t)(MP + rs) * PB_LD + col), gb = *(const u32x2*)(PB + (size_t)(MP + rs) * PB_LD + 1024 + col);
          u32x2 w; w.x = pk2(sigm(bf_lo(ga.x)) * accA[0] + sigm(bf_lo(gb.x)) * accB[0], sigm(bf_hi(ga.x)) * accA[1] + sigm(bf_hi(gb.x)) * accB[1]);
          w.y = pk2(sigm(bf_lo(ga.y)) * accA[2] + sigm(bf_lo(gb.y)) * accB[2], sigm(bf_hi(ga.y)) * accA[3] + sigm(bf_hi(gb.y)) * accB[3]);
          *(u32x2*)(MERGED_S + (size_t)rs * DM + col) = w; } }
    GRID_BAR(); STAMP(5);
    { FRESH_TID();
    for (int u = blk; u < NSC * 4; u += G) { const int sc = u >> 2, h = u & 3;
        gla_unit<true>(lds, wave, sc * 256, 4, 64, h, PA, ALR, w_alpha, b_alpha, gla_norm_g, US + (size_t)u * 32768, nullptr, nullptr, ACAT, gacc5); } }
    { FRESH_TID();
      __syncthreads();
      for (int tl = blk; tl < 256; tl += G) { const int rb = tl & 7, cb = tl >> 3;
          const f32x4 acc = tile_gemm<4>(lds, tid, MERGED_S + (size_t)(64 * rb) * DM, DM, Wout_t + (size_t)(32 * cb) * DM, DM, 0);
          const int rs = 64 * rb + (tid >> 3), col = 32 * cb + 4 * (tid & 7), seq = 1 + (rs >> 4);
          const f32x4 xb = *(const f32x4*)(x_sample + (size_t)rs * DM + col), gt = *(const f32x4*)(MOD + (size_t)seq * NMOD + 2048 + col);
          *(f32x4*)(Y + (size_t)(MP + rs) * DM + col) = xb + gt * acc; } }
    GRID_BAR(); STAMP(6);
    {
        FRESH_TID();
        pg8::Gemm g{ACAT, Wcat_t, MP, DM, KCAT}; pg8::StaticOrder S; S.init(MP, DM, G, blk);
        pg8::EpiMerge E{PB, MERGED};
        pg8::gemm_phase<pg8::EpiMerge, pg8::StaticOrder, true, true>(lds, g, S, E, wave);
        for (int m = gw; m < MS; m += NGW) { const int seq = 1 + (m >> 4);
            norm_row_bf16(Y + (size_t)(MP + m) * DM, norm2_g, MOD + (size_t)seq * NMOD + 3072, MOD + (size_t)seq * NMOD + 4096, H2_S + (size_t)m * DM, lane); }
    }
    GRID_BAR(); STAMP(7);
    {
        FRESH_TID();
        pg8::Gemm g{MERGED, Wout_t, MP, DM, DM}; pg8::StaticOrder S; S.init(MP, DM, G, blk);
        pg8::EpiRes<false> E{x_prompt, x_sample, Y, MOD + 2048};
        pg8::gemm_phase<pg8::EpiRes<false>, pg8::StaticOrder, true, true>(lds, g, S, E, wave);
        for (int tl = blk; tl < 1024; tl += G) { const int rb = tl & 7, cb = tl >> 3;
            const f32x4 acc = tile_gemm<4>(lds, tid, H2_S + (size_t)(64 * rb) * DM, DM, Wff1_t + (size_t)(32 * cb) * DM, DM, 0);
            const int rs = 64 * rb + (tid >> 3), col = 32 * cb + 4 * (tid & 7);
            const float r0 = fmaxf(acc[0], 0.f), r1 = fmaxf(acc[1], 0.f), r2 = fmaxf(acc[2], 0.f), r3 = fmaxf(acc[3], 0.f);
            u32x2 w; w.x = pk2(r0 * r0, r1 * r1); w.y = pk2(r2 * r2, r3 * r3);
            *(u32x2*)(HID_S + (size_t)rs * DFF + col) = w; }
    }
    GRID_BAR(); STAMP(8);
    { FRESH_TID();
    for (int m = gw; m < MP; m += NGW) { const int seq = 0;
        norm_row_bf16(Y + (size_t)m * DM, norm2_g, MOD + (size_t)seq * NMOD + 3072, MOD + (size_t)seq * NMOD + 4096, H2 + (size_t)m * DM, lane); }
      __syncthreads();
      for (int tl = blk; tl < 256; tl += G) { const int rb = tl & 7, cb = tl >> 3;
          const f32x4 acc = tile_gemm<16>(lds, tid, HID_S + (size_t)(64 * rb) * DFF, DFF, Wff2_t + (size_t)(32 * cb) * DFF, DFF, 0);
          const int rs = 64 * rb + (tid >> 3), col = 32 * cb + 4 * (tid & 7), seq = 1 + (rs >> 4);
          float* yp = Y + (size_t)(MP + rs) * DM + col; const f32x4 gt = *(const f32x4*)(MOD + (size_t)seq * NMOD + 5120 + col);
          *(f32x4*)yp = *(const f32x4*)yp + gt * acc; } }
    GRID_BAR(); STAMP(9);
    {
        FRESH_TID();
        pg8::Gemm g{H2, Wff1_t, MP, DFF, DM}; pg8::StaticOrder S; S.init(MP, DFF, G, blk);
        pg8::EpiRelu2 E{HID};
        pg8::gemm_phase<pg8::EpiRelu2, pg8::StaticOrder, true, true>(lds, g, S, E, wave);
        for (int m = gw; m < MS; m += NGW) { f32x4* xr = (f32x4*)(Y + (size_t)(MP + m) * DM) + lane; f32x4 v[4]; float sq = 0.f;
#pragma unroll
            for (int j = 0; j < 4; ++j) { v[j] = xr[64 * j]; sq += (v[j][0] * v[j][0] + v[j][1] * v[j][1]) + (v[j][2] * v[j][2] + v[j][3] * v[j][3]); }
            const float rstd = rsqrtf(wave_sum(sq, lane) * (1.0f / DM) + EPS);
#pragma unroll
            for (int j = 0; j < 4; ++j) { const f32x4 gg = *(const f32x4*)(final_g + 4 * lane + 256 * j); xr[64 * j] = v[j] * rstd * gg; } }
    }
    GRID_BAR(); STAMP(10);
    {
        FRESH_TID();
        pg8::Gemm g{HID, Wff2_t, MP, DM, DFF}; pg8::StaticOrder S; S.init(MP, DM, G, blk);
        pg8::EpiRes<true> E{nullptr, nullptr, Y, MOD + 5120};
        pg8::gemm_phase<pg8::EpiRes<true>, pg8::StaticOrder, true, true>(lds, g, S, E, wave);
    }
    GRID_BAR(); STAMP(11);
    { FRESH_TID();
    for (int m = gw; m < MP; m += NGW) { f32x4* xr = (f32x4*)(Y + (size_t)m * DM) + lane; f32x4 v[4]; float s = 0.f;
#pragma unroll
        for (int j = 0; j < 4; ++j) { v[j] = xr[64 * j]; s += (v[j][0] * v[j][0] + v[j][1] * v[j][1]) + (v[j][2] * v[j][2] + v[j][3] * v[j][3]); }
        const float rstd = rsqrtf(wave_sum(s, lane) * (1.0f / DM) + EPS);
#pragma unroll
        for (int j = 0; j < 4; ++j) { const f32x4 gg = *(const f32x4*)(final_g + 4 * lane + 256 * j); xr[64 * j] = v[j] * rstd * gg; } } }
    if (PROBE_LO >= 0 || PROBE_SUB >= 0) { if (PROBE_HI == 12) tB = __builtin_amdgcn_s_memrealtime(); if (blk == 0) { const unsigned long long t0 = __builtin_amdgcn_s_memrealtime(), w = 4ull * (PROBE_SUB >= 0 ? gacc5 : (tB - tA)); while (__builtin_amdgcn_s_memrealtime() - t0 < w) __builtin_amdgcn_s_sleep(8); } }
}

#undef ws
#undef out
#undef x_prompt
#undef x_sample
#undef c_prompt
#undef c_sample
#undef state_gla
#undef cache_pool
#undef w_ada
#undef b_ada
#undef norm1_g
#undef w_in
#undef w_alpha
#undef b_alpha
#undef w_pool
#undef pool_scale
#undef gla_norm_g
#undef w_pa
#undef w_pb
#undef w_out
#undef norm2_g
#undef w_ff1
#undef w_ff2
#undef final_g
#undef MOD
#undef ALR
#undef GT
#undef Win_t
#undef Wcat_t
#undef Wout_t
#undef Wff1_t
#undef Wff2_t
#undef PB
#undef PA
#undef US
#undef MODP
#undef H
#undef ACAT
#undef H2
#undef MERGED
#undef HID
#undef Y
#undef MERGED_S
#undef H2_S
#undef HID_S
extern "C" void kernel_launch(void* const* d_in, const int* in_sizes, int n_in, void* d_out, int out_size, void* d_ws, size_t ws_size, hipStream_t stream) {
    static int grid = 0;
    if (grid == 0) {
        if (n_in != 22 || ws_size < WS_END) { fprintf(stderr, "kernel_launch: unexpected n_in %d / ws %zu\n", n_in, ws_size); grid = -1; return; }
        int dev = 0, cus = 0, per_cu = 0;
        hipGetDevice(&dev); hipDeviceGetAttribute(&cus, hipDeviceAttributeMultiprocessorCount, dev);
        if (hipFuncSetAttribute((const void*)fwd_kernel, hipFuncAttributeMaxDynamicSharedMemorySize, LDS_BYTES) != hipSuccess) { fprintf(stderr, "kernel_launch: hipFuncSetAttribute failed\n"); grid = -1; return; }
        if (hipOccupancyMaxActiveBlocksPerMultiprocessor(&per_cu, (const void*)fwd_kernel, 512, LDS_BYTES) != hipSuccess || per_cu < 1) { fprintf(stderr, "kernel_launch: occupancy query says %d\n", per_cu); per_cu = 1; }
        (void)hipGetLastError();
        grid = cus * 1;
    }
    if (grid < 0) return;
    if (hipMemsetAsync(d_ws, 0, 65536, stream) != hipSuccess) { fprintf(stderr, "kernel_launch: memset failed\n"); return; }
    Args a{};
    for (int i = 0; i < 22; ++i) a.in[i] = (const float*)d_in[i];
    a.out = (float*)d_out; a.ws = (unsigned char*)d_ws;
    void* args[] = {&a};
    hipError_t e = hipLaunchCooperativeKernel((const void*)fwd_kernel, dim3(grid), dim3(512), args, LDS_BYTES, stream);
    if (e != hipSuccess) fprintf(stderr, "kernel_launch: cooperative launch failed: %s (grid %d)\n", hipGetErrorString(e), grid);
}
```

```cpp
#include <hip/hip_runtime.h>
#include <hip/hip_cooperative_groups.h>
#include <cstdio>
#include <cstdint>
namespace cg = cooperative_groups;
__device__ __forceinline__ int lane_id_fresh() { int l; asm volatile("v_mbcnt_lo_u32_b32 %0, -1, 0\n\tv_mbcnt_hi_u32_b32 %0, -1, %0" : "=v"(l)); return l; }
__device__ __forceinline__ float shfl_xor_l(float v, int o, int lane) { return __int_as_float(__builtin_amdgcn_ds_bpermute((lane ^ o) << 2, __float_as_int(v))); }
__device__ __forceinline__ float bf_lo(unsigned w) { return __uint_as_float(w << 16); }
__device__ __forceinline__ float bf_hi(unsigned w) { return __uint_as_float(w & 0xffff0000u); }
__device__ __forceinline__ float sigm(float x) { return 1.0f / (1.0f + __expf(-x)); }
namespace pg8 {
#define PG8_LAS __attribute__((address_space(3)))
typedef unsigned short bf16_t;
typedef short bf16x8 __attribute__((ext_vector_type(8)));
typedef float f32x4 __attribute__((ext_vector_type(4)));
typedef unsigned u32x4 __attribute__((ext_vector_type(4)));
constexpr int BM = 256, BK = 64, HALF = 128, HTB = HALF * BK * 2  , STAGE_BYTES = 8 * HTB, NXCD = 8, WGM = 8;

__host__ __device__ __forceinline__ int lds_byte(int r, int c) { const int st = (r >> 4) * 2 + (c >> 5), rr = r & 15, cc = c & 31, ob = rr * 64 + cc * 2; return st * 1024 + (ob ^ (((ob >> 9) & 1) << 5)); }
__host__ __device__ __forceinline__ void stage_rc(int b, int& R, int& C) { const int st = b / 1024, sb = b % 1024, swz = sb ^ (((sb >> 9) & 1) << 5); R = (st >> 1) * 16 + swz / 64; C = (st & 1) * 32 + (swz % 64) / 2; }
__host__ __device__ __forceinline__ int perm32(int rho) { const int n = rho >> 4, i = rho & 15; return 8 * (i >> 2) + 4 * n + (i & 3); }

struct Unit { int pm, pn; };
struct Gemm { const bf16_t* A; const bf16_t* Bt; int M, N, K; };

struct StaticOrder {
    int nM, nN, nwg, G, c;
    __host__ __device__ void init(int M, int N, int G_, int c_) { nM = M / BM; nN = N / BM; nwg = nM * nN; G = G_; c = c_; }
    __host__ __device__ bool next(int i, Unit& u) const {
        const long L = (long)i * G + c; if (L >= nwg) return false;
        int wgid = (int)L; { const int q = nwg / NXCD, r = nwg % NXCD, xcd = wgid % NXCD, off = wgid / NXCD; wgid = (xcd < r ? xcd * (q + 1) : r * (q + 1) + (xcd - r) * q) + off; }
        const int nig = WGM * nN, gid = wgid / nig, fm = gid * WGM, gsz = (nM - fm) < WGM ? (nM - fm) : WGM;
        u.pm = fm + ((wgid % nig) % gsz); u.pn = (wgid % nig) / gsz; return true;
    }
    __device__ __forceinline__ void a_ready(const Unit&) const {}
    __device__ __forceinline__ void done(const Unit&) const {}
};

__device__ __forceinline__ unsigned cvt_pk_bf16(float lo, float hi) { unsigned r; asm volatile("v_cvt_pk_bf16_f32 %0, %1, %2" : "=v"(r) : "v"(lo), "v"(hi)); return r; }
template <class Epi, class Sched, bool ALIGN_EPI = false, bool SP2 = false>
__device__ __forceinline__ void gemm_phase(PG8_LAS unsigned char* lds, const Gemm g, const Sched& S, const Epi& E, const int wave_id) {
    int tid_ = lane_id_fresh() + 64 * wave_id;
    const int tid = tid_, wid = __builtin_amdgcn_readfirstlane(tid >> 6), lane = tid & 63, wr = wid >> 2, wc = wid & 3, fr = lane & 15, fq = lane >> 4;
    const int K = g.K, nt = K / BK;
    unsigned voffA[2], voffB[2];
#pragma unroll
    for (int i = 0; i < 2; ++i) { int R, C; stage_rc(tid * 16 + i * 8192, R, C); const int Rb = Epi::PERM ? ((R & ~31) + perm32(R & 31)) : R;
        voffA[i] = (unsigned)(R * K + C) * 2u; voffB[i] = (unsigned)(Rb * K + C) * 2u; }
    const size_t kstep = (size_t)(BK * 2);
    const size_t hstep = (size_t)HALF * K * 2;
    const size_t tstep = 2 * hstep;
    const unsigned ldsw = (unsigned)wid * 1024u;
    const int aoff = lds_byte(wr * 64 + fr, fq * 8), boff = lds_byte(wc * 32 + fr, fq * 8);
#define PG8_SA(b, h) (((b) * 2 + (h)) * HTB)
#define PG8_SB(b, h) ((4 + (b) * 2 + (h)) * HTB)
#define PG8_STAGE(bufoff, gbase, voff) do { _Pragma("unroll") for (int _i = 0; _i < 2; ++_i) \
        __builtin_amdgcn_global_load_lds((const unsigned*)((const char*)(gbase) + (voff)[_i]), (PG8_LAS unsigned*)(lds + (bufoff) + ldsw + _i * 8192), 16, 0, 0); } while (0)
#define PG8_LDA(dst, b, h) do { _Pragma("unroll") for (int m = 0; m < 4; ++m) _Pragma("unroll") for (int k = 0; k < 2; ++k) dst[m][k] = *(const PG8_LAS bf16x8*)(lds + PG8_SA(b, h) + aoff + m * 2048 + k * 1024); } while (0)
#define PG8_LDB(dst, b, h) do { _Pragma("unroll") for (int n = 0; n < 2; ++n) _Pragma("unroll") for (int k = 0; k < 2; ++k) dst[n][k] = *(const PG8_LAS bf16x8*)(lds + PG8_SB(b, h) + boff + n * 2048 + k * 1024); } while (0)
#define PG8_MMA(ai, bj, At, Bt) do { __builtin_amdgcn_s_setprio(1); _Pragma("unroll") for (int m = 0; m < 4; ++m) _Pragma("unroll") for (int n = 0; n < 2; ++n) _Pragma("unroll") for (int k = 0; k < 2; ++k) \
        acc[ai][bj][m][n] = __builtin_amdgcn_mfma_f32_16x16x32_bf16(Bt[n][k], At[m][k], acc[ai][bj][m][n], 0, 0, 0); __builtin_amdgcn_s_setprio(0); } while (0)
#define PG8_WAIT_V(n) asm volatile("s_waitcnt vmcnt(" #n ")" ::: "memory")
#define PG8_WAIT_L(n) asm volatile("s_waitcnt lgkmcnt(" #n ")" ::: "memory")
#define PG8_BAR __builtin_amdgcn_s_barrier()
#define PG8_SCHED __builtin_amdgcn_sched_barrier(0)
    Unit cur, nxt; int ui = 0;
    if (!S.next(0, cur)) return;
    f32x4 acc[2][2][4][2];
#pragma unroll
    for (int a = 0; a < 2; ++a)
#pragma unroll
        for (int b = 0; b < 2; ++b)
#pragma unroll
            for (int m = 0; m < 4; ++m)
#pragma unroll
                for (int n = 0; n < 2; ++n) acc[a][b][m][n] = (f32x4){0.f, 0.f, 0.f, 0.f};
    bf16x8 At[4][2], B0[2][2], B1[2][2];
    const char* cA = (const char*)g.A + (size_t)cur.pm * tstep; const char* cB = (const char*)g.Bt + (size_t)cur.pn * tstep;
    S.a_ready(cur);
    if constexpr (SP2) {
        PG8_STAGE(PG8_SB(0, 0), cB, voffB); PG8_STAGE(PG8_SB(0, 1), cB + hstep, voffB); PG8_STAGE(PG8_SA(0, 0), cA, voffA); PG8_STAGE(PG8_SA(0, 1), cA + hstep, voffA);
        if (wr == 1) PG8_BAR;
        PG8_WAIT_V(2); PG8_BAR;
        PG8_STAGE(PG8_SB(1, 0), cB + kstep, voffB); PG8_STAGE(PG8_SA(1, 0), cA + kstep, voffA); PG8_STAGE(PG8_SB(1, 1), cB + hstep + kstep, voffB);
        PG8_WAIT_V(6); PG8_BAR;
    } else {
        PG8_STAGE(PG8_SB(0, 0), cB, voffB); PG8_STAGE(PG8_SA(0, 0), cA, voffA); PG8_STAGE(PG8_SB(0, 1), cB + hstep, voffB); PG8_STAGE(PG8_SA(0, 1), cA + hstep, voffA);
        if (wr == 1) PG8_BAR;
        PG8_WAIT_V(4); PG8_BAR;
        PG8_STAGE(PG8_SB(1, 0), cB + kstep, voffB); PG8_STAGE(PG8_SA(1, 0), cA + kstep, voffA); PG8_STAGE(PG8_SB(1, 1), cB + hstep + kstep, voffB);
        PG8_WAIT_V(6); PG8_BAR;
    }
    for (;;) {
        const bool has_next = S.next(ui + 1, nxt);
        const char* nA = has_next ? (const char*)g.A + (size_t)nxt.pm * tstep : cA; const char* nB = has_next ? (const char*)g.Bt + (size_t)nxt.pn * tstep : cB;
        for (int t = 0; t < nt; t += 2) {
            if constexpr (Epi::MID_T > 0) { if (t == Epi::MID_T) E.mid(acc, cur, wr, wc, fr, fq); }
            const bool last = (t == nt - 2);
            const char* a1 = cA + (size_t)(t + 1) * kstep;
            const char* a2 = last ? nA : cA + (size_t)(t + 2) * kstep; const char* b2 = last ? nB : cB + (size_t)(t + 2) * kstep;
            const char* a3 = a2 + kstep; const char* b3 = b2 + kstep;
            if (last && has_next) S.a_ready(nxt);
            if constexpr (SP2) {
            PG8_LDB(B0, 0, 0); PG8_LDB(B1, 0, 1); PG8_SCHED; PG8_LDA(At, 0, 0); PG8_STAGE(PG8_SA(1, 1), a1 + hstep, voffA);
            PG8_WAIT_V(8); PG8_WAIT_L(0); PG8_BAR; PG8_MMA(0, 0, At, B0); PG8_MMA(0, 1, At, B1); PG8_BAR; PG8_SCHED;
            PG8_LDA(At, 0, 1); PG8_STAGE(PG8_SB(0, 0), b2, voffB); PG8_STAGE(PG8_SB(0, 1), b2 + hstep, voffB); PG8_STAGE(PG8_SA(0, 0), a2, voffA);
            PG8_WAIT_V(8); PG8_WAIT_L(0); PG8_BAR; PG8_MMA(1, 0, At, B0); PG8_MMA(1, 1, At, B1); PG8_BAR; PG8_SCHED;
            PG8_LDB(B0, 1, 0); PG8_LDB(B1, 1, 1); PG8_SCHED; PG8_LDA(At, 1, 0); PG8_STAGE(PG8_SA(0, 1), a2 + hstep, voffA);
            PG8_WAIT_V(8); PG8_WAIT_L(0); PG8_BAR; PG8_MMA(0, 0, At, B0); PG8_MMA(0, 1, At, B1); PG8_BAR; PG8_SCHED;
            PG8_LDA(At, 1, 1); PG8_STAGE(PG8_SB(1, 0), b3, voffB); PG8_STAGE(PG8_SB(1, 1), b3 + hstep, voffB); PG8_STAGE(PG8_SA(1, 0), a3, voffA);
            PG8_WAIT_V(8); PG8_WAIT_L(0); PG8_BAR; PG8_MMA(1, 0, At, B0); PG8_MMA(1, 1, At, B1); PG8_BAR; PG8_SCHED;
            } else {
            PG8_LDB(B0, 0, 0); PG8_SCHED; PG8_LDA(At, 0, 0); PG8_STAGE(PG8_SA(1, 1), a1 + hstep, voffA);
            PG8_WAIT_L(8); PG8_BAR; PG8_WAIT_L(0); PG8_MMA(0, 0, At, B0); PG8_BAR; PG8_SCHED;
            PG8_LDB(B1, 0, 1); PG8_STAGE(PG8_SB(0, 0), b2, voffB);
            PG8_BAR; PG8_WAIT_L(0); PG8_MMA(0, 1, At, B1); PG8_BAR;
            PG8_LDA(At, 0, 1); PG8_STAGE(PG8_SA(0, 0), a2, voffA);
            PG8_BAR; PG8_WAIT_L(0); PG8_MMA(1, 0, At, B0); PG8_BAR; PG8_SCHED;
            PG8_STAGE(PG8_SB(0, 1), b2 + hstep, voffB);
            PG8_WAIT_V(6); PG8_BAR; PG8_MMA(1, 1, At, B1); PG8_BAR;
            PG8_LDB(B0, 1, 0); PG8_SCHED; PG8_LDA(At, 1, 0); PG8_STAGE(PG8_SA(0, 1), a2 + hstep, voffA);
            PG8_WAIT_L(8); PG8_BAR; PG8_WAIT_L(0); PG8_MMA(0, 0, At, B0); PG8_BAR; PG8_SCHED;
            PG8_LDB(B1, 1, 1); PG8_STAGE(PG8_SB(1, 0), b3, voffB);
            PG8_BAR; PG8_WAIT_L(0); PG8_MMA(0, 1, At, B1); PG8_BAR;
            PG8_LDA(At, 1, 1); PG8_STAGE(PG8_SA(1, 0), a3, voffA);
            PG8_BAR; PG8_WAIT_L(0); PG8_MMA(1, 0, At, B0); PG8_BAR; PG8_SCHED;
            PG8_STAGE(PG8_SB(1, 1), b3 + hstep, voffB);
            PG8_WAIT_V(6); PG8_BAR; PG8_MMA(1, 1, At, B1); PG8_BAR;
            }
        }
        if constexpr (ALIGN_EPI) { if (wr == 0) PG8_BAR; }
        if constexpr (!Epi::AFTER_DRAIN) { E(acc, cur, wr, wc, fr, fq); S.done(cur); }
        if (!has_next) break;
#pragma unroll
        for (int a = 0; a < 2; ++a)
#pragma unroll
            for (int b = 0; b < 2; ++b)
#pragma unroll
                for (int m = 0; m < 4; ++m)
#pragma unroll
                    for (int n = 0; n < 2; ++n) acc[a][b][m][n] = (f32x4){0.f, 0.f, 0.f, 0.f};
        cur = nxt; cA = nA; cB = nB; ++ui;
        if constexpr (ALIGN_EPI) { if (wr == 1) PG8_BAR; }
    }
    PG8_WAIT_V(0);
    if constexpr (!ALIGN_EPI) { if (wr == 0) PG8_BAR; }
    PG8_BAR;
    if constexpr (Epi::AFTER_DRAIN) { E.fused(acc, cur, wr, wc, fr, fq, lds, wid, lane); S.done(cur); }
#undef PG8_SA
#undef PG8_SB
#undef PG8_STAGE
#undef PG8_LDA
#undef PG8_LDB
#undef PG8_MMA
#undef PG8_WAIT_V
#undef PG8_WAIT_L
#undef PG8_BAR
#undef PG8_SCHED
}


constexpr int MP_ROWS = 16384;

struct EpiProj {
    static constexpr bool PERM = true, AFTER_DRAIN = false; static constexpr int MID_T = 0;
    bf16_t* PA; bf16_t* PB; float* ALR;
    __device__ __forceinline__ void mid(f32x4 (&)[2][2][4][2], const Unit&, int, int, int, int) const {}
    __device__ __forceinline__ void operator()(const f32x4 (&acc)[2][2][4][2], const Unit& u, int wr, int wc, int fr, int fq) const {
        const int row0 = u.pm * BM + wr * 64 + fr;
        if (u.pn < 22) {
            bf16_t* base; int ldc, colt;
            if (u.pn < 14) { base = PA; ldc = 3584; colt = u.pn * BM; } else { base = PB; ldc = 2048; colt = (u.pn - 14) * BM; }
            const int col0 = colt + wc * 32 + 8 * fq;
#pragma unroll
            for (int ai = 0; ai < 2; ++ai)
#pragma unroll
                for (int m = 0; m < 4; ++m) { bf16_t* rowp = base + (size_t)(row0 + ai * HALF + m * 16) * ldc + col0;
#pragma unroll
                    for (int bj = 0; bj < 2; ++bj) { const f32x4 v0 = acc[ai][bj][m][0], v1 = acc[ai][bj][m][1];
                        u32x4 w; w.x = cvt_pk_bf16(v0[0], v0[1]); w.y = cvt_pk_bf16(v0[2], v0[3]); w.z = cvt_pk_bf16(v1[0], v1[1]); w.w = cvt_pk_bf16(v1[2], v1[3]);
                        *(u32x4*)(rowp + bj * HALF) = w; } }
        } else if (wc == 0 && fq < 2) {
#pragma unroll
            for (int ai = 0; ai < 2; ++ai)
#pragma unroll
                for (int m = 0; m < 4; ++m) { float* p = ALR + (size_t)(row0 + ai * HALF + m * 16) * 16 + 8 * fq;
                    *(f32x4*)p = acc[ai][0][m][0]; *(f32x4*)(p + 4) = acc[ai][0][m][1]; }
        }
    }
};
struct EpiMerge {
    static constexpr bool PERM = true, AFTER_DRAIN = false; static constexpr int MID_T = 8;
    const bf16_t* PB; bf16_t* O;
    __device__ __forceinline__ void mid(f32x4 (&acc)[2][2][4][2], const Unit& u, int wr, int wc, int fr_, int fq) const {
        int fr = fr_; asm volatile("" : "+v"(fr));
        const int row0 = u.pm * BM + wr * 64 + fr, col0 = u.pn * BM + wc * 32 + 8 * fq;
#pragma unroll
        for (int ai = 0; ai < 2; ++ai)
#pragma unroll
            for (int m = 0; m < 4; ++m) { const bf16_t* gp = PB + (size_t)(row0 + ai * HALF + m * 16) * 2048 + col0;
#pragma unroll
                for (int bj = 0; bj < 2; ++bj) { const u32x4 a8 = *(const u32x4*)(gp + bj * HALF), b8 = *(const u32x4*)(gp + 1024 + bj * HALF);
#pragma unroll
                    for (int e = 0; e < 4; ++e) { const unsigned aw = a8[e], bw = b8[e];
                        const float f0 = (1.0f + __expf(-bf_lo(bw))) / (1.0f + __expf(-bf_lo(aw))), f1 = (1.0f + __expf(-bf_hi(bw))) / (1.0f + __expf(-bf_hi(aw)));
                        acc[ai][bj][m][e >> 1][(e & 1) * 2] *= f0; acc[ai][bj][m][e >> 1][(e & 1) * 2 + 1] *= f1; } }
                if (m == 3) asm volatile("" ::: "memory"); }
    }
    __device__ __forceinline__ void operator()(const f32x4 (&acc)[2][2][4][2], const Unit& u, int wr, int wc, int fr, int fq) const {
        const int row0 = u.pm * BM + wr * 64 + fr, col0 = u.pn * BM + wc * 32 + 8 * fq;
#pragma unroll
        for (int ai = 0; ai < 2; ++ai)
#pragma unroll
            for (int m = 0; m < 4; ++m) { const size_t r = (size_t)(row0 + ai * HALF + m * 16);
#pragma unroll
                for (int bj = 0; bj < 2; ++bj) { const u32x4 b8 = *(const u32x4*)(PB + r * 2048 + 1024 + col0 + bj * HALF);
                    const f32x4 v0 = acc[ai][bj][m][0], v1 = acc[ai][bj][m][1]; u32x4 w;
                    w.x = cvt_pk_bf16(v0[0] * sigm(bf_lo(b8.x)), v0[1] * sigm(bf_hi(b8.x))); w.y = cvt_pk_bf16(v0[2] * sigm(bf_lo(b8.y)), v0[3] * sigm(bf_hi(b8.y)));
                    w.z = cvt_pk_bf16(v1[0] * sigm(bf_lo(b8.z)), v1[1] * sigm(bf_hi(b8.z))); w.w = cvt_pk_bf16(v1[2] * sigm(bf_lo(b8.w)), v1[3] * sigm(bf_hi(b8.w)));
                    *(u32x4*)(O + r * 1024 + col0 + bj * HALF) = w; } }
    }
};
template <bool INPLACE> struct EpiRes {
    static constexpr bool PERM = false, AFTER_DRAIN = false; static constexpr int MID_T = 0;
    const float* xp; float* out; const float* gate;
    __device__ __forceinline__ void mid(f32x4 (&)[2][2][4][2], const Unit&, int, int, int, int) const {}
    __device__ __forceinline__ void operator()(const f32x4 (&acc)[2][2][4][2], const Unit& u, int wr, int wc, int fr, int fq) const {
        const int row0 = u.pm * BM + wr * 64 + fr, col0 = u.pn * BM + wc * 32 + 4 * fq;
        f32x4 gt[2][2];
#pragma unroll
        for (int bj = 0; bj < 2; ++bj)
#pragma unroll
            for (int n = 0; n < 2; ++n) gt[bj][n] = *(const f32x4*)(gate + col0 + bj * HALF + n * 16);
#pragma unroll
        for (int ai = 0; ai < 2; ++ai) {
#pragma unroll
            for (int m = 0; m < 4; ++m) { const int row = row0 + ai * HALF + m * 16; float* op = out + (size_t)row * 1024 + col0;
                const float* bp = INPLACE ? (const float*)op : (xp + (size_t)row * 1024 + col0);
#pragma unroll
                for (int bj = 0; bj < 2; ++bj)
#pragma unroll
                    for (int n = 0; n < 2; ++n) { const int c = bj * HALF + n * 16; const f32x4 bs = *(const f32x4*)(bp + c);
                        *(f32x4*)(op + c) = bs + gt[bj][n] * acc[ai][bj][m][n]; } }
            asm volatile("" ::: "memory"); }
    }
};
struct EpiRelu2 {
    static constexpr bool PERM = true, AFTER_DRAIN = false; static constexpr int MID_T = 0;
    bf16_t* O;
    __device__ __forceinline__ void mid(f32x4 (&)[2][2][4][2], const Unit&, int, int, int, int) const {}
    __device__ __forceinline__ void operator()(const f32x4 (&acc)[2][2][4][2], const Unit& u, int wr, int wc, int fr, int fq) const {
        const int row0 = u.pm * BM + wr * 64 + fr, col0 = u.pn * BM + wc * 32 + 8 * fq;
#pragma unroll
        for (int ai = 0; ai < 2; ++ai)
#pragma unroll
            for (int m = 0; m < 4; ++m) { bf16_t* rowp = O + (size_t)(row0 + ai * HALF + m * 16) * 4096 + col0;
#pragma unroll
                for (int bj = 0; bj < 2; ++bj) { f32x4 v0 = acc[ai][bj][m][0], v1 = acc[ai][bj][m][1];
#pragma unroll
                    for (int e = 0; e < 4; ++e) { const float a = fmaxf(v0[e], 0.f), b = fmaxf(v1[e], 0.f); v0[e] = a * a; v1[e] = b * b; }
                    u32x4 w; w.x = cvt_pk_bf16(v0[0], v0[1]); w.y = cvt_pk_bf16(v0[2], v0[3]); w.z = cvt_pk_bf16(v1[0], v1[1]); w.w = cvt_pk_bf16(v1[2], v1[3]);
                    *(u32x4*)(rowp + bj * HALF) = w; } }
    }
};
}

#define LAS __attribute__((address_space(3)))
typedef unsigned short bf16;
typedef float f32x4 __attribute__((ext_vector_type(4)));
typedef float f32x2 __attribute__((ext_vector_type(2)));
typedef unsigned u32x4 __attribute__((ext_vector_type(4)));
typedef unsigned u32x2 __attribute__((ext_vector_type(2)));
typedef short bf16x8 __attribute__((ext_vector_type(8)));
typedef short s16x4 __attribute__((ext_vector_type(4)));

constexpr int DM = 1024, MP = 16384, NSEQ = 32, LSAMP = 16, MS = NSEQ * LSAMP, MT = MP + MS;
constexpr int NIN = 5888, KCAT = 1536, DFF = 4096, NMOD = 6144, NROWS_MOD = 33;
constexpr int PA_LD = 3584, PB_LD = 2048;
constexpr int NSC = 64;
constexpr float EPS = 1e-6f;
constexpr size_t MiB = 1u << 20;
constexpr size_t WS_MOD = 1 * MiB;
constexpr size_t WS_ALR = 2 * MiB;
constexpr size_t WS_GT = 4 * MiB;
constexpr size_t WS_WIN = 8 * MiB;
constexpr size_t WS_WCAT = 20 * MiB;
constexpr size_t WS_WOUT = 23 * MiB;
constexpr size_t WS_WFF1 = 25 * MiB;
constexpr size_t WS_WFF2 = 33 * MiB;
constexpr size_t WS_PB = 42 * MiB;
constexpr size_t WS_PA = 108 * MiB;
constexpr size_t WS_US = 224 * MiB;
constexpr size_t WS_MS = 5 * MiB;
constexpr size_t WS_H2S = 6 * MiB;
constexpr size_t WS_HIDS = 240 * MiB;
constexpr size_t WS_END = 256 * MiB;
constexpr size_t O_Y = 0, O_SGP = (size_t)MT * DM, O_CPP = O_SGP + 131072, O_SGS = O_CPP + 7680, O_CPS = O_SGS + (size_t)NSEQ * 131072;
constexpr int LDS_BYTES = 147456;

__device__ __forceinline__ float bf2f(unsigned short h) { return __uint_as_float((unsigned)h << 16); }
__device__ __forceinline__ unsigned f2bf(float f) { unsigned u = __float_as_uint(f); return (u + 0x7fffu + ((u >> 16) & 1u)) >> 16; }
__device__ __forceinline__ unsigned pk2(float lo, float hi) { return f2bf(lo) | (f2bf(hi) << 16); }
__device__ __forceinline__ float wave_sum(float v, int lane) {
#pragma unroll
    for (int o = 1; o < 64; o <<= 1) v += shfl_xor_l(v, o, lane);
    return v;
}
__device__ __forceinline__ float silu_f(float x) { return x / (1.0f + __expf(-x)); }

__device__ __forceinline__ void transpose_item(const float* W, int ldn, int k0, int c0, int valid, bf16* WT, int dld, int drow0, int dk0, LAS float* scr, int lane) {
    float tv[32];
#pragma unroll
    for (int i = 0; i < 32; ++i) { const int kk = 2 * i + (lane >> 5), n = lane & 31; tv[i] = n < valid ? W[(size_t)(k0 + kk) * ldn + c0 + n] : 0.f; }
#pragma unroll
    for (int i = 0; i < 32; ++i) { const int kk = 2 * i + (lane >> 5), n = lane & 31; scr[kk * 33 + n] = tv[i]; }
    asm volatile("s_waitcnt lgkmcnt(0)" ::: "memory");
    const int c = lane & 7;
#pragma unroll
    for (int j = 0; j < 4; ++j) { const int n = (lane >> 3) + 8 * j; const LAS float* s = scr + (8 * c) * 33 + n;
        u32x4 o; o.x = pk2(s[0 * 33], s[1 * 33]); o.y = pk2(s[2 * 33], s[3 * 33]); o.z = pk2(s[4 * 33], s[5 * 33]); o.w = pk2(s[6 * 33], s[7 * 33]);
        *(u32x4*)(WT + (size_t)(drow0 + n) * dld + dk0 + k0 + 8 * c) = o; }
    asm volatile("s_waitcnt lgkmcnt(0)" ::: "memory");
}

#define XB_TMO      128
#define XB_XCNT(j)  (256  + 64 * (j))
#define XB_XSUB(j)  (1280 + 64 * (j))
#define XB_XGEN(j)  (2304 + 64 * (j))
#define XB_TOP      3328
#define XB_TOPGEN   3392
#define XCD_BAR_WORDS 3456
#define XB_SPIN_CAP (1u << 18)

__device__ __forceinline__ unsigned xb_ld(unsigned* p)              { return __hip_atomic_load(p, __ATOMIC_RELAXED, __HIP_MEMORY_SCOPE_AGENT); }
__device__ __forceinline__ unsigned xb_add(unsigned* p, unsigned v) { return __hip_atomic_fetch_add(p, v, __ATOMIC_RELAXED, __HIP_MEMORY_SCOPE_AGENT); }
__device__ __forceinline__ unsigned xb_xcc_id() { return (unsigned)__builtin_amdgcn_s_getreg((3 << 11) | 20) & 0xFu; }
#define XB_SPIN(cond, bar) do { unsigned _sp = 0; while (cond) { __builtin_amdgcn_s_sleep(1); \
    if ((++_sp & 255u) == 0u) { if (xb_ld(&(bar)[XB_TMO])) break; if (_sp > XB_SPIN_CAP) { atomicAdd(&(bar)[XB_TMO], 1u); break; } } } } while (0)

struct XcdBarrier {
    unsigned* bar; unsigned x;
    volatile LAS unsigned* st;
};

__device__ __forceinline__ XcdBarrier xcd_barrier_post(unsigned* bar, volatile LAS unsigned* st, int tid) {
    XcdBarrier b; b.bar = bar; b.x = xb_xcc_id(); b.st = st;
    if (tid == 0) (void)xb_add(&bar[XB_XCNT(b.x)], 1u);
    return b;
}
__device__ __forceinline__ void xcd_barrier_complete(unsigned* bar, unsigned x, unsigned& nloc, unsigned& nx) {
    const unsigned G = gridDim.x * gridDim.y * gridDim.z;
    unsigned sum, cnt, mine, sp = 0u;
    for (;;) {
        sum = 0u; cnt = 0u; mine = 0u;
#pragma unroll
        for (unsigned j = 0; j < 16; ++j) { const unsigned c = xb_ld(&bar[XB_XCNT(j)]); sum += c; cnt += (c > 0u) ? 1u : 0u; mine = (j == x) ? c : mine; }
        if (sum == G) break;
        __builtin_amdgcn_s_sleep(1);
        if ((++sp & 255u) == 0u) { if (xb_ld(&bar[XB_TMO])) break; if (sp > XB_SPIN_CAP) { atomicAdd(&bar[XB_TMO], 1u); break; } }
    }
    nloc = mine > 0u ? mine : 1u; nx = cnt > 0u ? cnt : 1u;
}

__device__ __forceinline__ void xcd_barrier(const XcdBarrier& b, int tid) {
    asm volatile("s_waitcnt vmcnt(0)" ::: "memory");
    __syncthreads();
    if (tid == 0) {
        unsigned* bar = b.bar;
        __builtin_amdgcn_s_waitcnt(0);
        unsigned nloc = b.st[0], nx = b.st[1];
        if (nloc == 0u) { xcd_barrier_complete(bar, b.x, nloc, nx); b.st[0] = nloc; b.st[1] = nx; }
        const unsigned old = xb_add(&bar[XB_XSUB(b.x)], 1u);
        const unsigned gen = old / nloc;
        if (old + 1u == (gen + 1u) * nloc) {
            __builtin_amdgcn_fence(__ATOMIC_RELEASE, "agent");
            asm volatile("s_waitcnt vmcnt(0)" ::: "memory");
            const unsigned og = xb_add(&bar[XB_TOP], 1u);
            const unsigned tg = og / nx;
            if (og + 1u == (tg + 1u) * nx) xb_add(&bar[XB_TOPGEN], 1u);
            else XB_SPIN(xb_ld(&bar[XB_TOPGEN]) == tg, bar);
            __builtin_amdgcn_fence(__ATOMIC_ACQUIRE, "agent");
            xb_add(&bar[XB_XGEN(b.x)], 1u);
            asm volatile("s_waitcnt vmcnt(0)" ::: "memory");
        } else {
            XB_SPIN(xb_ld(&bar[XB_XGEN(b.x)]) == gen, bar);
            __builtin_amdgcn_fence(__ATOMIC_ACQUIRE, "agent");
            asm volatile("s_waitcnt vmcnt(0)" ::: "memory");
        }
    }
    __syncthreads();
}

struct Args { const float* in[22]; float* out; unsigned char* ws; };
__device__ __forceinline__ unsigned* bar_words() { const __attribute__((address_space(4))) Args* ap_ = (const __attribute__((address_space(4))) Args*)__builtin_amdgcn_kernarg_segment_ptr(); asm volatile("" : "+s"(ap_)); return (unsigned*)(ap_->ws); }
constexpr int LDS_BARST = 131072 + 512;


constexpr int G_QD = 0, G_KD = 17408, G_KPT = 34816, G_VT = 53248, G_ALR = 90112, G_PART = 94208, G_GL = 98304, G_SSQ = 98816, G_WAL = 100864, G_GN = 109056;
#define MFMA16(a, b, c) __builtin_amdgcn_mfma_f32_16x16x32_bf16((a), (b), (c), 0, 0, 0)
#define LBAR() do { asm volatile("s_waitcnt lgkmcnt(0)" ::: "memory"); __builtin_amdgcn_s_barrier(); asm volatile("" ::: "memory"); } while (0)
__device__ __forceinline__ bf16x8 pack8(const f32x4& a, const f32x4& b) {
    u32x4 p; p.x = pk2(a[0], a[1]); p.y = pk2(a[2], a[3]); p.z = pk2(b[0], b[1]); p.w = pk2(b[2], b[3]); return __builtin_bit_cast(bf16x8, p);
}
__device__ __forceinline__ float logsig16(float x) { return (fminf(x, 0.f) - __logf(1.0f + __expf(-fabsf(x)))) * (1.0f / 16.0f); }
template <bool DO_O>
__device__ __forceinline__ void gla_unit(LAS unsigned char* lds, const int tid_in, const int row0, const int nchunks, const int nvalid, const int h,
                                         const bf16* PA, const float* ALR, const float* w_alpha, const float* b_alpha, const float* gnorm,
                                         const float* Sinit, float* Sout, float* Gout, bf16* ACAT, unsigned long long& gacc) {
#ifndef PROBE_SUB
#define PROBE_SUB -1
#endif
    unsigned long long glast = 0; (void)glast;
#define GSTAMP(k) do { if (PROBE_SUB >= 0) { const unsigned long long t_ = __builtin_amdgcn_s_memrealtime(); if ((k) == PROBE_SUB) gacc += t_ - glast; glast = t_; } } while (0)
    const int tid = lane_id_fresh() + 64 * tid_in;
    const int lane = tid & 63, wid = tid >> 6, fr = lane & 15, fq = lane >> 4, dvb = wid * 32;
    LAS float* ALRL = (LAS float*)(lds + G_ALR); LAS float* PART = (LAS float*)(lds + G_PART); LAS float* GL = (LAS float*)(lds + G_GL); LAS float* SSQ = (LAS float*)(lds + G_SSQ);
    LAS float* WAL = (LAS float*)(lds + G_WAL); LAS float* GN = (LAS float*)(lds + G_GN);
    LBAR();
#pragma unroll
    for (int j = 0; j < 4; ++j) { const int i = tid + 512 * j; WAL[i] = w_alpha[(i >> 7) * 512 + h * 128 + (i & 127)]; }
    if (tid < 256) GN[tid] = gnorm[tid];
    f32x4 S[8][2];
#pragma unroll
    for (int kt = 0; kt < 8; ++kt)
#pragma unroll
        for (int dvt = 0; dvt < 2; ++dvt) {
            if (Sinit) {
#pragma unroll
                for (int r = 0; r < 4; ++r) S[kt][dvt][r] = Sinit[(size_t)(16 * kt + 4 * fq + r) * 256 + dvb + 16 * dvt + fr];
            } else S[kt][dvt] = (f32x4){0.f, 0.f, 0.f, 0.f};
        }
    const int dkp = tid & 63, tg = tid >> 6, dv2 = tid & 127, vg = tid >> 7;
    const f32x2 bal = *(const f32x2*)(b_alpha + h * 128 + 2 * dkp);
    float gsum0 = 0.f, gsum1 = 0.f;
    unsigned qc[8], kc[8], vc[16]; f32x2 ac;
#define GLA_LOAD(rbase) do { \
        _Pragma("unroll") for (int i = 0; i < 8; ++i) { const int t = 8 * tg + i; qc[i] = 0u; kc[i] = 0u; \
            if (t < nvalid) { const bf16* p_ = PA + (size_t)((rbase) + t) * PA_LD + h * 128 + 2 * dkp; qc[i] = *(const unsigned*)(p_ + 512); kc[i] = *(const unsigned*)(p_ + 1024); } } \
        _Pragma("unroll") for (int i = 0; i < 16; ++i) { const int t = 16 * vg + i; vc[i] = 0u; if (t < nvalid) vc[i] = *(const unsigned*)(PA + (size_t)((rbase) + t) * PA_LD + 1536 + h * 256 + 2 * dv2); } \
        int tl_ = tid; asm volatile("" : "+v"(tl_)); ac = (f32x2){0.f, 0.f}; if ((tl_ >> 3) < nvalid) ac = *(const f32x2*)(ALR + (size_t)((rbase) + (tl_ >> 3)) * 16 + (tl_ & 7) * 2); } while (0)
    GLA_LOAD(row0);
    for (int ch = 0; ch < nchunks; ++ch) {
        const int r0 = row0 + ch * 64;
        LBAR();
        GSTAMP(-2);
        *(LAS f32x2*)(ALRL + (tid >> 3) * 16 + (tid & 7) * 2) = ac;
        {
            u32x4 lo0, lo1, hi0, hi1;
#pragma unroll
            for (int j = 0; j < 4; ++j) { lo0[j] = (vc[2 * j] & 0xffffu) | (vc[2 * j + 1] << 16); hi0[j] = (vc[2 * j] >> 16) | (vc[2 * j + 1] & 0xffff0000u);
                lo1[j] = (vc[8 + 2 * j] & 0xffffu) | (vc[8 + 2 * j + 1] << 16); hi1[j] = (vc[8 + 2 * j] >> 16) | (vc[8 + 2 * j + 1] & 0xffff0000u); }
            LAS unsigned char* vt = lds + G_VT + (2 * dv2) * 144 + vg * 32;
            *(LAS u32x4*)(vt) = lo0; *(LAS u32x4*)(vt + 16) = lo1; *(LAS u32x4*)(vt + 144) = hi0; *(LAS u32x4*)(vt + 160) = hi1;
        }
        LBAR();
        GSTAMP(0);
        float bl0[8], bl1[8];
        {
            f32x2 wl[16];
#pragma unroll
            for (int r = 0; r < 16; ++r) wl[r] = *(const LAS f32x2*)(WAL + r * 128 + 2 * dkp);
            float run0 = 0.f, run1 = 0.f;
#pragma unroll
            for (int i = 0; i < 8; ++i) { const int t = 8 * tg + i; const LAS f32x4* ar = (const LAS f32x4*)(ALRL + t * 16); float x0 = bal[0], x1 = bal[1];
#pragma unroll
                for (int j = 0; j < 4; ++j) { const f32x4 a4 = ar[j];
#pragma unroll
                    for (int e = 0; e < 4; ++e) { x0 += a4[e] * wl[4 * j + e][0]; x1 += a4[e] * wl[4 * j + e][1]; } }
                const bool ok = t < nvalid; run0 += ok ? logsig16(x0) : 0.f; run1 += ok ? logsig16(x1) : 0.f; bl0[i] = run0; bl1[i] = run1; }
            *(LAS f32x2*)(PART + tg * 128 + 2 * dkp) = (f32x2){run0, run1};
        }
        LBAR();
        GSTAMP(1);
        {
            float off0 = 0.f, off1 = 0.f, tot0 = 0.f, tot1 = 0.f;
#pragma unroll
            for (int t8 = 0; t8 < 8; ++t8) { const f32x2 p = *(const LAS f32x2*)(PART + t8 * 128 + 2 * dkp); tot0 += p[0]; tot1 += p[1]; off0 += (t8 < tg) ? p[0] : 0.f; off1 += (t8 < tg) ? p[1] : 0.f; }
            unsigned kp0[4], kp1[4];
#pragma unroll
            for (int i = 0; i < 8; ++i) { const int t = 8 * tg + i; const float b0 = bl0[i] + off0, b1 = bl1[i] + off1;
                const float q0 = bf_lo(qc[i]) * 0.08838834764831845f, q1 = bf_hi(qc[i]) * 0.08838834764831845f, k0 = bf_lo(kc[i]), k1 = bf_hi(kc[i]);
                *(LAS unsigned*)(lds + G_QD + t * 272 + 4 * dkp) = pk2(q0 * __expf(b0), q1 * __expf(b1));
                *(LAS unsigned*)(lds + G_KD + t * 272 + 4 * dkp) = pk2(k0 * __expf(-b0), k1 * __expf(-b1));
                const unsigned a0 = f2bf(k0 * __expf(tot0 - b0)), a1 = f2bf(k1 * __expf(tot1 - b1));
                if (i & 1) { kp0[i >> 1] |= a0 << 16; kp1[i >> 1] |= a1 << 16; } else { kp0[i >> 1] = a0; kp1[i >> 1] = a1; } }
            LAS unsigned char* kp = lds + G_KPT + (2 * dkp) * 144 + tg * 16;
            *(LAS u32x4*)kp = (u32x4){kp0[0], kp0[1], kp0[2], kp0[3]}; *(LAS u32x4*)(kp + 144) = (u32x4){kp1[0], kp1[1], kp1[2], kp1[3]};
            if (tg == 0) *(LAS f32x2*)(GL + 2 * dkp) = (f32x2){__expf(tot0), __expf(tot1)};
            if constexpr (!DO_O) { gsum0 += tot0; gsum1 += tot1; }
        }
        LBAR();
        GSTAMP(2);
        u32x2 gq[4][2];
        if constexpr (!DO_O) { if (ch + 1 < nchunks) GLA_LOAD(r0 + 64); }
        if constexpr (DO_O) {
            f32x4 oT[4][2];
#pragma unroll
            for (int it = 0; it < 4; ++it) {
                oT[it][0] = (f32x4){0.f, 0.f, 0.f, 0.f}; oT[it][1] = (f32x4){0.f, 0.f, 0.f, 0.f};
#pragma unroll
                for (int jp = 0; jp < 2; ++jp) {
                    if (2 * jp > it) continue;
                    const int jt0 = 2 * jp, jt1 = 2 * jp + 1;
                    f32x4 P0 = (f32x4){0.f, 0.f, 0.f, 0.f}, P1 = (f32x4){0.f, 0.f, 0.f, 0.f};
#pragma unroll
                    for (int ks = 0; ks < 4; ++ks) {
                        const bf16x8 yq = *(const LAS bf16x8*)(lds + G_QD + (16 * it + fr) * 272 + (32 * ks + 8 * fq) * 2);
                        const bf16x8 x0 = *(const LAS bf16x8*)(lds + G_KD + (16 * jt0 + fr) * 272 + (32 * ks + 8 * fq) * 2);
                        P0 = MFMA16(x0, yq, P0);
                        if (jt1 <= it) { const bf16x8 x1 = *(const LAS bf16x8*)(lds + G_KD + (16 * jt1 + fr) * 272 + (32 * ks + 8 * fq) * 2); P1 = MFMA16(x1, yq, P1); }
                    }
                    if (jt0 == it) {
#pragma unroll
                        for (int r = 0; r < 4; ++r) if (fr < 4 * fq + r) P0[r] = 0.f;
                    }
                    if (jt1 == it) {
#pragma unroll
                        for (int r = 0; r < 4; ++r) if (fr < 4 * fq + r) P1[r] = 0.f;
                    }
                    const bf16x8 pb = pack8(P0, P1);
#pragma unroll
                    for (int dvt = 0; dvt < 2; ++dvt) {
                        const LAS unsigned char* vr = lds + G_VT + (dvb + 16 * dvt + fr) * 144;
                        const s16x4 a0 = *(const LAS s16x4*)(vr + (16 * jt0 + 4 * fq) * 2), a1 = *(const LAS s16x4*)(vr + (16 * jt1 + 4 * fq) * 2);
                        const bf16x8 xa = __builtin_shufflevector(a0, a1, 0, 1, 2, 3, 4, 5, 6, 7);
                        oT[it][dvt] = MFMA16(xa, pb, oT[it][dvt]);
                    }
                }
            }
            asm volatile("" ::: "memory");
#pragma unroll
            for (int it = 0; it < 4; ++it)
#pragma unroll
                for (int dvt = 0; dvt < 2; ++dvt) { gq[it][dvt] = (u32x2){0u, 0u};
                    if (16 * it + fr < nvalid) gq[it][dvt] = *(const u32x2*)(PA + (size_t)(r0 + 16 * it + fr) * PA_LD + 2560 + h * 256 + dvb + 16 * dvt + 4 * fq); }
            if (ch + 1 < nchunks) GLA_LOAD(r0 + 64);
            asm volatile("" ::: "memory");
#pragma unroll
            for (int kp = 0; kp < 4; ++kp) {
                const bf16x8 Sb0 = pack8(S[2 * kp][0], S[2 * kp + 1][0]), Sb1 = pack8(S[2 * kp][1], S[2 * kp + 1][1]);
#pragma unroll
                for (int it = 0; it < 4; ++it) {
                    const LAS unsigned char* qr = lds + G_QD + (16 * it + fr) * 272;
                    const s16x4 q0 = *(const LAS s16x4*)(qr + (32 * kp + 4 * fq) * 2), q1 = *(const LAS s16x4*)(qr + (32 * kp + 16 + 4 * fq) * 2);
                    const bf16x8 yq = __builtin_shufflevector(q0, q1, 0, 1, 2, 3, 4, 5, 6, 7);
                    oT[it][0] = MFMA16(Sb0, yq, oT[it][0]); oT[it][1] = MFMA16(Sb1, yq, oT[it][1]);
                }
            }
#pragma unroll
            for (int it = 0; it < 4; ++it) {
                float ss = 0.f;
#pragma unroll
                for (int dvt = 0; dvt < 2; ++dvt)
#pragma unroll
                    for (int r = 0; r < 4; ++r) ss += oT[it][dvt][r] * oT[it][dvt][r];
                ss += shfl_xor_l(ss, 16, lane); ss += shfl_xor_l(ss, 32, lane);
                if (fq == 0) SSQ[wid * 64 + 16 * it + fr] = ss;
            }
            LBAR();
            GSTAMP(3);
            int r0o = r0; asm volatile("" : "+s"(r0o));
#pragma unroll
            for (int it = 0; it < 4; ++it) {
                const int tok = 16 * it + fr; float tss = 0.f;
#pragma unroll
                for (int w = 0; w < 8; ++w) tss += SSQ[w * 64 + tok];
                const float rstd = rsqrtf(tss * (1.0f / 256.0f) + EPS);
                if (tok < nvalid) {
#pragma unroll
                    for (int dvt = 0; dvt < 2; ++dvt) { const int dv0 = dvb + 16 * dvt + 4 * fq; const size_t row = (size_t)(r0o + tok);
                        const u32x2 g4 = gq[it][dvt]; const f32x4 gn = *(const LAS f32x4*)(GN + dv0);
                        const f32x4 o = oT[it][dvt]; u32x2 w;
                        w.x = pk2(o[0] * rstd * gn[0] * silu_f(bf_lo(g4.x)), o[1] * rstd * gn[1] * silu_f(bf_hi(g4.x)));
                        w.y = pk2(o[2] * rstd * gn[2] * silu_f(bf_lo(g4.y)), o[3] * rstd * gn[3] * silu_f(bf_hi(g4.y)));
                        *(u32x2*)(ACAT + row * KCAT + 512 + h * 256 + dv0) = w; }
                }
            }
        }
        GSTAMP(4);
#pragma unroll
        for (int kt = 0; kt < 8; ++kt) { const f32x4 gl = *(const LAS f32x4*)(GL + 16 * kt + 4 * fq); S[kt][0] *= gl; S[kt][1] *= gl; }
#pragma unroll
        for (int ks = 0; ks < 2; ++ks) {
            const bf16x8 yv0 = *(const LAS bf16x8*)(lds + G_VT + (dvb + fr) * 144 + (32 * ks + 8 * fq) * 2);
            const bf16x8 yv1 = *(const LAS bf16x8*)(lds + G_VT + (dvb + 16 + fr) * 144 + (32 * ks + 8 * fq) * 2);
#pragma unroll
            for (int kt = 0; kt < 8; ++kt) { const bf16x8 xk = *(const LAS bf16x8*)(lds + G_KPT + (16 * kt + fr) * 144 + (32 * ks + 8 * fq) * 2);
                S[kt][0] = MFMA16(xk, yv0, S[kt][0]); S[kt][1] = MFMA16(xk, yv1, S[kt][1]); }
        }
        GSTAMP(5);
    }
#undef GLA_LOAD
    if (Sout) {
        int l2 = lane; asm volatile("" : "+v"(l2)); const int fr2 = l2 & 15, fq2 = l2 >> 4;
#pragma unroll
        for (int kt = 0; kt < 8; ++kt)
#pragma unroll
            for (int dvt = 0; dvt < 2; ++dvt)
#pragma unroll
                for (int r = 0; r < 4; ++r) Sout[(size_t)(16 * kt + 4 * fq2 + r) * 256 + dvb + 16 * dvt + fr2] = S[kt][dvt][r];
    }
    if constexpr (!DO_O) { if (Gout && tg == 0) *(f32x2*)(Gout + 2 * dkp) = (f32x2){__expf(gsum0), __expf(gsum1)}; }
}

template <int STEPS  >
__device__ __forceinline__ f32x4 tile_gemm(LAS unsigned char* lds, const int tid, const bf16* A, const int lda, const bf16* Bt, const int ldb, const int kbase) {
    const int lane = tid & 63, wid = tid >> 6, fr = lane & 15, fq = lane >> 4;
    const bf16* ap = A + (size_t)fr * lda + kbase + wid * (STEPS * 32) + 8 * fq;
    const bf16* bp = Bt + (size_t)fr * ldb + kbase + wid * (STEPS * 32) + 8 * fq;
    f32x4 acc[4][2];
#pragma unroll
    for (int mt = 0; mt < 4; ++mt) { acc[mt][0] = (f32x4){0.f, 0.f, 0.f, 0.f}; acc[mt][1] = (f32x4){0.f, 0.f, 0.f, 0.f}; }
    constexpr int GRP = STEPS < 4 ? STEPS : 4;
#pragma unroll 1
    for (int kb = 0; kb < STEPS / GRP; ++kb) {
        bf16x8 a[GRP][4], b[GRP][2];
#pragma unroll
        for (int ks = 0; ks < GRP; ++ks) {
#pragma unroll
            for (int mt = 0; mt < 4; ++mt) a[ks][mt] = *(const bf16x8*)(ap + (size_t)(16 * mt) * lda + 32 * (kb * GRP + ks));
#pragma unroll
            for (int nt = 0; nt < 2; ++nt) b[ks][nt] = *(const bf16x8*)(bp + (size_t)(16 * nt) * ldb + 32 * (kb * GRP + ks));
        }
#pragma unroll
        for (int ks = 0; ks < GRP; ++ks)
#pragma unroll
            for (int mt = 0; mt < 4; ++mt)
#pragma unroll
                for (int nt = 0; nt < 2; ++nt) acc[mt][nt] = MFMA16(b[ks][nt], a[ks][mt], acc[mt][nt]);
    }
    LAS float* RED = (LAS float*)lds;
#pragma unroll
    for (int mt = 0; mt < 4; ++mt)
#pragma unroll
        for (int nt = 0; nt < 2; ++nt) *(LAS f32x4*)(RED + ((wid * 64 + 16 * mt + fr) * 36 + 16 * nt + 4 * fq)) = acc[mt][nt];
    __syncthreads();
    const int tok = tid >> 3, c4 = (tid & 7) * 4; f32x4 sres = (f32x4){0.f, 0.f, 0.f, 0.f};
#pragma unroll
    for (int w = 0; w < 8; ++w) sres += *(const LAS f32x4*)(RED + ((w * 64 + tok) * 36 + c4));
    __syncthreads();
    return sres;
}

__device__ __forceinline__ void norm_row_bf16(const float* xrow, const float* g, const float* shift, const float* scale, bf16* orow, int lane) {
    const f32x4* xr = (const f32x4*)xrow + lane; f32x4 v[4]; float s = 0.f;
#pragma unroll
    for (int j = 0; j < 4; ++j) { v[j] = xr[64 * j]; s += (v[j][0] * v[j][0] + v[j][1] * v[j][1]) + (v[j][2] * v[j][2] + v[j][3] * v[j][3]); }
    const float rstd = rsqrtf(wave_sum(s, lane) * (1.0f / DM) + EPS);
#pragma unroll
    for (int j = 0; j < 4; ++j) { const int c = 4 * lane + 256 * j; const f32x4 gg = *(const f32x4*)(g + c), sh = *(const f32x4*)(shift + c), sc = *(const f32x4*)(scale + c);
        const f32x4 o = v[j] * rstd * gg * (1.0f + sc) + sh;
        u32x2 w; w.x = pk2(o[0], o[1]); w.y = pk2(o[2], o[3]); *(u32x2*)(orow + c) = w; }
}

__global__ void __launch_bounds__(512, 2) fwd_kernel(Args a) {
    extern __shared__ __attribute__((aligned(16))) unsigned char lds_raw[];
    cg::grid_group grid = cg::this_grid();
    LAS unsigned char* lds = (LAS unsigned char*)lds_raw;
    const int wave = __builtin_amdgcn_readfirstlane((int)threadIdx.x >> 6);
    const int G = gridDim.x, blk = blockIdx.x, gw = blk * 8 + wave, NGW = G * 8;
#ifndef PROBE_LO
#define PROBE_LO -1
#define PROBE_HI -1
#endif
    { const int t0_ = lane_id_fresh() + 64 * wave; if (t0_ < 2) ((LAS unsigned*)(lds + LDS_BARST))[t0_] = 0u; __syncthreads();
      (void)xcd_barrier_post(bar_words(), (volatile LAS unsigned*)(lds + LDS_BARST), t0_); }
    unsigned long long tA = 0, tB = 0, gacc5 = 0, gdummy = 0; (void)gdummy;
    if (PROBE_LO == 0) tA = __builtin_amdgcn_s_memrealtime();
#define STAMP(k) do { if (PROBE_LO >= 0) { if ((k) == PROBE_LO - 1) tA = __builtin_amdgcn_s_memrealtime(); if ((k) == PROBE_HI) tB = __builtin_amdgcn_s_memrealtime(); } } while (0)
#define GRID_BAR() do { XcdBarrier b_; b_.bar = bar_words(); b_.x = xb_xcc_id(); b_.st = (volatile LAS unsigned*)(lds + LDS_BARST); xcd_barrier(b_, lane_id_fresh() + 64 * wave); } while (0)
#define FRESH_TID() const __attribute__((address_space(4))) Args* ap = (const __attribute__((address_space(4))) Args*)__builtin_amdgcn_kernarg_segment_ptr(); asm volatile("" : "+s"(ap)); int tid = lane_id_fresh() + 64 * wave; const int lane = tid & 63; (void)lane; (void)tid
#define ws (ap->ws)
#define out (ap->out)
#define x_prompt (ap->in[0])
#define x_sample (ap->in[1])
#define c_prompt (ap->in[2])
#define c_sample (ap->in[3])
#define state_gla (ap->in[4])
#define cache_pool (ap->in[5])
#define w_ada (ap->in[6])
#define b_ada (ap->in[7])
#define norm1_g (ap->in[8])
#define w_in (ap->in[9])
#define w_alpha (ap->in[10])
#define b_alpha (ap->in[11])
#define w_pool (ap->in[12])
#define pool_scale (ap->in[13])
#define gla_norm_g (ap->in[14])
#define w_pa (ap->in[15])
#define w_pb (ap->in[16])
#define w_out (ap->in[17])
#define norm2_g (ap->in[18])
#define w_ff1 (ap->in[19])
#define w_ff2 (ap->in[20])
#define final_g (ap->in[21])
#define MOD ((float*)(ws + WS_MOD))
#define ALR ((float*)(ws + WS_ALR))
#define GT ((float*)(ws + WS_GT))
#define Win_t ((bf16*)(ws + WS_WIN))
#define Wcat_t ((bf16*)(ws + WS_WCAT))
#define Wout_t ((bf16*)(ws + WS_WOUT))
#define Wff1_t ((bf16*)(ws + WS_WFF1))
#define Wff2_t ((bf16*)(ws + WS_WFF2))
#define PB ((bf16*)(ws + WS_PB))
#define PA ((bf16*)(ws + WS_PA))
#define US ((float*)(ws + WS_US))
#define MODP ((float*)(ws + WS_US))
#define H ((bf16*)out)
#define ACAT ((bf16*)out)
#define H2 ((bf16*)(ws + WS_PB))
#define MERGED ((bf16*)(ws + WS_PA))
#define HID ((bf16*)(ws + WS_PA))
#define Y (out + O_Y)
#define MERGED_S ((bf16*)(ws + WS_MS))
#define H2_S ((bf16*)(ws + WS_H2S))
#define HID_S ((bf16*)(ws + WS_HIDS))

    {
        FRESH_TID();
        LAS float* scr = (LAS float*)(lds + wave * 16384);
        constexpr int I_IN = 16 * 184, I_PB = 16 * 32, I_OUT = 16 * 32, I_F1 = 16 * 128, I_F2 = 64 * 32, I_WA = 1024, I_MOD = 96 * 16;
        constexpr int NITEMS = I_MOD + I_IN + I_PB + I_OUT + I_F1 + I_F2 + I_WA;
        for (int it = gw; it < NITEMS; it += NGW) {
            int r = it;
            if (r < I_WA) {
                const int g = r >> 8, cb = (r >> 4) & 15, nb = r & 15, n = 64 * nb + lane, c0 = 8 * cb;
                float acc[8];
#pragma unroll
                for (int cc = 0; cc < 8; ++cc) acc[cc] = 0.f;
#pragma unroll 1
                for (int db = 0; db < 4; ++db) { float wp[32];
#pragma unroll
                    for (int d = 0; d < 32; ++d) wp[d] = w_pa[(size_t)(g * 128 + db * 32 + d) * DM + n] * pool_scale[g * 128 + db * 32 + d];
#pragma unroll
                    for (int d = 0; d < 32; ++d)
#pragma unroll
                        for (int cc = 0; cc < 8; ++cc) acc[cc] += w_pool[(size_t)(g * 128 + c0 + cc) * 128 + db * 32 + d] * wp[d]; }
                u32x4 o; o.x = pk2(acc[0], acc[1]); o.y = pk2(acc[2], acc[3]); o.z = pk2(acc[4], acc[5]); o.w = pk2(acc[6], acc[7]);
                *(u32x4*)(Wcat_t + (size_t)n * KCAT + g * 128 + c0) = o;
                continue;
            }
            r -= I_WA;
            if (r < I_MOD) {
                const int cgp = r % 96, ks = r / 96, k0 = 64 * ks, n = 64 * cgp + lane;
                { float cvv[NROWS_MOD];
#pragma unroll
                  for (int rr = 0; rr < NROWS_MOD; ++rr) cvv[rr] = rr == 0 ? c_prompt[k0 + lane] : c_sample[(size_t)(rr - 1) * DM + k0 + lane];
#pragma unroll
                  for (int rr = 0; rr < NROWS_MOD; ++rr) scr[rr * 64 + lane] = silu_f(cvv[rr]); }
                asm volatile("s_waitcnt lgkmcnt(0)" ::: "memory");
                float acc[NROWS_MOD];
#pragma unroll
                for (int rr = 0; rr < NROWS_MOD; ++rr) acc[rr] = 0.f;
#pragma unroll
                for (int kb = 0; kb < 2; ++kb) { float wv[32];
#pragma unroll
                    for (int kk = 0; kk < 32; ++kk) wv[kk] = w_ada[(size_t)(k0 + kb * 32 + kk) * NMOD + n];
#pragma unroll
                    for (int kk = 0; kk < 32; ++kk)
#pragma unroll
                        for (int rr = 0; rr < NROWS_MOD; ++rr) acc[rr] += scr[rr * 64 + kb * 32 + kk] * wv[kk]; }
#pragma unroll
                for (int rr = 0; rr < NROWS_MOD; ++rr) MODP[((size_t)ks * NROWS_MOD + rr) * NMOD + n] = acc[rr];
                asm volatile("s_waitcnt lgkmcnt(0)" ::: "memory");
                continue;
            }
            r -= I_MOD;
            if (r < I_IN) { const int kb = r / 184, nb = r % 184; int c0, valid;
                if (nb < 112) { c0 = 32 * nb; valid = 32; } else if (nb < 176) { c0 = 32 * nb + 16; valid = 32; } else if (nb == 176) { c0 = 3584; valid = 16; } else { c0 = 0; valid = 0; }
                transpose_item(w_in, 5648, 64 * kb, c0, valid, Win_t, DM, 32 * nb, 0, scr, lane); continue; }
            r -= I_IN;
            if (r < I_PB) { transpose_item(w_pb, DM, 64 * (r / 32), 32 * (r % 32), 32, Wcat_t, KCAT, 32 * (r % 32), 512, scr, lane); continue; }
            r -= I_PB;
            if (r < I_OUT) { transpose_item(w_out, DM, 64 * (r / 32), 32 * (r % 32), 32, Wout_t, DM, 32 * (r % 32), 0, scr, lane); continue; }
            r -= I_OUT;
            if (r < I_F1) { transpose_item(w_ff1, DFF, 64 * (r / 128), 32 * (r % 128), 32, Wff1_t, DM, 32 * (r % 128), 0, scr, lane); continue; }
            r -= I_F1;
            transpose_item(w_ff2, DM, 64 * (r / 32), 32 * (r % 32), 32, Wff2_t, DFF, 32 * (r % 32), 0, scr, lane);
        }
    }
    if (gridDim.x == 0x7fffffffu) grid.sync();
    GRID_BAR(); STAMP(0);
    { FRESH_TID();
    for (int i = blk * 512 + tid; i < NROWS_MOD * NMOD; i += G * 512) { float s = b_ada[i % NMOD];
#pragma unroll
        for (int ks = 0; ks < 16; ++ks) s += MODP[(size_t)ks * NROWS_MOD * NMOD + i];
        MOD[i] = s; } }
    GRID_BAR(); STAMP(1);
    { FRESH_TID();
    for (int m = gw; m < MT; m += NGW) { const int seq = m < MP ? 0 : 1 + ((m - MP) >> 4); const float* xr = m < MP ? x_prompt + (size_t)m * DM : x_sample + (size_t)(m - MP) * DM;
        norm_row_bf16(xr, norm1_g, MOD + (size_t)seq * NMOD, MOD + (size_t)seq * NMOD + 1024, H + (size_t)m * DM, lane); } }
    GRID_BAR(); STAMP(2);
    {
        FRESH_TID();
        pg8::Gemm g{H, Win_t, MT, NIN, DM}; pg8::StaticOrder S; S.init(MT, NIN, G, blk);
        pg8::EpiProj E{PA, PB, ALR};
        pg8::gemm_phase<pg8::EpiProj, pg8::StaticOrder, true, true>(lds, g, S, E, wave);
    }
    GRID_BAR(); STAMP(3);
    {
        FRESH_TID();
        for (int u = blk; u < NSC * 4; u += G) { const int sc2 = u >> 2, h2 = u & 3;
            gla_unit<false>(lds, wave, sc2 * 256, 4, 64, h2, PA, ALR, w_alpha, b_alpha, gla_norm_g, nullptr, US + (size_t)u * 32768, GT + (size_t)u * 128, ACAT, gdummy); }
        for (int u = (G - 1 - blk); u < NSEQ * 4; u += G) { const int s = u >> 2, h = u & 3;
            gla_unit<true>(lds, wave, MP + s * 16, 1, 16, h, PA, ALR, w_alpha, b_alpha, gla_norm_g, state_gla + (size_t)u * 32768, out + O_SGS + (size_t)u * 32768, nullptr, ACAT, gdummy); }
        for (int pt = blk; pt < MT / 16; pt += G) {
            const int rowb = pt * 16, c = tid, gi = c >> 7, w = 2 << gi; const bool samp = rowb >= MP; const int seq = samp ? (rowb - MP) >> 4 : 0;
            float e[31];
#pragma unroll
            for (int i = 0; i < 31; ++i) { const int j = i - 15; float v;
                if (j >= 0) v = bf2f(PA[(size_t)(rowb + j) * PA_LD + c]);
                else if (samp) v = cache_pool[((size_t)seq * 15 + (15 + j)) * 512 + c];
                else v = (rowb + j >= 0) ? bf2f(PA[(size_t)(rowb + j) * PA_LD + c]) : 0.f;
                e[i] = v; }
            float ps[32]; ps[0] = 0.f;
#pragma unroll
            for (int i = 0; i < 31; ++i) ps[i + 1] = ps[i] + e[i];
#pragma unroll
            for (int tl = 0; tl < 16; ++tl) { const int row = rowb + tl, a2 = 16 + tl; const float ut = e[15 + tl];
                const float lo = gi == 0 ? ps[a2 - 2] : gi == 1 ? ps[a2 - 4] : gi == 2 ? ps[a2 - 8] : ps[a2 - 16];
                const float cnt = samp ? (float)w : (float)((row + 1) < w ? (row + 1) : w);
                ACAT[(size_t)row * KCAT + c] = (bf16)f2bf((ps[a2] - lo) / cnt - ut);
                if (samp) { if (tl >= 1) out[O_CPS + ((size_t)seq * 15 + (tl - 1)) * 512 + c] = ut; }
                else if (row >= MP - 15) out[O_CPP + (size_t)(row - (MP - 15)) * 512 + c] = ut; }
        }
    }
    GRID_BAR(); STAMP(4);
    { FRESH_TID();
    for (int e = blk * 512 + tid; e < 131072; e += G * 512) { float S = 0.f; const int hd = __builtin_amdgcn_readfirstlane(e >> 8);
        float u[NSC];
#pragma unroll
        for (int sc = 0; sc < NSC; ++sc) u[sc] = US[(size_t)sc * 131072 + e];
#pragma unroll
        for (int sc = 0; sc < NSC; ++sc) { US[(size_t)sc * 131072 + e] = S; S = GT[sc * 512 + hd] * S + u[sc]; }
        out[O_SGP + e] = S; }
      for (int tl = blk; tl < 256; tl += G) { const int rb = tl & 7, cb = tl >> 3;
          const bf16* Ab = ACAT + (size_t)(MP + 64 * rb) * KCAT; const bf16* Bb = Wcat_t + (size_t)(32 * cb) * KCAT;
          const f32x4 accA = tile_gemm<2>(lds, tid, Ab, KCAT, Bb, KCAT, 0);
          const f32x4 accB = tile_gemm<4>(lds, tid, Ab, KCAT, Bb, KCAT, 512);
          const int rs = 64 * rb + (tid >> 3), col = 32 * cb + 4 * (tid & 7);
          const u32x2 ga = *(const u32x2*)(PB + (size_t)(MP + rs) * PB_LD + col), gb = *(const u32x2*)(PB + (size_t)(MP + rs) * PB_LD + 1024 + col);
          u32x2 w; w.x = pk2(sigm(bf_lo(ga.x)) * accA[0] + sigm(bf_lo(gb.x)) * accB[0], sigm(bf_hi(ga.x)) * accA[1] + sigm(bf_hi(gb.x)) * accB[1]);
          w.y = pk2(sigm(bf_lo(ga.y)) * accA[2] + sigm(bf_lo(gb.y)) * accB[2], sigm(bf_hi(ga.y)) * accA[3] + sigm(bf_hi(gb.y)) * accB[3]);
          *(u32x2*)(MERGED_S + (size_t)rs * DM + col) = w; } }
    GRID_BAR(); STAMP(5);
    { FRESH_TID();
    for (int u = blk; u < NSC * 4; u += G) { const int sc = u >> 2, h = u & 3;
        gla_unit<true>(lds, wave, sc * 256, 4, 64, h, PA, ALR, w_alpha, b_alpha, gla_norm_g, US + (size_t)u * 32768, nullptr, nullptr, ACAT, gacc5); } }
    { FRESH_TID();
      __syncthreads();
      for (int tl = blk; tl < 256; tl += G) { const int rb = tl & 7, cb = tl >> 3;
          const f32x4 acc = tile_gemm<4>(lds, tid, MERGED_S + (size_t)(64 * rb) * DM, DM, Wout_t + (size_t)(32 * cb) * DM, DM, 0);
          const int rs = 64 * rb + (tid >> 3), col = 32 * cb + 4 * (tid & 7), seq = 1 + (rs >> 4);
          const f32x4 xb = *(const f32x4*)(x_sample + (size_t)rs * DM + col), gt = *(const f32x4*)(MOD + (size_t)seq * NMOD + 2048 + col);
          *(f32x4*)(Y + (size_t)(MP + rs) * DM + col) = xb + gt * acc; } }
    GRID_BAR(); STAMP(6);
    {
        FRESH_TID();
        pg8::Gemm g{ACAT, Wcat_t, MP, DM, KCAT}; pg8::StaticOrder S; S.init(MP, DM, G, blk);
        pg8::EpiMerge E{PB, MERGED};
        pg8::gemm_phase<pg8::EpiMerge, pg8::StaticOrder, true, true>(lds, g, S, E, wave);
        for (int m = gw; m < MS; m += NGW) { const int seq = 1 + (m >> 4);
            norm_row_bf16(Y + (size_t)(MP + m) * DM, norm2_g, MOD + (size_t)seq * NMOD + 3072, MOD + (size_t)seq * NMOD + 4096, H2_S + (size_t)m * DM, lane); }
    }
    GRID_BAR(); STAMP(7);
    {
        FRESH_TID();
        pg8::Gemm g{MERGED, Wout_t, MP, DM, DM}; pg8::StaticOrder S; S.init(MP, DM, G, blk);
        pg8::EpiRes<false> E{x_prompt, Y, MOD + 2048};
        pg8::gemm_phase<pg8::EpiRes<false>, pg8::StaticOrder, true, true>(lds, g, S, E, wave);
        for (int tl = blk; tl < 1024; tl += G) { const int rb = tl & 7, cb = tl >> 3;
            const f32x4 acc = tile_gemm<4>(lds, tid, H2_S + (size_t)(64 * rb) * DM, DM, Wff1_t + (size_t)(32 * cb) * DM, DM, 0);
            const int rs = 64 * rb + (tid >> 3), col = 32 * cb + 4 * (tid & 7);
            const float r0 = fmaxf(acc[0], 0.f), r1 = fmaxf(acc[1], 0.f), r2 = fmaxf(acc[2], 0.f), r3 = fmaxf(acc[3], 0.f);
            u32x2 w; w.x = pk2(r0 * r0, r1 * r1); w.y = pk2(r2 * r2, r3 * r3);
            *(u32x2*)(HID_S + (size_t)rs * DFF + col) = w; }
    }
    GRID_BAR(); STAMP(8);
    { FRESH_TID();
    for (int m = gw; m < MP; m += NGW) { const int seq = 0;
        norm_row_bf16(Y + (size_t)m * DM, norm2_g, MOD + (size_t)seq * NMOD + 3072, MOD + (size_t)seq * NMOD + 4096, H2 + (size_t)m * DM, lane); }
      __syncthreads();
      for (int tl = blk; tl < 256; tl += G) { const int rb = tl & 7, cb = tl >> 3;
          const f32x4 acc = tile_gemm<16>(lds, tid, HID_S + (size_t)(64 * rb) * DFF, DFF, Wff2_t + (size_t)(32 * cb) * DFF, DFF, 0);
          const int rs = 64 * rb + (tid >> 3), col = 32 * cb + 4 * (tid & 7), seq = 1 + (rs >> 4);
          float* yp = Y + (size_t)(MP + rs) * DM + col; const f32x4 gt = *(const f32x4*)(MOD + (size_t)seq * NMOD + 5120 + col);
          *(f32x4*)yp = *(const f32x4*)yp + gt * acc; } }
    GRID_BAR(); STAMP(9);
    {
        FRESH_TID();
        pg8::Gemm g{H2, Wff1_t, MP, DFF, DM}; pg8::StaticOrder S; S.init(MP, DFF, G, blk);
        pg8::EpiRelu2 E{HID};
        pg8::gemm_phase<pg8::EpiRelu2, pg8::StaticOrder, true, true>(lds, g, S, E, wave);
        for (int m = gw; m < MS; m += NGW) { f32x4* xr = (f32x4*)(Y + (size_t)(MP + m) * DM) + lane; f32x4 v[4]; float sq = 0.f;
#pragma unroll
            for (int j = 0; j < 4; ++j) { v[j] = xr[64 * j]; sq += (v[j][0] * v[j][0] + v[j][1] * v[j][1]) + (v[j][2] * v[j][2] + v[j][3] * v[j][3]); }
            const float rstd = rsqrtf(wave_sum(sq, lane) * (1.0f / DM) + EPS);
#pragma unroll
            for (int j = 0; j < 4; ++j) { const f32x4 gg = *(const f32x4*)(final_g + 4 * lane + 256 * j); xr[64 * j] = v[j] * rstd * gg; } }
    }
    GRID_BAR(); STAMP(10);
    {
        FRESH_TID();
        pg8::Gemm g{HID, Wff2_t, MP, DM, DFF}; pg8::StaticOrder S; S.init(MP, DM, G, blk);
        pg8::EpiRes<true> E{nullptr, Y, MOD + 5120};
        pg8::gemm_phase<pg8::EpiRes<true>, pg8::StaticOrder, true, true>(lds, g, S, E, wave);
    }
    GRID_BAR(); STAMP(11);
    { FRESH_TID();
    for (int m = gw; m < MP; m += NGW) { f32x4* xr = (f32x4*)(Y + (size_t)m * DM) + lane; f32x4 v[4]; float s = 0.f;
#pragma unroll
        for (int j = 0; j < 4; ++j) { v[j] = xr[64 * j]; s += (v[j][0] * v[j][0] + v[j][1] * v[j][1]) + (v[j][2] * v[j][2] + v[j][3] * v[j][3]); }
        const float rstd = rsqrtf(wave_sum(s, lane) * (1.0f / DM) + EPS);
#pragma unroll
        for (int j = 0; j < 4; ++j) { const f32x4 gg = *(const f32x4*)(final_g + 4 * lane + 256 * j); xr[64 * j] = v[j] * rstd * gg; } } }
    if (PROBE_LO >= 0 || PROBE_SUB >= 0) { if (PROBE_HI == 12) tB = __builtin_amdgcn_s_memrealtime(); if (blk == 0) { const unsigned long long t0 = __builtin_amdgcn_s_memrealtime(), w = 4ull * (PROBE_SUB >= 0 ? gacc5 : (tB - tA)); while (__builtin_amdgcn_s_memrealtime() - t0 < w) __builtin_amdgcn_s_sleep(8); } }
}

#undef ws
#undef out
#undef x_prompt
#undef x_sample
#undef c_prompt
#undef c_sample
#undef state_gla
#undef cache_pool
#undef w_ada
#undef b_ada
#undef norm1_g
#undef w_in
#undef w_alpha
#undef b_alpha
#undef w_pool
#undef pool_scale
#undef gla_norm_g
#undef w_pa
#undef w_pb
#undef w_out
#undef norm2_g
#undef w_ff1
#undef w_ff2
#undef final_g
#undef MOD
#undef ALR
#undef GT
#undef Win_t
#undef Wcat_t
#undef Wout_t
#undef Wff1_t
#undef Wff2_t
#undef PB
#undef PA
#undef US
#undef MODP
#undef H
#undef ACAT
#undef H2
#undef MERGED
#undef HID
#undef Y
#undef MERGED_S
#undef H2_S
#undef HID_S
extern "C" void kernel_launch(void* const* d_in, const int* in_sizes, int n_in, void* d_out, int out_size, void* d_ws, size_t ws_size, hipStream_t stream) {
    static int grid = 0;
    if (grid == 0) {
        if (n_in != 22 || ws_size < WS_END) { fprintf(stderr, "kernel_launch: unexpected n_in %d / ws %zu\n", n_in, ws_size); grid = -1; return; }
        int dev = 0, cus = 0, per_cu = 0;
        hipGetDevice(&dev); hipDeviceGetAttribute(&cus, hipDeviceAttributeMultiprocessorCount, dev);
        if (hipFuncSetAttribute((const void*)fwd_kernel, hipFuncAttributeMaxDynamicSharedMemorySize, LDS_BYTES) != hipSuccess) { fprintf(stderr, "kernel_launch: hipFuncSetAttribute failed\n"); grid = -1; return; }
        if (hipOccupancyMaxActiveBlocksPerMultiprocessor(&per_cu, (const void*)fwd_kernel, 512, LDS_BYTES) != hipSuccess || per_cu < 1) { fprintf(stderr, "kernel_launch: occupancy query says %d\n", per_cu); per_cu = 1; }
        (void)hipGetLastError();
        grid = cus * 1;
    }
    if (grid < 0) return;
    if (hipMemsetAsync(d_ws, 0, 65536, stream) != hipSuccess) { fprintf(stderr, "kernel_launch: memset failed\n"); return; }
    Args a{};
    for (int i = 0; i < 22; ++i) a.in[i] = (const float*)d_in[i];
    a.out = (float*)d_out; a.ws = (unsigned char*)d_ws;
    void* args[] = {&a};
    hipError_t e = hipLaunchCooperativeKernel((const void*)fwd_kernel, dim3(grid), dim3(512), args, LDS_BYTES, stream);
    if (e != hipSuccess) fprintf(stderr, "kernel_launch: cooperative launch failed: %s (grid %d)\n", hipGetErrorString(e), grid);
}
```

```cpp
#include <hip/hip_runtime.h>
#include <hip/hip_cooperative_groups.h>
#include <cstdio>
#include <cstdint>
namespace cg = cooperative_groups;
__device__ __forceinline__ int lane_id_fresh() { int l; asm volatile("v_mbcnt_lo_u32_b32 %0, -1, 0\n\tv_mbcnt_hi_u32_b32 %0, -1, %0" : "=v"(l)); return l; }
__device__ __forceinline__ float shfl_xor_l(float v, int o, int lane) { return __int_as_float(__builtin_amdgcn_ds_bpermute((lane ^ o) << 2, __float_as_int(v))); }
__device__ __forceinline__ float bf_lo(unsigned w) { return __uint_as_float(w << 16); }
__device__ __forceinline__ float bf_hi(unsigned w) { return __uint_as_float(w & 0xffff0000u); }
__device__ __forceinline__ float sigm(float x) { return 1.0f / (1.0f + __expf(-x)); }
namespace pg8 {
#define PG8_LAS __attribute__((address_space(3)))
typedef unsigned short bf16_t;
typedef short bf16x8 __attribute__((ext_vector_type(8)));
typedef float f32x4 __attribute__((ext_vector_type(4)));
typedef unsigned u32x4 __attribute__((ext_vector_type(4)));
constexpr int BM = 256, BK = 64, HALF = 128, HTB = HALF * BK * 2  , STAGE_BYTES = 8 * HTB, NXCD = 8, WGM = 8;

__host__ __device__ __forceinline__ int lds_byte(int r, int c) { const int st = (r >> 4) * 2 + (c >> 5), rr = r & 15, cc = c & 31, ob = rr * 64 + cc * 2; return st * 1024 + (ob ^ (((ob >> 9) & 1) << 5)); }
__host__ __device__ __forceinline__ void stage_rc(int b, int& R, int& C) { const int st = b / 1024, sb = b % 1024, swz = sb ^ (((sb >> 9) & 1) << 5); R = (st >> 1) * 16 + swz / 64; C = (st & 1) * 32 + (swz % 64) / 2; }
__host__ __device__ __forceinline__ int perm32(int rho) { const int n = rho >> 4, i = rho & 15; return 8 * (i >> 2) + 4 * n + (i & 3); }

struct Unit { int pm, pn; };
struct Gemm { const bf16_t* A; const bf16_t* Bt; int M, N, K; };

struct StaticOrder {
    int nM, nN, nwg, G, c;
    __host__ __device__ void init(int M, int N, int G_, int c_) { nM = M / BM; nN = N / BM; nwg = nM * nN; G = G_; c = c_; }
    __host__ __device__ bool next(int i, Unit& u) const {
        const long L = (long)i * G + c; if (L >= nwg) return false;
        int wgid = (int)L; { const int q = nwg / NXCD, r = nwg % NXCD, xcd = wgid % NXCD, off = wgid / NXCD; wgid = (xcd < r ? xcd * (q + 1) : r * (q + 1) + (xcd - r) * q) + off; }
        const int nig = WGM * nN, gid = wgid / nig, fm = gid * WGM, gsz = (nM - fm) < WGM ? (nM - fm) : WGM;
        u.pm = fm + ((wgid % nig) % gsz); u.pn = (wgid % nig) / gsz; return true;
    }
    __device__ __forceinline__ void a_ready(const Unit&) const {}
    __device__ __forceinline__ void done(const Unit&) const {}
};

__device__ __forceinline__ unsigned cvt_pk_bf16(float lo, float hi) { unsigned r; asm volatile("v_cvt_pk_bf16_f32 %0, %1, %2" : "=v"(r) : "v"(lo), "v"(hi)); return r; }
template <class Epi, class Sched, bool ALIGN_EPI = false, bool SP2 = false>
__device__ __forceinline__ void gemm_phase(PG8_LAS unsigned char* lds, const Gemm g, const Sched& S, const Epi& E, const int wave_id) {
    int tid_ = lane_id_fresh() + 64 * wave_id;
    const int tid = tid_, wid = __builtin_amdgcn_readfirstlane(tid >> 6), lane = tid & 63, wr = wid >> 2, wc = wid & 3, fr = lane & 15, fq = lane >> 4;
    const int K = g.K, nt = K / BK;
    unsigned voffA[2], voffB[2];
#pragma unroll
    for (int i = 0; i < 2; ++i) { int R, C; stage_rc(tid * 16 + i * 8192, R, C); const int Rb = Epi::PERM ? ((R & ~31) + perm32(R & 31)) : R;
        voffA[i] = (unsigned)(R * K + C) * 2u; voffB[i] = (unsigned)(Rb * K + C) * 2u; }
    const size_t kstep = (size_t)(BK * 2);
    const size_t hstep = (size_t)HALF * K * 2;
    const size_t tstep = 2 * hstep;
    const unsigned ldsw = (unsigned)wid * 1024u;
    const int aoff = lds_byte(wr * 64 + fr, fq * 8), boff = lds_byte(wc * 32 + fr, fq * 8);
#define PG8_SA(b, h) (((b) * 2 + (h)) * HTB)
#define PG8_SB(b, h) ((4 + (b) * 2 + (h)) * HTB)
#define PG8_STAGE(bufoff, gbase, voff) do { _Pragma("unroll") for (int _i = 0; _i < 2; ++_i) \
        __builtin_amdgcn_global_load_lds((const unsigned*)((const char*)(gbase) + (voff)[_i]), (PG8_LAS unsigned*)(lds + (bufoff) + ldsw + _i * 8192), 16, 0, 0); } while (0)
#define PG8_LDA(dst, b, h) do { _Pragma("unroll") for (int m = 0; m < 4; ++m) _Pragma("unroll") for (int k = 0; k < 2; ++k) dst[m][k] = *(const PG8_LAS bf16x8*)(lds + PG8_SA(b, h) + aoff + m * 2048 + k * 1024); } while (0)
#define PG8_LDB(dst, b, h) do { _Pragma("unroll") for (int n = 0; n < 2; ++n) _Pragma("unroll") for (int k = 0; k < 2; ++k) dst[n][k] = *(const PG8_LAS bf16x8*)(lds + PG8_SB(b, h) + boff + n * 2048 + k * 1024); } while (0)
#define PG8_MMA(ai, bj, At, Bt) do { __builtin_amdgcn_s_setprio(1); _Pragma("unroll") for (int m = 0; m < 4; ++m) _Pragma("unroll") for (int n = 0; n < 2; ++n) _Pragma("unroll") for (int k = 0; k < 2; ++k) \
        acc[ai][bj][m][n] = __builtin_amdgcn_mfma_f32_16x16x32_bf16(Bt[n][k], At[m][k], acc[ai][bj][m][n], 0, 0, 0); __builtin_amdgcn_s_setprio(0); } while (0)
#define PG8_WAIT_V(n) asm volatile("s_waitcnt vmcnt(" #n ")" ::: "memory")
#define PG8_WAIT_L(n) asm volatile("s_waitcnt lgkmcnt(" #n ")" ::: "memory")
#define PG8_BAR __builtin_amdgcn_s_barrier()
#define PG8_SCHED __builtin_amdgcn_sched_barrier(0)
    Unit cur, nxt; int ui = 0;
    if (!S.next(0, cur)) return;
    f32x4 acc[2][2][4][2];
#pragma unroll
    for (int a = 0; a < 2; ++a)
#pragma unroll
        for (int b = 0; b < 2; ++b)
#pragma unroll
            for (int m = 0; m < 4; ++m)
#pragma unroll
                for (int n = 0; n < 2; ++n) acc[a][b][m][n] = (f32x4){0.f, 0.f, 0.f, 0.f};
    bf16x8 At[4][2], B0[2][2], B1[2][2];
    const char* cA = (const char*)g.A + (size_t)cur.pm * tstep; const char* cB = (const char*)g.Bt + (size_t)cur.pn * tstep;
    S.a_ready(cur);
    if constexpr (SP2) {
        PG8_STAGE(PG8_SB(0, 0), cB, voffB); PG8_STAGE(PG8_SB(0, 1), cB + hstep, voffB); PG8_STAGE(PG8_SA(0, 0), cA, voffA); PG8_STAGE(PG8_SA(0, 1), cA + hstep, voffA);
        if (wr == 1) PG8_BAR;
        PG8_WAIT_V(2); PG8_BAR;
        PG8_STAGE(PG8_SB(1, 0), cB + kstep, voffB); PG8_STAGE(PG8_SA(1, 0), cA + kstep, voffA); PG8_STAGE(PG8_SB(1, 1), cB + hstep + kstep, voffB);
        PG8_WAIT_V(6); PG8_BAR;
    } else {
        PG8_STAGE(PG8_SB(0, 0), cB, voffB); PG8_STAGE(PG8_SA(0, 0), cA, voffA); PG8_STAGE(PG8_SB(0, 1), cB + hstep, voffB); PG8_STAGE(PG8_SA(0, 1), cA + hstep, voffA);
        if (wr == 1) PG8_BAR;
        PG8_WAIT_V(4); PG8_BAR;
        PG8_STAGE(PG8_SB(1, 0), cB + kstep, voffB); PG8_STAGE(PG8_SA(1, 0), cA + kstep, voffA); PG8_STAGE(PG8_SB(1, 1), cB + hstep + kstep, voffB);
        PG8_WAIT_V(6); PG8_BAR;
    }
    for (;;) {
        const bool has_next = S.next(ui + 1, nxt);
        const char* nA = has_next ? (const char*)g.A + (size_t)nxt.pm * tstep : cA; const char* nB = has_next ? (const char*)g.Bt + (size_t)nxt.pn * tstep : cB;
        for (int t = 0; t < nt; t += 2) {
            if constexpr (Epi::MID_T > 0) { if (t == Epi::MID_T) E.mid(acc, cur, wr, wc, fr, fq); }
            const bool last = (t == nt - 2);
            const char* a1 = cA + (size_t)(t + 1) * kstep;
            const char* a2 = last ? nA : cA + (size_t)(t + 2) * kstep; const char* b2 = last ? nB : cB + (size_t)(t + 2) * kstep;
            const char* a3 = a2 + kstep; const char* b3 = b2 + kstep;
            if (last && has_next) S.a_ready(nxt);
            if constexpr (SP2) {
            PG8_LDB(B0, 0, 0); PG8_LDB(B1, 0, 1); PG8_SCHED; PG8_LDA(At, 0, 0); PG8_STAGE(PG8_SA(1, 1), a1 + hstep, voffA);
            PG8_WAIT_V(8); PG8_WAIT_L(0); PG8_BAR; PG8_MMA(0, 0, At, B0); PG8_MMA(0, 1, At, B1); PG8_BAR; PG8_SCHED;
            PG8_LDA(At, 0, 1); PG8_STAGE(PG8_SB(0, 0), b2, voffB); PG8_STAGE(PG8_SB(0, 1), b2 + hstep, voffB); PG8_STAGE(PG8_SA(0, 0), a2, voffA);
            PG8_WAIT_V(8); PG8_WAIT_L(0); PG8_BAR; PG8_MMA(1, 0, At, B0); PG8_MMA(1, 1, At, B1); PG8_BAR; PG8_SCHED;
            PG8_LDB(B0, 1, 0); PG8_LDB(B1, 1, 1); PG8_SCHED; PG8_LDA(At, 1, 0); PG8_STAGE(PG8_SA(0, 1), a2 + hstep, voffA);
            PG8_WAIT_V(8); PG8_WAIT_L(0); PG8_BAR; PG8_MMA(0, 0, At, B0); PG8_MMA(0, 1, At, B1); PG8_BAR; PG8_SCHED;
            PG8_LDA(At, 1, 1); PG8_STAGE(PG8_SB(1, 0), b3, voffB); PG8_STAGE(PG8_SB(1, 1), b3 + hstep, voffB); PG8_STAGE(PG8_SA(1, 0), a3, voffA);
            PG8_WAIT_V(8); PG8_WAIT_L(0); PG8_BAR; PG8_MMA(1, 0, At, B0); PG8_MMA(1, 1, At, B1); PG8_BAR; PG8_SCHED;
            } else {
            PG8_LDB(B0, 0, 0); PG8_SCHED; PG8_LDA(At, 0, 0); PG8_STAGE(PG8_SA(1, 1), a1 + hstep, voffA);
            PG8_WAIT_L(8); PG8_BAR; PG8_WAIT_L(0); PG8_MMA(0, 0, At, B0); PG8_BAR; PG8_SCHED;
            PG8_LDB(B1, 0, 1); PG8_STAGE(PG8_SB(0, 0), b2, voffB);
            PG8_BAR; PG8_WAIT_L(0); PG8_MMA(0, 1, At, B1); PG8_BAR;
            PG8_LDA(At, 0, 1); PG8_STAGE(PG8_SA(0, 0), a2, voffA);
            PG8_BAR; PG8_WAIT_L(0); PG8_MMA(1, 0, At, B0); PG8_BAR; PG8_SCHED;
            PG8_STAGE(PG8_SB(0, 1), b2 + hstep, voffB);
            PG8_WAIT_V(6); PG8_BAR; PG8_MMA(1, 1, At, B1); PG8_BAR;
            PG8_LDB(B0, 1, 0); PG8_SCHED; PG8_LDA(At, 1, 0); PG8_STAGE(PG8_SA(0, 1), a2 + hstep, voffA);
            PG8_WAIT_L(8); PG8_BAR; PG8_WAIT_L(0); PG8_MMA(0, 0, At, B0); PG8_BAR; PG8_SCHED;
            PG8_LDB(B1, 1, 1); PG8_STAGE(PG8_SB(1, 0), b3, voffB);
            PG8_BAR; PG8_WAIT_L(0); PG8_MMA(0, 1, At, B1); PG8_BAR;
            PG8_LDA(At, 1, 1); PG8_STAGE(PG8_SA(1, 0), a3, voffA);
            PG8_BAR; PG8_WAIT_L(0); PG8_MMA(1, 0, At, B0); PG8_BAR; PG8_SCHED;
            PG8_STAGE(PG8_SB(1, 1), b3 + hstep, voffB);
            PG8_WAIT_V(6); PG8_BAR; PG8_MMA(1, 1, At, B1); PG8_BAR;
            }
        }
        if constexpr (ALIGN_EPI) { if (wr == 0) PG8_BAR; }
        if constexpr (!Epi::AFTER_DRAIN) { E(acc, cur, wr, wc, fr, fq); S.done(cur); }
        if (!has_next) break;
#pragma unroll
        for (int a = 0; a < 2; ++a)
#pragma unroll
            for (int b = 0; b < 2; ++b)
#pragma unroll
                for (int m = 0; m < 4; ++m)
#pragma unroll
                    for (int n = 0; n < 2; ++n) acc[a][b][m][n] = (f32x4){0.f, 0.f, 0.f, 0.f};
        cur = nxt; cA = nA; cB = nB; ++ui;
        if constexpr (ALIGN_EPI) { if (wr == 1) PG8_BAR; }
    }
    PG8_WAIT_V(0);
    if constexpr (!ALIGN_EPI) { if (wr == 0) PG8_BAR; }
    PG8_BAR;
    if constexpr (Epi::AFTER_DRAIN) { E.fused(acc, cur, wr, wc, fr, fq, lds, wid, lane); S.done(cur); }
#undef PG8_SA
#undef PG8_SB
#undef PG8_STAGE
#undef PG8_LDA
#undef PG8_LDB
#undef PG8_MMA
#undef PG8_WAIT_V
#undef PG8_WAIT_L
#undef PG8_BAR
#undef PG8_SCHED
}


constexpr int MP_ROWS = 16384;

struct EpiProj {
    static constexpr bool PERM = true, AFTER_DRAIN = false; static constexpr int MID_T = 0;
    bf16_t* PA; bf16_t* PB; float* ALR;
    __device__ __forceinline__ void mid(f32x4 (&)[2][2][4][2], const Unit&, int, int, int, int) const {}
    __device__ __forceinline__ void operator()(const f32x4 (&acc)[2][2][4][2], const Unit& u, int wr, int wc, int fr, int fq) const {
        const int row0 = u.pm * BM + wr * 64 + fr;
        if (u.pn < 22) {
            bf16_t* base; int ldc, colt;
            if (u.pn < 14) { base = PA; ldc = 3584; colt = u.pn * BM; } else { base = PB; ldc = 2048; colt = (u.pn - 14) * BM; }
            const int col0 = colt + wc * 32 + 8 * fq;
#pragma unroll
            for (int ai = 0; ai < 2; ++ai)
#pragma unroll
                for (int m = 0; m < 4; ++m) { bf16_t* rowp = base + (size_t)(row0 + ai * HALF + m * 16) * ldc + col0;
#pragma unroll
                    for (int bj = 0; bj < 2; ++bj) { const f32x4 v0 = acc[ai][bj][m][0], v1 = acc[ai][bj][m][1];
                        u32x4 w; w.x = cvt_pk_bf16(v0[0], v0[1]); w.y = cvt_pk_bf16(v0[2], v0[3]); w.z = cvt_pk_bf16(v1[0], v1[1]); w.w = cvt_pk_bf16(v1[2], v1[3]);
                        *(u32x4*)(rowp + bj * HALF) = w; } }
        } else if (wc == 0 && fq < 2) {
#pragma unroll
            for (int ai = 0; ai < 2; ++ai)
#pragma unroll
                for (int m = 0; m < 4; ++m) { float* p = ALR + (size_t)(row0 + ai * HALF + m * 16) * 16 + 8 * fq;
                    *(f32x4*)p = acc[ai][0][m][0]; *(f32x4*)(p + 4) = acc[ai][0][m][1]; }
        }
    }
};
struct EpiMerge {
    static constexpr bool PERM = true, AFTER_DRAIN = false; static constexpr int MID_T = 8;
    const bf16_t* PB; bf16_t* O;
    __device__ __forceinline__ void mid(f32x4 (&acc)[2][2][4][2], const Unit& u, int wr, int wc, int fr_, int fq) const {
        int fr = fr_; asm volatile("" : "+v"(fr));
        const int row0 = u.pm * BM + wr * 64 + fr, col0 = u.pn * BM + wc * 32 + 8 * fq;
#pragma unroll
        for (int ai = 0; ai < 2; ++ai)
#pragma unroll
            for (int m = 0; m < 4; ++m) { const bf16_t* gp = PB + (size_t)(row0 + ai * HALF + m * 16) * 2048 + col0;
#pragma unroll
                for (int bj = 0; bj < 2; ++bj) { const u32x4 a8 = *(const u32x4*)(gp + bj * HALF), b8 = *(const u32x4*)(gp + 1024 + bj * HALF);
#pragma unroll
                    for (int e = 0; e < 4; ++e) { const unsigned aw = a8[e], bw = b8[e];
                        const float f0 = (1.0f + __expf(-bf_lo(bw))) / (1.0f + __expf(-bf_lo(aw))), f1 = (1.0f + __expf(-bf_hi(bw))) / (1.0f + __expf(-bf_hi(aw)));
                        acc[ai][bj][m][e >> 1][(e & 1) * 2] *= f0; acc[ai][bj][m][e >> 1][(e & 1) * 2 + 1] *= f1; } }
                if (m == 3) asm volatile("" ::: "memory"); }
    }
    __device__ __forceinline__ void operator()(const f32x4 (&acc)[2][2][4][2], const Unit& u, int wr, int wc, int fr, int fq) const {
        const int row0 = u.pm * BM + wr * 64 + fr, col0 = u.pn * BM + wc * 32 + 8 * fq;
#pragma unroll
        for (int ai = 0; ai < 2; ++ai)
#pragma unroll
            for (int m = 0; m < 4; ++m) { const size_t r = (size_t)(row0 + ai * HALF + m * 16);
#pragma unroll
                for (int bj = 0; bj < 2; ++bj) { const u32x4 b8 = *(const u32x4*)(PB + r * 2048 + 1024 + col0 + bj * HALF);
                    const f32x4 v0 = acc[ai][bj][m][0], v1 = acc[ai][bj][m][1]; u32x4 w;
                    w.x = cvt_pk_bf16(v0[0] * sigm(bf_lo(b8.x)), v0[1] * sigm(bf_hi(b8.x))); w.y = cvt_pk_bf16(v0[2] * sigm(bf_lo(b8.y)), v0[3] * sigm(bf_hi(b8.y)));
                    w.z = cvt_pk_bf16(v1[0] * sigm(bf_lo(b8.z)), v1[1] * sigm(bf_hi(b8.z))); w.w = cvt_pk_bf16(v1[2] * sigm(bf_lo(b8.w)), v1[3] * sigm(bf_hi(b8.w)));
                    *(u32x4*)(O + r * 1024 + col0 + bj * HALF) = w; } }
    }
};
template <bool INPLACE> struct EpiRes {
    static constexpr bool PERM = false, AFTER_DRAIN = false; static constexpr int MID_T = 0;
    const float* xp; float* out; const float* gate;
    __device__ __forceinline__ void mid(f32x4 (&)[2][2][4][2], const Unit&, int, int, int, int) const {}
    __device__ __forceinline__ void operator()(const f32x4 (&acc)[2][2][4][2], const Unit& u, int wr, int wc, int fr, int fq) const {
        const int row0 = u.pm * BM + wr * 64 + fr, col0 = u.pn * BM + wc * 32 + 4 * fq;
        f32x4 gt[2][2];
#pragma unroll
        for (int bj = 0; bj < 2; ++bj)
#pragma unroll
            for (int n = 0; n < 2; ++n) gt[bj][n] = *(const f32x4*)(gate + col0 + bj * HALF + n * 16);
#pragma unroll
        for (int ai = 0; ai < 2; ++ai) {
#pragma unroll
            for (int m = 0; m < 4; ++m) { const int row = row0 + ai * HALF + m * 16; float* op = out + (size_t)row * 1024 + col0;
                const float* bp = INPLACE ? (const float*)op : (xp + (size_t)row * 1024 + col0);
#pragma unroll
                for (int bj = 0; bj < 2; ++bj)
#pragma unroll
                    for (int n = 0; n < 2; ++n) { const int c = bj * HALF + n * 16; const f32x4 bs = *(const f32x4*)(bp + c);
                        *(f32x4*)(op + c) = bs + gt[bj][n] * acc[ai][bj][m][n]; } }
            asm volatile("" ::: "memory"); }
    }
};
struct EpiRelu2 {
    static constexpr bool PERM = true, AFTER_DRAIN = false; static constexpr int MID_T = 0;
    bf16_t* O;
    __device__ __forceinline__ void mid(f32x4 (&)[2][2][4][2], const Unit&, int, int, int, int) const {}
    __device__ __forceinline__ void operator()(const f32x4 (&acc)[2][2][4][2], const Unit& u, int wr, int wc, int fr, int fq) const {
        const int row0 = u.pm * BM + wr * 64 + fr, col0 = u.pn * BM + wc * 32 + 8 * fq;
#pragma unroll
        for (int ai = 0; ai < 2; ++ai)
#pragma unroll
            for (int m = 0; m < 4; ++m) { bf16_t* rowp = O + (size_t)(row0 + ai * HALF + m * 16) * 4096 + col0;
#pragma unroll
                for (int bj = 0; bj < 2; ++bj) { f32x4 v0 = acc[ai][bj][m][0], v1 = acc[ai][bj][m][1];
#pragma unroll
                    for (int e = 0; e < 4; ++e) { const float a = fmaxf(v0[e], 0.f), b = fmaxf(v1[e], 0.f); v0[e] = a * a; v1[e] = b * b; }
                    u32x4 w; w.x = cvt_pk_bf16(v0[0], v0[1]); w.y = cvt_pk_bf16(v0[2], v0[3]); w.z = cvt_pk_bf16(v1[0], v1[1]); w.w = cvt_pk_bf16(v1[2], v1[3]);
                    *(u32x4*)(rowp + bj * HALF) = w; } }
    }
};
}

#define LAS __attribute__((address_space(3)))
typedef unsigned short bf16;
typedef float f32x4 __attribute__((ext_vector_type(4)));
typedef float f32x2 __attribute__((ext_vector_type(2)));
typedef unsigned u32x4 __attribute__((ext_vector_type(4)));
typedef unsigned u32x2 __attribute__((ext_vector_type(2)));
typedef short bf16x8 __attribute__((ext_vector_type(8)));
typedef short s16x4 __attribute__((ext_vector_type(4)));

constexpr int DM = 1024, MP = 16384, NSEQ = 32, LSAMP = 16, MS = NSEQ * LSAMP, MT = MP + MS;
constexpr int NIN = 5888, KCAT = 1536, DFF = 4096, NMOD = 6144, NROWS_MOD = 33;
constexpr int PA_LD = 3584, PB_LD = 2048;
constexpr int NSC = 64;
constexpr float EPS = 1e-6f;
constexpr size_t MiB = 1u << 20;
constexpr size_t WS_MOD = 1 * MiB;
constexpr size_t WS_ALR = 2 * MiB;
constexpr size_t WS_GT = 4 * MiB;
constexpr size_t WS_WIN = 8 * MiB;
constexpr size_t WS_WCAT = 20 * MiB;
constexpr size_t WS_WOUT = 23 * MiB;
constexpr size_t WS_WFF1 = 25 * MiB;
constexpr size_t WS_WFF2 = 33 * MiB;
constexpr size_t WS_PB = 42 * MiB;
constexpr size_t WS_PA = 108 * MiB;
constexpr size_t WS_US = 224 * MiB;
constexpr size_t WS_MS = 5 * MiB;
constexpr size_t WS_H2S = 6 * MiB;
constexpr size_t WS_HIDS = 240 * MiB;
constexpr size_t WS_END = 256 * MiB;
constexpr size_t O_Y = 0, O_SGP = (size_t)MT * DM, O_CPP = O_SGP + 131072, O_SGS = O_CPP + 7680, O_CPS = O_SGS + (size_t)NSEQ * 131072;
constexpr int LDS_BYTES = 147456;

__device__ __forceinline__ float bf2f(unsigned short h) { return __uint_as_float((unsigned)h << 16); }
__device__ __forceinline__ unsigned f2bf(float f) { unsigned u = __float_as_uint(f); return (u + 0x7fffu + ((u >> 16) & 1u)) >> 16; }
__device__ __forceinline__ unsigned pk2(float lo, float hi) { return f2bf(lo) | (f2bf(hi) << 16); }
__device__ __forceinline__ float wave_sum(float v, int lane) {
#pragma unroll
    for (int o = 1; o < 64; o <<= 1) v += shfl_xor_l(v, o, lane);
    return v;
}
__device__ __forceinline__ float silu_f(float x) { return x / (1.0f + __expf(-x)); }

__device__ __forceinline__ void transpose_item(const float* W, int ldn, int k0, int c0, int valid, bf16* WT, int dld, int drow0, int dk0, LAS float* scr, int lane) {
    float tv[32];
#pragma unroll
    for (int i = 0; i < 32; ++i) { const int kk = 2 * i + (lane >> 5), n = lane & 31; tv[i] = n < valid ? W[(size_t)(k0 + kk) * ldn + c0 + n] : 0.f; }
#pragma unroll
    for (int i = 0; i < 32; ++i) { const int kk = 2 * i + (lane >> 5), n = lane & 31; scr[kk * 33 + n] = tv[i]; }
    asm volatile("s_waitcnt lgkmcnt(0)" ::: "memory");
    const int c = lane & 7;
#pragma unroll
    for (int j = 0; j < 4; ++j) { const int n = (lane >> 3) + 8 * j; const LAS float* s = scr + (8 * c) * 33 + n;
        u32x4 o; o.x = pk2(s[0 * 33], s[1 * 33]); o.y = pk2(s[2 * 33], s[3 * 33]); o.z = pk2(s[4 * 33], s[5 * 33]); o.w = pk2(s[6 * 33], s[7 * 33]);
        *(u32x4*)(WT + (size_t)(drow0 + n) * dld + dk0 + k0 + 8 * c) = o; }
    asm volatile("s_waitcnt lgkmcnt(0)" ::: "memory");
}

#define XB_TMO      128
#define XB_XCNT(j)  (256  + 64 * (j))
#define XB_XSUB(j)  (1280 + 64 * (j))
#define XB_XGEN(j)  (2304 + 64 * (j))
#define XB_TOP      3328
#define XB_TOPGEN   3392
#define XCD_BAR_WORDS 3456
#define XB_SPIN_CAP (1u << 18)

__device__ __forceinline__ unsigned xb_ld(unsigned* p)              { return __hip_atomic_load(p, __ATOMIC_RELAXED, __HIP_MEMORY_SCOPE_AGENT); }
__device__ __forceinline__ unsigned xb_add(unsigned* p, unsigned v) { return __hip_atomic_fetch_add(p, v, __ATOMIC_RELAXED, __HIP_MEMORY_SCOPE_AGENT); }
__device__ __forceinline__ unsigned xb_xcc_id() { return (unsigned)__builtin_amdgcn_s_getreg((3 << 11) | 20) & 0xFu; }
#define XB_SPIN(cond, bar) do { unsigned _sp = 0; while (cond) { __builtin_amdgcn_s_sleep(1); \
    if ((++_sp & 255u) == 0u) { if (xb_ld(&(bar)[XB_TMO])) break; if (_sp > XB_SPIN_CAP) { atomicAdd(&(bar)[XB_TMO], 1u); break; } } } } while (0)

struct XcdBarrier {
    unsigned* bar; unsigned x;
    volatile LAS unsigned* st;
};

__device__ __forceinline__ XcdBarrier xcd_barrier_post(unsigned* bar, volatile LAS unsigned* st, int tid) {
    XcdBarrier b; b.bar = bar; b.x = xb_xcc_id(); b.st = st;
    if (tid == 0) (void)xb_add(&bar[XB_XCNT(b.x)], 1u);
    return b;
}
__device__ __forceinline__ void xcd_barrier_complete(unsigned* bar, unsigned x, unsigned& nloc, unsigned& nx) {
    const unsigned G = gridDim.x * gridDim.y * gridDim.z;
    unsigned sum, cnt, mine, sp = 0u;
    for (;;) {
        sum = 0u; cnt = 0u; mine = 0u;
#pragma unroll
        for (unsigned j = 0; j < 16; ++j) { const unsigned c = xb_ld(&bar[XB_XCNT(j)]); sum += c; cnt += (c > 0u) ? 1u : 0u; mine = (j == x) ? c : mine; }
        if (sum == G) break;
        __builtin_amdgcn_s_sleep(1);
        if ((++sp & 255u) == 0u) { if (xb_ld(&bar[XB_TMO])) break; if (sp > XB_SPIN_CAP) { atomicAdd(&bar[XB_TMO], 1u); break; } }
    }
    nloc = mine > 0u ? mine : 1u; nx = cnt > 0u ? cnt : 1u;
}

__device__ __forceinline__ void xcd_barrier(const XcdBarrier& b, int tid) {
    asm volatile("s_waitcnt vmcnt(0)" ::: "memory");
    __syncthreads();
    if (tid == 0) {
        unsigned* bar = b.bar;
        __builtin_amdgcn_s_waitcnt(0);
        unsigned nloc = b.st[0], nx = b.st[1];
        if (nloc == 0u) { xcd_barrier_complete(bar, b.x, nloc, nx); b.st[0] = nloc; b.st[1] = nx; }
        const unsigned old = xb_add(&bar[XB_XSUB(b.x)], 1u);
        const unsigned gen = old / nloc;
        if (old + 1u == (gen + 1u) * nloc) {
            __builtin_amdgcn_fence(__ATOMIC_RELEASE, "agent");
            asm volatile("s_waitcnt vmcnt(0)" ::: "memory");
            const unsigned og = xb_add(&bar[XB_TOP], 1u);
            const unsigned tg = og / nx;
            if (og + 1u == (tg + 1u) * nx) xb_add(&bar[XB_TOPGEN], 1u);
            else XB_SPIN(xb_ld(&bar[XB_TOPGEN]) == tg, bar);
            __builtin_amdgcn_fence(__ATOMIC_ACQUIRE, "agent");
            xb_add(&bar[XB_XGEN(b.x)], 1u);
            asm volatile("s_waitcnt vmcnt(0)" ::: "memory");
        } else {
            XB_SPIN(xb_ld(&bar[XB_XGEN(b.x)]) == gen, bar);
            __builtin_amdgcn_fence(__ATOMIC_ACQUIRE, "agent");
            asm volatile("s_waitcnt vmcnt(0)" ::: "memory");
        }
    }
    __syncthreads();
}

struct Args { const float* in[22]; float* out; unsigned char* ws; };
__device__ __forceinline__ unsigned* bar_words() { const __attribute__((address_space(4))) Args* ap_ = (const __attribute__((address_space(4))) Args*)__builtin_amdgcn_kernarg_segment_ptr(); asm volatile("" : "+s"(ap_)); return (unsigned*)(ap_->ws); }
constexpr int LDS_BARST = 147456 - 64;


constexpr int G_QD = 0, G_KD = 17408, G_KPT = 34816, G_VT = 53248, G_ALR = 90112, G_PART = 94208, G_GL = 98304, G_SSQ = 98816, G_WAL = 100864, G_GN = 109056;
#define MFMA16(a, b, c) __builtin_amdgcn_mfma_f32_16x16x32_bf16((a), (b), (c), 0, 0, 0)
#define LBAR() do { asm volatile("s_waitcnt lgkmcnt(0)" ::: "memory"); __builtin_amdgcn_s_barrier(); asm volatile("" ::: "memory"); } while (0)
__device__ __forceinline__ bf16x8 pack8(const f32x4& a, const f32x4& b) {
    u32x4 p; p.x = pk2(a[0], a[1]); p.y = pk2(a[2], a[3]); p.z = pk2(b[0], b[1]); p.w = pk2(b[2], b[3]); return __builtin_bit_cast(bf16x8, p);
}
__device__ __forceinline__ float logsig16(float x) { return (fminf(x, 0.f) - __logf(1.0f + __expf(-fabsf(x)))) * (1.0f / 16.0f); }
template <bool DO_O>
__device__ __forceinline__ void gla_unit(LAS unsigned char* lds, const int tid_in, const int row0, const int nchunks, const int nvalid, const int h,
                                         const bf16* PA, const float* ALR, const float* w_alpha, const float* b_alpha, const float* gnorm,
                                         const float* Sinit, float* Sout, float* Gout, bf16* ACAT, unsigned long long& gacc) {
#ifndef PROBE_SUB
#define PROBE_SUB -1
#endif
    unsigned long long glast = 0; (void)glast;
#define GSTAMP(k) do { if (PROBE_SUB >= 0) { const unsigned long long t_ = __builtin_amdgcn_s_memrealtime(); if ((k) == PROBE_SUB) gacc += t_ - glast; glast = t_; } } while (0)
    const int tid = lane_id_fresh() + 64 * tid_in;
    const int lane = tid & 63, wid = tid >> 6, fr = lane & 15, fq = lane >> 4, dvb = wid * 32;
    LAS float* ALRL = (LAS float*)(lds + G_ALR); LAS float* PART = (LAS float*)(lds + G_PART); LAS float* GL = (LAS float*)(lds + G_GL); LAS float* SSQ = (LAS float*)(lds + G_SSQ);
    LAS float* WAL = (LAS float*)(lds + G_WAL); LAS float* GN = (LAS float*)(lds + G_GN);
    LBAR();
#pragma unroll
    for (int j = 0; j < 4; ++j) { const int i = tid + 512 * j; WAL[i] = w_alpha[(i >> 7) * 512 + h * 128 + (i & 127)]; }
    if (tid < 256) GN[tid] = gnorm[tid];
    f32x4 S[8][2];
#pragma unroll
    for (int kt = 0; kt < 8; ++kt)
#pragma unroll
        for (int dvt = 0; dvt < 2; ++dvt) {
            if (Sinit) {
#pragma unroll
                for (int r = 0; r < 4; ++r) S[kt][dvt][r] = Sinit[(size_t)(16 * kt + 4 * fq + r) * 256 + dvb + 16 * dvt + fr];
            } else S[kt][dvt] = (f32x4){0.f, 0.f, 0.f, 0.f};
        }
    const int dkp = tid & 63, tg = tid >> 6, dv2 = tid & 127, vg = tid >> 7;
    const f32x2 bal = *(const f32x2*)(b_alpha + h * 128 + 2 * dkp);
    float gsum0 = 0.f, gsum1 = 0.f;
    unsigned qc[8], kc[8], vc[16]; f32x2 ac;
#define GLA_LOAD(rbase) do { \
        _Pragma("unroll") for (int i = 0; i < 8; ++i) { const int t = 8 * tg + i; qc[i] = 0u; kc[i] = 0u; \
            if (t < nvalid) { const bf16* p_ = PA + (size_t)((rbase) + t) * PA_LD + h * 128 + 2 * dkp; qc[i] = *(const unsigned*)(p_ + 512); kc[i] = *(const unsigned*)(p_ + 1024); } } \
        _Pragma("unroll") for (int i = 0; i < 16; ++i) { const int t = 16 * vg + i; vc[i] = 0u; if (t < nvalid) vc[i] = *(const unsigned*)(PA + (size_t)((rbase) + t) * PA_LD + 1536 + h * 256 + 2 * dv2); } \
        int tl_ = tid; asm volatile("" : "+v"(tl_)); ac = (f32x2){0.f, 0.f}; if ((tl_ >> 3) < nvalid) ac = *(const f32x2*)(ALR + (size_t)((rbase) + (tl_ >> 3)) * 16 + (tl_ & 7) * 2); } while (0)
    GLA_LOAD(row0);
    for (int ch = 0; ch < nchunks; ++ch) {
        const int r0 = row0 + ch * 64;
        LBAR();
        GSTAMP(-2);
        *(LAS f32x2*)(ALRL + (tid >> 3) * 16 + (tid & 7) * 2) = ac;
        {
            u32x4 lo0, lo1, hi0, hi1;
#pragma unroll
            for (int j = 0; j < 4; ++j) { lo0[j] = (vc[2 * j] & 0xffffu) | (vc[2 * j + 1] << 16); hi0[j] = (vc[2 * j] >> 16) | (vc[2 * j + 1] & 0xffff0000u);
                lo1[j] = (vc[8 + 2 * j] & 0xffffu) | (vc[8 + 2 * j + 1] << 16); hi1[j] = (vc[8 + 2 * j] >> 16) | (vc[8 + 2 * j + 1] & 0xffff0000u); }
            LAS unsigned char* vt = lds + G_VT + (2 * dv2) * 144 + vg * 32;
            *(LAS u32x4*)(vt) = lo0; *(LAS u32x4*)(vt + 16) = lo1; *(LAS u32x4*)(vt + 144) = hi0; *(LAS u32x4*)(vt + 160) = hi1;
        }
        LBAR();
        GSTAMP(0);
        float bl0[8], bl1[8];
        {
            f32x2 wl[16];
#pragma unroll
            for (int r = 0; r < 16; ++r) wl[r] = *(const LAS f32x2*)(WAL + r * 128 + 2 * dkp);
            float run0 = 0.f, run1 = 0.f;
#pragma unroll
            for (int i = 0; i < 8; ++i) { const int t = 8 * tg + i; const LAS f32x4* ar = (const LAS f32x4*)(ALRL + t * 16); float x0 = bal[0], x1 = bal[1];
#pragma unroll
                for (int j = 0; j < 4; ++j) { const f32x4 a4 = ar[j];
#pragma unroll
                    for (int e = 0; e < 4; ++e) { x0 += a4[e] * wl[4 * j + e][0]; x1 += a4[e] * wl[4 * j + e][1]; } }
                const bool ok = t < nvalid; run0 += ok ? logsig16(x0) : 0.f; run1 += ok ? logsig16(x1) : 0.f; bl0[i] = run0; bl1[i] = run1; }
            *(LAS f32x2*)(PART + tg * 128 + 2 * dkp) = (f32x2){run0, run1};
        }
        LBAR();
        GSTAMP(1);
        {
            float off0 = 0.f, off1 = 0.f, tot0 = 0.f, tot1 = 0.f;
#pragma unroll
            for (int t8 = 0; t8 < 8; ++t8) { const f32x2 p = *(const LAS f32x2*)(PART + t8 * 128 + 2 * dkp); tot0 += p[0]; tot1 += p[1]; off0 += (t8 < tg) ? p[0] : 0.f; off1 += (t8 < tg) ? p[1] : 0.f; }
            unsigned kp0[4], kp1[4];
#pragma unroll
            for (int i = 0; i < 8; ++i) { const int t = 8 * tg + i; const float b0 = bl0[i] + off0, b1 = bl1[i] + off1;
                const float q0 = bf_lo(qc[i]) * 0.08838834764831845f, q1 = bf_hi(qc[i]) * 0.08838834764831845f, k0 = bf_lo(kc[i]), k1 = bf_hi(kc[i]);
                *(LAS unsigned*)(lds + G_QD + t * 272 + 4 * dkp) = pk2(q0 * __expf(b0), q1 * __expf(b1));
                *(LAS unsigned*)(lds + G_KD + t * 272 + 4 * dkp) = pk2(k0 * __expf(-b0), k1 * __expf(-b1));
                const unsigned a0 = f2bf(k0 * __expf(tot0 - b0)), a1 = f2bf(k1 * __expf(tot1 - b1));
                if (i & 1) { kp0[i >> 1] |= a0 << 16; kp1[i >> 1] |= a1 << 16; } else { kp0[i >> 1] = a0; kp1[i >> 1] = a1; } }
            LAS unsigned char* kp = lds + G_KPT + (2 * dkp) * 144 + tg * 16;
            *(LAS u32x4*)kp = (u32x4){kp0[0], kp0[1], kp0[2], kp0[3]}; *(LAS u32x4*)(kp + 144) = (u32x4){kp1[0], kp1[1], kp1[2], kp1[3]};
            if (tg == 0) *(LAS f32x2*)(GL + 2 * dkp) = (f32x2){__expf(tot0), __expf(tot1)};
            if constexpr (!DO_O) { gsum0 += tot0; gsum1 += tot1; }
        }
        LBAR();
        GSTAMP(2);
        u32x2 gq[4][2];
        if constexpr (!DO_O) { if (ch + 1 < nchunks) GLA_LOAD(r0 + 64); }
        if constexpr (DO_O) {
            f32x4 oT[4][2];
#pragma unroll
            for (int it = 0; it < 4; ++it) {
                oT[it][0] = (f32x4){0.f, 0.f, 0.f, 0.f}; oT[it][1] = (f32x4){0.f, 0.f, 0.f, 0.f};
#pragma unroll
                for (int jp = 0; jp < 2; ++jp) {
                    if (2 * jp > it) continue;
                    const int jt0 = 2 * jp, jt1 = 2 * jp + 1;
                    f32x4 P0 = (f32x4){0.f, 0.f, 0.f, 0.f}, P1 = (f32x4){0.f, 0.f, 0.f, 0.f};
#pragma unroll
                    for (int ks = 0; ks < 4; ++ks) {
                        const bf16x8 yq = *(const LAS bf16x8*)(lds + G_QD + (16 * it + fr) * 272 + (32 * ks + 8 * fq) * 2);
                        const bf16x8 x0 = *(const LAS bf16x8*)(lds + G_KD + (16 * jt0 + fr) * 272 + (32 * ks + 8 * fq) * 2);
                        P0 = MFMA16(x0, yq, P0);
                        if (jt1 <= it) { const bf16x8 x1 = *(const LAS bf16x8*)(lds + G_KD + (16 * jt1 + fr) * 272 + (32 * ks + 8 * fq) * 2); P1 = MFMA16(x1, yq, P1); }
                    }
                    if (jt0 == it) {
#pragma unroll
                        for (int r = 0; r < 4; ++r) if (fr < 4 * fq + r) P0[r] = 0.f;
                    }
                    if (jt1 == it) {
#pragma unroll
                        for (int r = 0; r < 4; ++r) if (fr < 4 * fq + r) P1[r] = 0.f;
                    }
                    const bf16x8 pb = pack8(P0, P1);
#pragma unroll
                    for (int dvt = 0; dvt < 2; ++dvt) {
                        const LAS unsigned char* vr = lds + G_VT + (dvb + 16 * dvt + fr) * 144;
                        const s16x4 a0 = *(const LAS s16x4*)(vr + (16 * jt0 + 4 * fq) * 2), a1 = *(const LAS s16x4*)(vr + (16 * jt1 + 4 * fq) * 2);
                        const bf16x8 xa = __builtin_shufflevector(a0, a1, 0, 1, 2, 3, 4, 5, 6, 7);
                        oT[it][dvt] = MFMA16(xa, pb, oT[it][dvt]);
                    }
                }
            }
            asm volatile("" ::: "memory");
#pragma unroll
            for (int it = 0; it < 4; ++it)
#pragma unroll
                for (int dvt = 0; dvt < 2; ++dvt) { gq[it][dvt] = (u32x2){0u, 0u};
                    if (16 * it + fr < nvalid) gq[it][dvt] = *(const u32x2*)(PA + (size_t)(r0 + 16 * it + fr) * PA_LD + 2560 + h * 256 + dvb + 16 * dvt + 4 * fq); }
            if (ch + 1 < nchunks) GLA_LOAD(r0 + 64);
            asm volatile("" ::: "memory");
#pragma unroll
            for (int kp = 0; kp < 4; ++kp) {
                const bf16x8 Sb0 = pack8(S[2 * kp][0], S[2 * kp + 1][0]), Sb1 = pack8(S[2 * kp][1], S[2 * kp + 1][1]);
#pragma unroll
                for (int it = 0; it < 4; ++it) {
                    const LAS unsigned char* qr = lds + G_QD + (16 * it + fr) * 272;
                    const s16x4 q0 = *(const LAS s16x4*)(qr + (32 * kp + 4 * fq) * 2), q1 = *(const LAS s16x4*)(qr + (32 * kp + 16 + 4 * fq) * 2);
                    const bf16x8 yq = __builtin_shufflevector(q0, q1, 0, 1, 2, 3, 4, 5, 6, 7);
                    oT[it][0] = MFMA16(Sb0, yq, oT[it][0]); oT[it][1] = MFMA16(Sb1, yq, oT[it][1]);
                }
            }
#pragma unroll
            for (int it = 0; it < 4; ++it) {
                float ss = 0.f;
#pragma unroll
                for (int dvt = 0; dvt < 2; ++dvt)
#pragma unroll
                    for (int r = 0; r < 4; ++r) ss += oT[it][dvt][r] * oT[it][dvt][r];
                ss += shfl_xor_l(ss, 16, lane); ss += shfl_xor_l(ss, 32, lane);
                if (fq == 0) SSQ[wid * 64 + 16 * it + fr] = ss;
            }
            LBAR();
            GSTAMP(3);
            int r0o = r0; asm volatile("" : "+s"(r0o));
#pragma unroll
            for (int it = 0; it < 4; ++it) {
                const int tok = 16 * it + fr; float tss = 0.f;
#pragma unroll
                for (int w = 0; w < 8; ++w) tss += SSQ[w * 64 + tok];
                const float rstd = rsqrtf(tss * (1.0f / 256.0f) + EPS);
                if (tok < nvalid) {
#pragma unroll
                    for (int dvt = 0; dvt < 2; ++dvt) { const int dv0 = dvb + 16 * dvt + 4 * fq; const size_t row = (size_t)(r0o + tok);
                        const u32x2 g4 = gq[it][dvt]; const f32x4 gn = *(const LAS f32x4*)(GN + dv0);
                        const f32x4 o = oT[it][dvt]; u32x2 w;
                        w.x = pk2(o[0] * rstd * gn[0] * silu_f(bf_lo(g4.x)), o[1] * rstd * gn[1] * silu_f(bf_hi(g4.x)));
                        w.y = pk2(o[2] * rstd * gn[2] * silu_f(bf_lo(g4.y)), o[3] * rstd * gn[3] * silu_f(bf_hi(g4.y)));
                        *(u32x2*)(ACAT + row * KCAT + 512 + h * 256 + dv0) = w; }
                }
            }
        }
        GSTAMP(4);
#pragma unroll
        for (int kt = 0; kt < 8; ++kt) { const f32x4 gl = *(const LAS f32x4*)(GL + 16 * kt + 4 * fq); S[kt][0] *= gl; S[kt][1] *= gl; }
#pragma unroll
        for (int ks = 0; ks < 2; ++ks) {
            const bf16x8 yv0 = *(const LAS bf16x8*)(lds + G_VT + (dvb + fr) * 144 + (32 * ks + 8 * fq) * 2);
            const bf16x8 yv1 = *(const LAS bf16x8*)(lds + G_VT + (dvb + 16 + fr) * 144 + (32 * ks + 8 * fq) * 2);
#pragma unroll
            for (int kt = 0; kt < 8; ++kt) { const bf16x8 xk = *(const LAS bf16x8*)(lds + G_KPT + (16 * kt + fr) * 144 + (32 * ks + 8 * fq) * 2);
                S[kt][0] = MFMA16(xk, yv0, S[kt][0]); S[kt][1] = MFMA16(xk, yv1, S[kt][1]); }
        }
        GSTAMP(5);
    }
#undef GLA_LOAD
    if (Sout) {
        int l2 = lane; asm volatile("" : "+v"(l2)); const int fr2 = l2 & 15, fq2 = l2 >> 4;
#pragma unroll
        for (int kt = 0; kt < 8; ++kt)
#pragma unroll
            for (int dvt = 0; dvt < 2; ++dvt)
#pragma unroll
                for (int r = 0; r < 4; ++r) Sout[(size_t)(16 * kt + 4 * fq2 + r) * 256 + dvb + 16 * dvt + fr2] = S[kt][dvt][r];
    }
    if constexpr (!DO_O) { if (Gout && tg == 0) *(f32x2*)(Gout + 2 * dkp) = (f32x2){__expf(gsum0), __expf(gsum1)}; }
}

template <int STEPS  >
__device__ __forceinline__ f32x4 tile_gemm(LAS unsigned char* lds, const int tid, const bf16* A, const int lda, const bf16* Bt, const int ldb, const int kbase) {
    const int lane = tid & 63, wid = tid >> 6, fr = lane & 15, fq = lane >> 4;
    const bf16* ap = A + (size_t)fr * lda + kbase + wid * (STEPS * 32) + 8 * fq;
    const bf16* bp = Bt + (size_t)fr * ldb + kbase + wid * (STEPS * 32) + 8 * fq;
    f32x4 acc[4][2];
#pragma unroll
    for (int mt = 0; mt < 4; ++mt) { acc[mt][0] = (f32x4){0.f, 0.f, 0.f, 0.f}; acc[mt][1] = (f32x4){0.f, 0.f, 0.f, 0.f}; }
    constexpr int GRP = STEPS < 4 ? STEPS : 4;
#pragma unroll 1
    for (int kb = 0; kb < STEPS / GRP; ++kb) {
        bf16x8 a[GRP][4], b[GRP][2];
#pragma unroll
        for (int ks = 0; ks < GRP; ++ks) {
#pragma unroll
            for (int mt = 0; mt < 4; ++mt) a[ks][mt] = *(const bf16x8*)(ap + (size_t)(16 * mt) * lda + 32 * (kb * GRP + ks));
#pragma unroll
            for (int nt = 0; nt < 2; ++nt) b[ks][nt] = *(const bf16x8*)(bp + (size_t)(16 * nt) * ldb + 32 * (kb * GRP + ks));
        }
#pragma unroll
        for (int ks = 0; ks < GRP; ++ks)
#pragma unroll
            for (int mt = 0; mt < 4; ++mt)
#pragma unroll
                for (int nt = 0; nt < 2; ++nt) acc[mt][nt] = MFMA16(b[ks][nt], a[ks][mt], acc[mt][nt]);
    }
    LAS float* RED = (LAS float*)lds;
#pragma unroll
    for (int mt = 0; mt < 4; ++mt)
#pragma unroll
        for (int nt = 0; nt < 2; ++nt) *(LAS f32x4*)(RED + ((wid * 64 + 16 * mt + fr) * 36 + 16 * nt + 4 * fq)) = acc[mt][nt];
    __syncthreads();
    const int tok = tid >> 3, c4 = (tid & 7) * 4; f32x4 sres = (f32x4){0.f, 0.f, 0.f, 0.f};
#pragma unroll
    for (int w = 0; w < 8; ++w) sres += *(const LAS f32x4*)(RED + ((w * 64 + tok) * 36 + c4));
    __syncthreads();
    return sres;
}

__device__ __forceinline__ void norm_row_bf16(const float* xrow, const float* g, const float* shift, const float* scale, bf16* orow, int lane) {
    const f32x4* xr = (const f32x4*)xrow + lane; f32x4 v[4]; float s = 0.f;
#pragma unroll
    for (int j = 0; j < 4; ++j) { v[j] = xr[64 * j]; s += (v[j][0] * v[j][0] + v[j][1] * v[j][1]) + (v[j][2] * v[j][2] + v[j][3] * v[j][3]); }
    const float rstd = rsqrtf(wave_sum(s, lane) * (1.0f / DM) + EPS);
#pragma unroll
    for (int j = 0; j < 4; ++j) { const int c = 4 * lane + 256 * j; const f32x4 gg = *(const f32x4*)(g + c), sh = *(const f32x4*)(shift + c), sc = *(const f32x4*)(scale + c);
        const f32x4 o = v[j] * rstd * gg * (1.0f + sc) + sh;
        u32x2 w; w.x = pk2(o[0], o[1]); w.y = pk2(o[2], o[3]); *(u32x2*)(orow + c) = w; }
}

__global__ void __launch_bounds__(512, 2) fwd_kernel(Args a) {
    extern __shared__ __attribute__((aligned(16))) unsigned char lds_raw[];
    cg::grid_group grid = cg::this_grid();
    LAS unsigned char* lds = (LAS unsigned char*)lds_raw;
    const int wave = __builtin_amdgcn_readfirstlane((int)threadIdx.x >> 6);
    const int G = gridDim.x, blk = blockIdx.x, gw = blk * 8 + wave, NGW = G * 8;
#ifndef PROBE_LO
#define PROBE_LO -1
#define PROBE_HI -1
#endif
    { const int t0_ = lane_id_fresh() + 64 * wave; if (t0_ < 2) ((LAS unsigned*)(lds + LDS_BARST))[t0_] = 0u; __syncthreads();
      (void)xcd_barrier_post(bar_words(), (volatile LAS unsigned*)(lds + LDS_BARST), t0_); }
    unsigned long long tA = 0, tB = 0, gacc5 = 0, gdummy = 0; (void)gdummy;
    if (PROBE_LO == 0) tA = __builtin_amdgcn_s_memrealtime();
#define STAMP(k) do { if (PROBE_LO >= 0) { if ((k) == PROBE_LO - 1) tA = __builtin_amdgcn_s_memrealtime(); if ((k) == PROBE_HI) tB = __builtin_amdgcn_s_memrealtime(); } } while (0)
#define GRID_BAR() do { XcdBarrier b_; b_.bar = bar_words(); b_.x = xb_xcc_id(); b_.st = (volatile LAS unsigned*)(lds + LDS_BARST); xcd_barrier(b_, lane_id_fresh() + 64 * wave); } while (0)
#define FRESH_TID() const __attribute__((address_space(4))) Args* ap = (const __attribute__((address_space(4))) Args*)__builtin_amdgcn_kernarg_segment_ptr(); asm volatile("" : "+s"(ap)); int tid = lane_id_fresh() + 64 * wave; const int lane = tid & 63; (void)lane; (void)tid
#define ws (ap->ws)
#define out (ap->out)
#define x_prompt (ap->in[0])
#define x_sample (ap->in[1])
#define c_prompt (ap->in[2])
#define c_sample (ap->in[3])
#define state_gla (ap->in[4])
#define cache_pool (ap->in[5])
#define w_ada (ap->in[6])
#define b_ada (ap->in[7])
#define norm1_g (ap->in[8])
#define w_in (ap->in[9])
#define w_alpha (ap->in[10])
#define b_alpha (ap->in[11])
#define w_pool (ap->in[12])
#define pool_scale (ap->in[13])
#define gla_norm_g (ap->in[14])
#define w_pa (ap->in[15])
#define w_pb (ap->in[16])
#define w_out (ap->in[17])
#define norm2_g (ap->in[18])
#define w_ff1 (ap->in[19])
#define w_ff2 (ap->in[20])
#define final_g (ap->in[21])
#define MOD ((float*)(ws + WS_MOD))
#define ALR ((float*)(ws + WS_ALR))
#define GT ((float*)(ws + WS_GT))
#define Win_t ((bf16*)(ws + WS_WIN))
#define Wcat_t ((bf16*)(ws + WS_WCAT))
#define Wout_t ((bf16*)(ws + WS_WOUT))
#define Wff1_t ((bf16*)(ws + WS_WFF1))
#define Wff2_t ((bf16*)(ws + WS_WFF2))
#define PB ((bf16*)(ws + WS_PB))
#define PA ((bf16*)(ws + WS_PA))
#define US ((float*)(ws + WS_US))
#define MODP ((float*)(ws + WS_US))
#define H ((bf16*)out)
#define ACAT ((bf16*)out)
#define H2 ((bf16*)(ws + WS_PB))
#define MERGED ((bf16*)(ws + WS_PA))
#define HID ((bf16*)(ws + WS_PA))
#define Y (out + O_Y)
#define MERGED_S ((bf16*)(ws + WS_MS))
#define H2_S ((bf16*)(ws + WS_H2S))
#define HID_S ((bf16*)(ws + WS_HIDS))

    {
        FRESH_TID();
        LAS float* scr = (LAS float*)(lds + wave * 16384);
        constexpr int I_IN = 16 * 184, I_PB = 16 * 32, I_OUT = 16 * 32, I_F1 = 16 * 128, I_F2 = 64 * 32, I_WA = 1024, I_MOD = 96 * 16;
        constexpr int NITEMS = I_MOD + I_IN + I_PB + I_OUT + I_F1 + I_F2 + I_WA;
        for (int it = gw; it < NITEMS; it += NGW) {
            int r = it;
            if (r < I_WA) {
                const int g = r >> 8, cb = (r >> 4) & 15, nb = r & 15, n = 64 * nb + lane, c0 = 8 * cb;
                float acc[8];
#pragma unroll
                for (int cc = 0; cc < 8; ++cc) acc[cc] = 0.f;
#pragma unroll 1
                for (int db = 0; db < 4; ++db) { float wp[32];
#pragma unroll
                    for (int d = 0; d < 32; ++d) wp[d] = w_pa[(size_t)(g * 128 + db * 32 + d) * DM + n] * pool_scale[g * 128 + db * 32 + d];
#pragma unroll
                    for (int d = 0; d < 32; ++d)
#pragma unroll
                        for (int cc = 0; cc < 8; ++cc) acc[cc] += w_pool[(size_t)(g * 128 + c0 + cc) * 128 + db * 32 + d] * wp[d]; }
                u32x4 o; o.x = pk2(acc[0], acc[1]); o.y = pk2(acc[2], acc[3]); o.z = pk2(acc[4], acc[5]); o.w = pk2(acc[6], acc[7]);
                *(u32x4*)(Wcat_t + (size_t)n * KCAT + g * 128 + c0) = o;
                continue;
            }
            r -= I_WA;
            if (r < I_MOD) {
                const int cgp = r % 96, ks = r / 96, k0 = 64 * ks, n = 64 * cgp + lane;
                { float cvv[NROWS_MOD];
#pragma unroll
                  for (int rr = 0; rr < NROWS_MOD; ++rr) cvv[rr] = rr == 0 ? c_prompt[k0 + lane] : c_sample[(size_t)(rr - 1) * DM + k0 + lane];
#pragma unroll
                  for (int rr = 0; rr < NROWS_MOD; ++rr) scr[rr * 64 + lane] = silu_f(cvv[rr]); }
                asm volatile("s_waitcnt lgkmcnt(0)" ::: "memory");
                float acc[NROWS_MOD];
#pragma unroll
                for (int rr = 0; rr < NROWS_MOD; ++rr) acc[rr] = 0.f;
#pragma unroll
                for (int kb = 0; kb < 2; ++kb) { float wv[32];
#pragma unroll
                    for (int kk = 0; kk < 32; ++kk) wv[kk] = w_ada[(size_t)(k0 + kb * 32 + kk) * NMOD + n];
#pragma unroll
                    for (int kk = 0; kk < 32; ++kk)
#pragma unroll
                        for (int rr = 0; rr < NROWS_MOD; ++rr) acc[rr] += scr[rr * 64 + kb * 32 + kk] * wv[kk]; }
#pragma unroll
                for (int rr = 0; rr < NROWS_MOD; ++rr) MODP[((size_t)ks * NROWS_MOD + rr) * NMOD + n] = acc[rr];
                asm volatile("s_waitcnt lgkmcnt(0)" ::: "memory");
                continue;
            }
            r -= I_MOD;
            if (r < I_IN) { const int kb = r / 184, nb = r % 184; int c0, valid;
                if (nb < 112) { c0 = 32 * nb; valid = 32; } else if (nb < 176) { c0 = 32 * nb + 16; valid = 32; } else if (nb == 176) { c0 = 3584; valid = 16; } else { c0 = 0; valid = 0; }
                transpose_item(w_in, 5648, 64 * kb, c0, valid, Win_t, DM, 32 * nb, 0, scr, lane); continue; }
            r -= I_IN;
            if (r < I_PB) { transpose_item(w_pb, DM, 64 * (r / 32), 32 * (r % 32), 32, Wcat_t, KCAT, 32 * (r % 32), 512, scr, lane); continue; }
            r -= I_PB;
            if (r < I_OUT) { transpose_item(w_out, DM, 64 * (r / 32), 32 * (r % 32), 32, Wout_t, DM, 32 * (r % 32), 0, scr, lane); continue; }
            r -= I_OUT;
            if (r < I_F1) { transpose_item(w_ff1, DFF, 64 * (r / 128), 32 * (r % 128), 32, Wff1_t, DM, 32 * (r % 128), 0, scr, lane); continue; }
            r -= I_F1;
            transpose_item(w_ff2, DM, 64 * (r / 32), 32 * (r % 32), 32, Wff2_t, DFF, 32 * (r % 32), 0, scr, lane);
        }
    }
    if (gridDim.x == 0x7fffffffu) grid.sync();
    GRID_BAR(); STAMP(0);
    { FRESH_TID();
    for (int i = blk * 512 + tid; i < NROWS_MOD * NMOD; i += G * 512) { float s = b_ada[i % NMOD];
#pragma unroll
        for (int ks = 0; ks < 16; ++ks) s += MODP[(size_t)ks * NROWS_MOD * NMOD + i];
        MOD[i] = s; } }
    GRID_BAR(); STAMP(1);
    { FRESH_TID();
      {
          f32x4 Av[4], Bv[4];
#pragma unroll
          for (int j = 0; j < 4; ++j) { const int c = 4 * lane + 256 * j; const f32x4 gg = *(const f32x4*)(norm1_g + c), sh = *(const f32x4*)(MOD + c), sc = *(const f32x4*)(MOD + 1024 + c);
              Av[j] = gg * (1.0f + sc); Bv[j] = sh; }
          for (int m = gw; m < MP; m += 2 * NGW) { const int m2 = m + NGW; const bool two = m2 < MP;
              const f32x4* x0 = (const f32x4*)(x_prompt + (size_t)m * DM) + lane; const f32x4* x1 = (const f32x4*)(x_prompt + (size_t)(two ? m2 : m) * DM) + lane;
              f32x4 v0[4], v1[4]; float s0 = 0.f, s1 = 0.f;
#pragma unroll
              for (int j = 0; j < 4; ++j) { v0[j] = x0[64 * j]; v1[j] = x1[64 * j]; }
#pragma unroll
              for (int j = 0; j < 4; ++j) { s0 += (v0[j][0] * v0[j][0] + v0[j][1] * v0[j][1]) + (v0[j][2] * v0[j][2] + v0[j][3] * v0[j][3]);
                  s1 += (v1[j][0] * v1[j][0] + v1[j][1] * v1[j][1]) + (v1[j][2] * v1[j][2] + v1[j][3] * v1[j][3]); }
              const float r0 = rsqrtf(wave_sum(s0, lane) * (1.0f / DM) + EPS), r1 = rsqrtf(wave_sum(s1, lane) * (1.0f / DM) + EPS);
#pragma unroll
              for (int j = 0; j < 4; ++j) { const int c = 4 * lane + 256 * j; const f32x4 o0 = v0[j] * r0 * Av[j] + Bv[j], o1 = v1[j] * r1 * Av[j] + Bv[j];
                  u32x2 w0; w0.x = pk2(o0[0], o0[1]); w0.y = pk2(o0[2], o0[3]); *(u32x2*)(H + (size_t)m * DM + c) = w0;
                  if (two) { u32x2 w1; w1.x = pk2(o1[0], o1[1]); w1.y = pk2(o1[2], o1[3]); *(u32x2*)(H + (size_t)m2 * DM + c) = w1; } } }
      }
      for (int m = MP + gw; m < MT; m += NGW) { const int seq = 1 + ((m - MP) >> 4);
          norm_row_bf16(x_sample + (size_t)(m - MP) * DM, norm1_g, MOD + (size_t)seq * NMOD, MOD + (size_t)seq * NMOD + 1024, H + (size_t)m * DM, lane); } }
    GRID_BAR(); STAMP(2);
    {
        FRESH_TID();
        pg8::Gemm g{H, Win_t, MT, NIN, DM}; pg8::StaticOrder S; S.init(MT, NIN, G, blk);
        pg8::EpiProj E{PA, PB, ALR};
        pg8::gemm_phase<pg8::EpiProj, pg8::StaticOrder, true, true>(lds, g, S, E, wave);
    }
    GRID_BAR(); STAMP(3);
    {
        FRESH_TID();
        for (int u = blk; u < NSC * 4; u += G) { const int sc2 = u >> 2, h2 = u & 3;
            gla_unit<false>(lds, wave, sc2 * 256, 4, 64, h2, PA, ALR, w_alpha, b_alpha, gla_norm_g, nullptr, US + (size_t)u * 32768, GT + (size_t)u * 128, ACAT, gdummy); }
        for (int u = (G - 1 - blk); u < NSEQ * 4; u += G) { const int s = u >> 2, h = u & 3;
            gla_unit<true>(lds, wave, MP + s * 16, 1, 16, h, PA, ALR, w_alpha, b_alpha, gla_norm_g, state_gla + (size_t)u * 32768, out + O_SGS + (size_t)u * 32768, nullptr, ACAT, gdummy); }
        for (int pt = blk; pt < MT / 16; pt += G) {
            const int rowb = pt * 16, c = tid, gi = c >> 7, w = 2 << gi; const bool samp = rowb >= MP; const int seq = samp ? (rowb - MP) >> 4 : 0;
            float e[31];
#pragma unroll
            for (int i = 0; i < 31; ++i) { const int j = i - 15; float v;
                if (j >= 0) v = bf2f(PA[(size_t)(rowb + j) * PA_LD + c]);
                else if (samp) v = cache_pool[((size_t)seq * 15 + (15 + j)) * 512 + c];
                else v = (rowb + j >= 0) ? bf2f(PA[(size_t)(rowb + j) * PA_LD + c]) : 0.f;
                e[i] = v; }
            float ps[32]; ps[0] = 0.f;
#pragma unroll
            for (int i = 0; i < 31; ++i) ps[i + 1] = ps[i] + e[i];
#pragma unroll
            for (int tl = 0; tl < 16; ++tl) { const int row = rowb + tl, a2 = 16 + tl; const float ut = e[15 + tl];
                const float lo = gi == 0 ? ps[a2 - 2] : gi == 1 ? ps[a2 - 4] : gi == 2 ? ps[a2 - 8] : ps[a2 - 16];
                const float cnt = samp ? (float)w : (float)((row + 1) < w ? (row + 1) : w);
                ACAT[(size_t)row * KCAT + c] = (bf16)f2bf((ps[a2] - lo) / cnt - ut);
                if (samp) { if (tl >= 1) out[O_CPS + ((size_t)seq * 15 + (tl - 1)) * 512 + c] = ut; }
                else if (row >= MP - 15) out[O_CPP + (size_t)(row - (MP - 15)) * 512 + c] = ut; }
        }
    }
    GRID_BAR(); STAMP(4);
    { FRESH_TID();
    for (int e = blk * 512 + tid; e < 131072; e += G * 512) { float S = 0.f; const int hd = __builtin_amdgcn_readfirstlane(e >> 8);
        float u[NSC];
#pragma unroll
        for (int sc = 0; sc < NSC; ++sc) u[sc] = US[(size_t)sc * 131072 + e];
#pragma unroll
        for (int sc = 0; sc < NSC; ++sc) { US[(size_t)sc * 131072 + e] = S; S = GT[sc * 512 + hd] * S + u[sc]; }
        out[O_SGP + e] = S; }
      for (int tl = blk; tl < 256; tl += G) { const int rb = tl & 7, cb = tl >> 3;
          const bf16* Ab = ACAT + (size_t)(MP + 64 * rb) * KCAT; const bf16* Bb = Wcat_t + (size_t)(32 * cb) * KCAT;
          const f32x4 accA = tile_gemm<2>(lds, tid, Ab, KCAT, Bb, KCAT, 0);
          const f32x4 accB = tile_gemm<4>(lds, tid, Ab, KCAT, Bb, KCAT, 512);
          const int rs = 64 * rb + (tid >> 3), col = 32 * cb + 4 * (tid & 7);
          const u32x2 ga = *(const u32x2*)(PB + (size_t)(MP + rs) * PB_LD + col), gb = *(const u32x2*)(PB + (size_t)(MP + rs) * PB_LD + 1024 + col);
          u32x2 w; w.x = pk2(sigm(bf_lo(ga.x)) * accA[0] + sigm(bf_lo(gb.x)) * accB[0], sigm(bf_hi(ga.x)) * accA[1] + sigm(bf_hi(gb.x)) * accB[1]);
          w.y = pk2(sigm(bf_lo(ga.y)) * accA[2] + sigm(bf_lo(gb.y)) * accB[2], sigm(bf_hi(ga.y)) * accA[3] + sigm(bf_hi(gb.y)) * accB[3]);
          *(u32x2*)(MERGED_S + (size_t)rs * DM + col) = w; } }
    GRID_BAR(); STAMP(5);
    { FRESH_TID();
    for (int u = blk; u < NSC * 4; u += G) { const int sc = u >> 2, h = u & 3;
        gla_unit<true>(lds, wave, sc * 256, 4, 64, h, PA, ALR, w_alpha, b_alpha, gla_norm_g, US + (size_t)u * 32768, nullptr, nullptr, ACAT, gacc5); } }
    { FRESH_TID();
      __syncthreads();
      for (int tl = blk; tl < 256; tl += G) { const int rb = tl & 7, cb = tl >> 3;
          const f32x4 acc = tile_gemm<4>(lds, tid, MERGED_S + (size_t)(64 * rb) * DM, DM, Wout_t + (size_t)(32 * cb) * DM, DM, 0);
          const int rs = 64 * rb + (tid >> 3), col = 32 * cb + 4 * (tid & 7), seq = 1 + (rs >> 4);
          const f32x4 xb = *(const f32x4*)(x_sample + (size_t)rs * DM + col), gt = *(const f32x4*)(MOD + (size_t)seq * NMOD + 2048 + col);
          *(f32x4*)(Y + (size_t)(MP + rs) * DM + col) = xb + gt * acc; } }
    GRID_BAR(); STAMP(6);
    {
        FRESH_TID();
        pg8::Gemm g{ACAT, Wcat_t, MP, DM, KCAT}; pg8::StaticOrder S; S.init(MP, DM, G, blk);
        pg8::EpiMerge E{PB, MERGED};
        pg8::gemm_phase<pg8::EpiMerge, pg8::StaticOrder, true, true>(lds, g, S, E, wave);
        for (int m = gw; m < MS; m += NGW) { const int seq = 1 + (m >> 4);
            norm_row_bf16(Y + (size_t)(MP + m) * DM, norm2_g, MOD + (size_t)seq * NMOD + 3072, MOD + (size_t)seq * NMOD + 4096, H2_S + (size_t)m * DM, lane); }
    }
    GRID_BAR(); STAMP(7);
    {
        FRESH_TID();
        pg8::Gemm g{MERGED, Wout_t, MP, DM, DM}; pg8::StaticOrder S; S.init(MP, DM, G, blk);
        pg8::EpiRes<false> E{x_prompt, Y, MOD + 2048};
        pg8::gemm_phase<pg8::EpiRes<false>, pg8::StaticOrder, true, true>(lds, g, S, E, wave);
        for (int ub = blk; ub < 256; ub += G) { const int rb = ub & 7, cg = ub >> 3;
            __syncthreads();
            { u32x4 av[16];
#pragma unroll
              for (int ps = 0; ps < 16; ++ps) { const int idx = ps * 512 + tid; av[ps] = *(const u32x4*)(H2_S + (size_t)(64 * rb + (idx >> 7)) * DM + (idx & 127) * 8); }
#pragma unroll
              for (int ps = 0; ps < 16; ++ps) { const int idx = ps * 512 + tid; *(LAS u32x4*)(lds + (idx >> 7) * 2064 + (idx & 127) * 16) = av[ps]; } }
            __syncthreads();
            const int wv = tid >> 6, fr = lane & 15, fq = lane >> 4;
            const bf16* bp = Wff1_t + (size_t)(128 * cg + 16 * wv + fr) * DM + 8 * fq;
            f32x4 acc[4];
#pragma unroll
            for (int mt = 0; mt < 4; ++mt) acc[mt] = (f32x4){0.f, 0.f, 0.f, 0.f};
#pragma unroll 1
            for (int kb = 0; kb < 2; ++kb) { bf16x8 bfr[16];
#pragma unroll
                for (int ks = 0; ks < 16; ++ks) bfr[ks] = *(const bf16x8*)(bp + 32 * (16 * kb + ks));
#pragma unroll
                for (int ks = 0; ks < 16; ++ks)
#pragma unroll
                    for (int mt = 0; mt < 4; ++mt) { const bf16x8 af = *(const LAS bf16x8*)(lds + (16 * mt + fr) * 2064 + (32 * (16 * kb + ks) + 8 * fq) * 2);
                        acc[mt] = MFMA16(bfr[ks], af, acc[mt]); } }
#pragma unroll
            for (int mt = 0; mt < 4; ++mt) { const float r0 = fmaxf(acc[mt][0], 0.f), r1 = fmaxf(acc[mt][1], 0.f), r2 = fmaxf(acc[mt][2], 0.f), r3 = fmaxf(acc[mt][3], 0.f);
                u32x2 w; w.x = pk2(r0 * r0, r1 * r1); w.y = pk2(r2 * r2, r3 * r3);
                *(u32x2*)(HID_S + (size_t)(64 * rb + 16 * mt + fr) * DFF + 128 * cg + 16 * wv + 4 * fq) = w; }
        }
    }
    GRID_BAR(); STAMP(8);
    { FRESH_TID();
    for (int m = gw; m < MP; m += NGW) { const int seq = 0;
        norm_row_bf16(Y + (size_t)m * DM, norm2_g, MOD + (size_t)seq * NMOD + 3072, MOD + (size_t)seq * NMOD + 4096, H2 + (size_t)m * DM, lane); }
      __syncthreads();
      for (int tl = blk; tl < 256; tl += G) { const int rb = tl & 7, cb = tl >> 3;
          const f32x4 acc = tile_gemm<16>(lds, tid, HID_S + (size_t)(64 * rb) * DFF, DFF, Wff2_t + (size_t)(32 * cb) * DFF, DFF, 0);
          const int rs = 64 * rb + (tid >> 3), col = 32 * cb + 4 * (tid & 7), seq = 1 + (rs >> 4);
          float* yp = Y + (size_t)(MP + rs) * DM + col; const f32x4 gt = *(const f32x4*)(MOD + (size_t)seq * NMOD + 5120 + col);
          *(f32x4*)yp = *(const f32x4*)yp + gt * acc; } }
    GRID_BAR(); STAMP(9);
    {
        FRESH_TID();
        pg8::Gemm g{H2, Wff1_t, MP, DFF, DM}; pg8::StaticOrder S; S.init(MP, DFF, G, blk);
        pg8::EpiRelu2 E{HID};
        pg8::gemm_phase<pg8::EpiRelu2, pg8::StaticOrder, true, true>(lds, g, S, E, wave);
        for (int m = gw; m < MS; m += NGW) { f32x4* xr = (f32x4*)(Y + (size_t)(MP + m) * DM) + lane; f32x4 v[4]; float sq = 0.f;
#pragma unroll
            for (int j = 0; j < 4; ++j) { v[j] = xr[64 * j]; sq += (v[j][0] * v[j][0] + v[j][1] * v[j][1]) + (v[j][2] * v[j][2] + v[j][3] * v[j][3]); }
            const float rstd = rsqrtf(wave_sum(sq, lane) * (1.0f / DM) + EPS);
#pragma unroll
            for (int j = 0; j < 4; ++j) { const f32x4 gg = *(const f32x4*)(final_g + 4 * lane + 256 * j); xr[64 * j] = v[j] * rstd * gg; } }
    }
    GRID_BAR(); STAMP(10);
    {
        FRESH_TID();
        pg8::Gemm g{HID, Wff2_t, MP, DM, DFF}; pg8::StaticOrder S; S.init(MP, DM, G, blk);
        pg8::EpiRes<true> E{nullptr, Y, MOD + 5120};
        pg8::gemm_phase<pg8::EpiRes<true>, pg8::StaticOrder, true, true>(lds, g, S, E, wave);
    }
    GRID_BAR(); STAMP(11);
    { FRESH_TID();
    for (int m = gw; m < MP; m += NGW) { f32x4* xr = (f32x4*)(Y + (size_t)m * DM) + lane; f32x4 v[4]; float s = 0.f;
#pragma unroll
        for (int j = 0; j < 4; ++j) { v[j] = xr[64 * j]; s += (v[j][0] * v[j][0] + v[j][1] * v[j][1]) + (v[j][2] * v[j][2] + v[j][3] * v[j][3]); }
        const float rstd = rsqrtf(wave_sum(s, lane) * (1.0f / DM) + EPS);
#pragma unroll
        for (int j = 0; j < 4; ++j) { const f32x4 gg = *(const f32x4*)(final_g + 4 * lane + 256 * j); xr[64 * j] = v[j] * rstd * gg; } } }
    if (PROBE_LO >= 0 || PROBE_SUB >= 0) { if (PROBE_HI == 12) tB = __builtin_amdgcn_s_memrealtime(); if (blk == 0) { const unsigned long long t0 = __builtin_amdgcn_s_memrealtime(), w = 4ull * (PROBE_SUB >= 0 ? gacc5 : (tB - tA)); while (__builtin_amdgcn_s_memrealtime() - t0 < w) __builtin_amdgcn_s_sleep(8); } }
}

#undef ws
#undef out
#undef x_prompt
#undef x_sample
#undef c_prompt
#undef c_sample
#undef state_gla
#undef cache_pool
#undef w_ada
#undef b_ada
#undef norm1_g
#undef w_in
#undef w_alpha
#undef b_alpha
#undef w_pool
#undef pool_scale
#undef gla_norm_g
#undef w_pa
#undef w_pb
#undef w_out
#undef norm2_g
#undef w_ff1
#undef w_ff2
#undef final_g
#undef MOD
#undef ALR
#undef GT
#undef Win_t
#undef Wcat_t
#undef Wout_t
#undef Wff1_t
#undef Wff2_t
#undef PB
#undef PA
#undef US
#undef MODP
#undef H
#undef ACAT
#undef H2
#undef MERGED
#undef HID
#undef Y
#undef MERGED_S
#undef H2_S
#undef HID_S
extern "C" void kernel_launch(void* const* d_in, const int* in_sizes, int n_in, void* d_out, int out_size, void* d_ws, size_t ws_size, hipStream_t stream) {
    static int grid = 0;
    if (grid == 0) {
        if (n_in != 22 || ws_size < WS_END) { fprintf(stderr, "kernel_launch: unexpected n_in %d / ws %zu\n", n_in, ws_size); grid = -1; return; }
        int dev = 0, cus = 0, per_cu = 0;
        hipGetDevice(&dev); hipDeviceGetAttribute(&cus, hipDeviceAttributeMultiprocessorCount, dev);
        if (hipFuncSetAttribute((const void*)fwd_kernel, hipFuncAttributeMaxDynamicSharedMemorySize, LDS_BYTES) != hipSuccess) { fprintf(stderr, "kernel_launch: hipFuncSetAttribute failed\n"); grid = -1; return; }
        if (hipOccupancyMaxActiveBlocksPerMultiprocessor(&per_cu, (const void*)fwd_kernel, 512, LDS_BYTES) != hipSuccess || per_cu < 1) { fprintf(stderr, "kernel_launch: occupancy query says %d\n", per_cu); per_cu = 1; }
        (void)hipGetLastError();
        grid = cus * 1;
    }
    if (grid < 0) return;
    if (hipMemsetAsync(d_ws, 0, 65536, stream) != hipSuccess) { fprintf(stderr, "kernel_launch: memset failed\n"); return; }
    Args a{};
    for (int i = 0; i < 22; ++i) a.in[i] = (const float*)d_in[i];
    a.out = (float*)d_out; a.ws = (unsigned char*)d_ws;
    void* args[] = {&a};
    hipError_t e = hipLaunchCooperativeKernel((const void*)fwd_kernel, dim3(grid), dim3(512), args, LDS_BYTES, stream);
    if (e != hipSuccess) fprintf(stderr, "kernel_launch: cooperative launch failed: %s (grid %d)\n", hipGetErrorString(e), grid);
}
```
